# Optimizing an MI355X kernel written in HIP

```python
import math
import jax, jax.numpy as jnp
from jax import lax
import numpy as np

D_MODEL = 1024
BATCH = 4
SEQ = 4096
DEPTH = 2

PLE_DIM = 256
D_FF = 2816
HEAD_DIM = 64
SB_HEADS = 8
SWA_HEADS = 8
SWA_KV_HEADS = 2
WINDOW = 128
Q_BLOCK = 128
GDN_K_HEADS = 8
GDN_V_HEADS = 16
GDN_HEAD_DIM = 128
GDN_CONV = 4
GDN_CHUNK = 64
EPS = 1e-6
N_EVEN = (DEPTH + 1) // 2
N_ODD = DEPTH // 2

SB_W = SB_HEADS * HEAD_DIM
SWA_QW = SWA_HEADS * HEAD_DIM
SWA_KVW = SWA_KV_HEADS * HEAD_DIM
ATT_IN = 3 * SB_W + SWA_QW + 2 * SWA_KVW
ATT_OUT = SB_W + SWA_QW
GDN_KW = GDN_K_HEADS * GDN_HEAD_DIM
GDN_VW = GDN_V_HEADS * GDN_HEAD_DIM
GDN_CONV_W = 2 * GDN_KW + GDN_VW
GDN_IN = GDN_CONV_W + GDN_VW + 2 * GDN_V_HEADS

kernel_name = 'hybrid_stickbreak_swa_gdn_macaron'


def rmsnorm(x, g):
    xf = x.astype(jnp.float32)
    y = xf * lax.rsqrt(jnp.mean(xf * xf, axis=-1, keepdims=True) + EPS) * g.astype(jnp.float32)
    return y.astype(x.dtype)


def l2norm(x):
    xf = x.astype(jnp.float32)
    return xf * lax.rsqrt(jnp.sum(xf * xf, axis=-1, keepdims=True) + EPS)


def swiglu(h, w_gate, w_up, w_down):
    return (jax.nn.silu(h @ w_gate) * (h @ w_up)) @ w_down


def alibi_slopes(n):
    return jnp.asarray(2.0 ** (-8.0 * (np.arange(n) + 1) / n), dtype=jnp.float32)


def stick_breaking_attention(q, k, v):
    b, h, t, d = q.shape
    nblk = t // Q_BLOCK
    qb = q.reshape(b, h, nblk, Q_BLOCK, d).transpose(2, 0, 1, 3, 4)
    key_pos = jnp.arange(t)
    scale = d ** -0.5

    def block(args):
        qi, i = args
        z = jnp.einsum('bhqd,bhkd->bhqk', qi, k).astype(jnp.float32) * scale
        q_pos = i * Q_BLOCK + jnp.arange(Q_BLOCK)
        causal = key_pos[None, :] < q_pos[:, None]
        log_keep = jnp.where(causal, jax.nn.log_sigmoid(-z), 0.0)
        log_between = lax.cumsum(log_keep, axis=3, reverse=True) - log_keep
        w = jnp.where(causal, jnp.exp(jax.nn.log_sigmoid(z) + log_between), 0.0)
        return jnp.einsum('bhqk,bhkd->bhqd', w.astype(v.dtype), v)

    out = lax.map(block, (qb, jnp.arange(nblk)))
    return out.transpose(1, 2, 0, 3, 4).reshape(b, h, t, d)


def swa_sink_attention(q, k, v, q_gain, k_gain, sinks, slopes):
    q = rmsnorm(q, q_gain)
    k = rmsnorm(k, k_gain)
    b, t, hq, d = q.shape
    hkv = k.shape[2]
    g = hq // hkv
    nblk = t // WINDOW
    qb = q.reshape(b, nblk, WINDOW, hkv, g, d)
    kpad = jnp.pad(k, ((0, 0), (WINDOW, 0), (0, 0), (0, 0)))
    vpad = jnp.pad(v, ((0, 0), (WINDOW, 0), (0, 0), (0, 0)))
    kb = jnp.concatenate([kpad[:, :t].reshape(b, nblk, WINDOW, hkv, d),
                          k.reshape(b, nblk, WINDOW, hkv, d)], axis=2)
    vb = jnp.concatenate([vpad[:, :t].reshape(b, nblk, WINDOW, hkv, d),
                          v.reshape(b, nblk, WINDOW, hkv, d)], axis=2)
    s = jnp.einsum('bnqhgd,bnkhd->bnhgqk', qb, kb).astype(jnp.float32) * (d ** -0.5)
    qi = jnp.arange(WINDOW)[:, None]
    kj = jnp.arange(2 * WINDOW)[None, :]
    dist = (qi + WINDOW - kj)
    band = (dist >= 0) & (dist < WINDOW)
    valid = band[None] & ((jnp.arange(nblk)[:, None, None] > 0) | (kj >= WINDOW)[None])
    bias = -slopes.reshape(hkv, g)[:, :, None, None] * dist.astype(jnp.float32)
    s = jnp.where(valid[None, :, None, None], s + bias[None, None], -jnp.inf)
    sink = jnp.broadcast_to(sinks.astype(jnp.float32).reshape(hkv, g)[None, None, :, :, None, None],
                            s.shape[:-1] + (1,))
    probs = jax.nn.softmax(jnp.concatenate([s, sink], axis=-1), axis=-1)[..., :-1]
    o = jnp.einsum('bnhgqk,bnkhd->bnqhgd', probs.astype(v.dtype), vb)
    return o.reshape(b, t, hq, d)


def attention_mixer(h, w_in, q_gain, k_gain, sinks, w_out):
    b, t, _ = h.shape
    proj = h @ w_in
    cuts = [SB_W, 2 * SB_W, 3 * SB_W, 3 * SB_W + SWA_QW, 3 * SB_W + SWA_QW + SWA_KVW]
    sq, sk, sv, bq, bk, bv = jnp.split(proj, cuts, axis=-1)
    heads = lambda z, n: z.reshape(b, t, n, HEAD_DIM)
    a_out = stick_breaking_attention(heads(sq, SB_HEADS).transpose(0, 2, 1, 3),
                                     heads(sk, SB_HEADS).transpose(0, 2, 1, 3),
                                     heads(sv, SB_HEADS).transpose(0, 2, 1, 3))
    b_out = swa_sink_attention(heads(bq, SWA_HEADS), heads(bk, SWA_KV_HEADS), heads(bv, SWA_KV_HEADS),
                               q_gain, k_gain, sinks, alibi_slopes(SWA_HEADS))
    o = jnp.concatenate([a_out.transpose(0, 2, 1, 3).reshape(b, t, SB_W),
                         b_out.reshape(b, t, SWA_QW)], axis=-1)
    return o @ w_out


def causal_depthwise_conv(x, w):
    kk, c = w.shape
    return lax.conv_general_dilated(x, w[:, None, :].astype(x.dtype), window_strides=(1,),
                                    padding=[(kk - 1, 0)], dimension_numbers=('NWC', 'WIO', 'NWC'),
                                    feature_group_count=c)


def chunk_gated_delta_rule(q, k, v, g, beta):
    b, t, h, dk = q.shape
    dv = v.shape[-1]
    c = GDN_CHUNK
    n = t // c
    chunks = lambda z: z.astype(jnp.float32).reshape(b, n, c, h, -1).transpose(0, 3, 1, 2, 4)
    q, k, v = chunks(q), chunks(k), chunks(v)
    g = g.astype(jnp.float32).reshape(b, n, c, h).transpose(0, 3, 1, 2)
    beta = beta.astype(jnp.float32).reshape(b, n, c, h).transpose(0, 3, 1, 2)
    gc = jnp.cumsum(g, axis=-1)
    idx = jnp.arange(c)
    lower_incl = idx[:, None] >= idx[None, :]
    strict = idx[:, None] > idx[None, :]
    decay = jnp.exp(jnp.where(lower_incl, gc[..., :, None] - gc[..., None, :], -jnp.inf))
    kbeta = k * beta[..., None]
    lmat = jnp.where(strict, jnp.einsum('bhncd,bhnsd->bhncs', kbeta, k) * decay, 0.0)
    tmat = lmat + jnp.eye(c, dtype=jnp.float32)
    rhs = jnp.concatenate([v * beta[..., None], kbeta * jnp.exp(gc)[..., None]], axis=-1)
    sol = lax.linalg.triangular_solve(tmat, rhs, left_side=True, lower=True, unit_diagonal=True)
    u, w = sol[..., :dv], sol[..., dv:]
    attn = jnp.where(lower_incl, jnp.einsum('bhncd,bhnsd->bhncs', q, k) * decay, 0.0)
    q_dec = q * jnp.exp(gc)[..., None]
    k_tail = k * jnp.exp(gc[..., -1:] - gc)[..., None]
    chunk_dec = jnp.exp(gc[..., -1])

    def step(state, inp):
        u_c, w_c, qd_c, a_c, kt_c, dec_c = inp
        v_new = u_c - jnp.einsum('bhcd,bhdv->bhcv', w_c, state)
        o_c = jnp.einsum('bhcd,bhdv->bhcv', qd_c, state) + jnp.einsum('bhcs,bhsv->bhcv', a_c, v_new)
        state = state * dec_c[..., None, None] + jnp.einsum('bhcd,bhcv->bhdv', kt_c, v_new)
        return state, o_c

    xs = tuple(jnp.moveaxis(z, 2, 0) for z in (u, w, q_dec, attn, k_tail, chunk_dec))
    s0 = jnp.zeros((b, h, dk, dv), jnp.float32)
    _, o = lax.scan(step, s0, xs)
    return o.transpose(1, 0, 3, 2, 4).reshape(b, t, h, dv)


def gdn_mixer(h, w_in, conv_w, a_log, dt_bias, out_gain, w_out):
    b, t, _ = h.shape
    proj = h @ w_in
    qkv, z, beta_logit, a = jnp.split(
        proj, [GDN_CONV_W, GDN_CONV_W + GDN_VW, GDN_CONV_W + GDN_VW + GDN_V_HEADS], axis=-1)
    qkv = jax.nn.silu(causal_depthwise_conv(qkv, conv_w))
    q, k, v = jnp.split(qkv, [GDN_KW, 2 * GDN_KW], axis=-1)
    q = l2norm(q.reshape(b, t, GDN_K_HEADS, GDN_HEAD_DIM)) * (GDN_HEAD_DIM ** -0.5)
    k = l2norm(k.reshape(b, t, GDN_K_HEADS, GDN_HEAD_DIM))
    rep = GDN_V_HEADS // GDN_K_HEADS
    q = jnp.repeat(q, rep, axis=2)
    k = jnp.repeat(k, rep, axis=2)
    v = v.reshape(b, t, GDN_V_HEADS, GDN_HEAD_DIM)
    beta = jax.nn.sigmoid(beta_logit.astype(jnp.float32))
    g = -jnp.exp(a_log.astype(jnp.float32)) * jax.nn.softplus(a.astype(jnp.float32) + dt_bias.astype(jnp.float32))
    o = chunk_gated_delta_rule(q, k, v, g, beta).astype(h.dtype)
    o = rmsnorm(o, out_gain) * jax.nn.silu(z.reshape(b, t, GDN_V_HEADS, GDN_HEAD_DIM))
    return o.reshape(b, t, GDN_VW) @ w_out


def setup_inputs(seed: int = 0) -> dict:
    key = jax.random.key(seed)
    ks = jax.random.split(key, 24)
    f32 = jnp.float32
    nrm = lambda kk, shape, fan_in: jax.random.normal(kk, shape, f32) * (fan_in ** -0.5)
    gain = lambda kk, shape: 1.0 + 0.02 * jax.random.normal(kk, shape, f32)
    dt = jnp.exp(jax.random.uniform(ks[15], (N_ODD, GDN_V_HEADS), f32, math.log(1e-3), math.log(0.1)))
    return {
        'x': jax.random.normal(ks[0], (BATCH, SEQ, D_MODEL), f32),
        'p': jax.random.normal(ks[1], (DEPTH, BATCH, SEQ, PLE_DIM), f32),
        'ffn_norm': gain(ks[2], (DEPTH, 2, D_MODEL)),
        'ffn_w_gate': nrm(ks[3], (DEPTH, 2, D_MODEL, D_FF), D_MODEL),
        'ffn_w_up': nrm(ks[4], (DEPTH, 2, D_MODEL, D_FF), D_MODEL),
        'ffn_w_down': nrm(ks[5], (DEPTH, 2, D_FF, D_MODEL), D_FF),
        'mix_norm': gain(ks[6], (DEPTH, D_MODEL)),
        'att_w_in': nrm(ks[7], (N_EVEN, D_MODEL, ATT_IN), D_MODEL),
        'att_q_norm': gain(ks[8], (N_EVEN, HEAD_DIM)),
        'att_k_norm': gain(ks[9], (N_EVEN, HEAD_DIM)),
        'att_sinks': 0.5 * jax.random.normal(ks[10], (N_EVEN, SWA_HEADS), f32),
        'att_w_out': nrm(ks[11], (N_EVEN, ATT_OUT, D_MODEL), ATT_OUT),
        'gdn_w_in': nrm(ks[12], (N_ODD, D_MODEL, GDN_IN), D_MODEL),
        'gdn_conv_w': nrm(ks[13], (N_ODD, GDN_CONV, GDN_CONV_W), GDN_CONV),
        'gdn_a_log': jnp.log(jax.random.uniform(ks[14], (N_ODD, GDN_V_HEADS), f32, 1.0, 16.0)),
        'gdn_dt_bias': dt + jnp.log(-jnp.expm1(-dt)),
        'gdn_out_norm': gain(ks[16], (N_ODD, GDN_HEAD_DIM)),
        'gdn_w_out': nrm(ks[17], (N_ODD, GDN_VW, D_MODEL), GDN_VW),
        'ple_norm': gain(ks[18], (DEPTH, D_MODEL)),
        'ple_w_gate': nrm(ks[19], (DEPTH, D_MODEL, D_MODEL), D_MODEL),
        'ple_w_proj': nrm(ks[20], (DEPTH, PLE_DIM, D_MODEL), PLE_DIM),
    }


def reference(x, p, ffn_norm, ffn_w_gate, ffn_w_up, ffn_w_down, mix_norm,
              att_w_in, att_q_norm, att_k_norm, att_sinks, att_w_out,
              gdn_w_in, gdn_conv_w, gdn_a_log, gdn_dt_bias, gdn_out_norm, gdn_w_out,
              ple_norm, ple_w_gate, ple_w_proj):
    h = x
    for i in range(DEPTH):
        h = h + 0.5 * swiglu(rmsnorm(h, ffn_norm[i, 0]), ffn_w_gate[i, 0], ffn_w_up[i, 0], ffn_w_down[i, 0])
        hn = rmsnorm(h, mix_norm[i])
        j = i // 2
        if i % 2 == 0:
            h = h + attention_mixer(hn, att_w_in[j], att_q_norm[j], att_k_norm[j], att_sinks[j], att_w_out[j])
        else:
            h = h + gdn_mixer(hn, gdn_w_in[j], gdn_conv_w[j], gdn_a_log[j], gdn_dt_bias[j],
                              gdn_out_norm[j], gdn_w_out[j])
        h = h + 0.5 * swiglu(rmsnorm(h, ffn_norm[i, 1]), ffn_w_gate[i, 1], ffn_w_up[i, 1], ffn_w_down[i, 1])
        gate = jax.nn.sigmoid(rmsnorm(h, ple_norm[i]) @ ple_w_gate[i])
        h = h + gate * (p[i] @ ple_w_proj[i])
    return h
```

```cpp
#include <hip/hip_runtime.h>
#include <hip/hip_cooperative_groups.h>
#include <cstdio>
namespace cg = cooperative_groups;
#ifndef EN_ATT
#define EN_ATT 1
#endif
#ifndef EN_GDN
#define EN_GDN 1
#endif
__device__ __forceinline__ int tid_fresh() { int t = threadIdx.x; asm volatile("" : "+v"(t)); return t; }
namespace pg8 {
#define PG8_LAS __attribute__((address_space(3)))
typedef unsigned short bf16_t;
typedef short bf16x8 __attribute__((ext_vector_type(8)));
typedef float f32x4 __attribute__((ext_vector_type(4)));
typedef unsigned u32x4 __attribute__((ext_vector_type(4)));
constexpr int BM = 256, BK = 64, HALF = 128, HTB = HALF * BK * 2  , STAGE_BYTES = 8 * HTB, NXCD = 8, WGM = 8;

__host__ __device__ __forceinline__ int lds_byte(int r, int c) { const int st = (r >> 4) * 2 + (c >> 5), rr = r & 15, cc = c & 31, ob = rr * 64 + cc * 2; return st * 1024 + (ob ^ (((ob >> 9) & 1) << 5)); }
__host__ __device__ __forceinline__ void stage_rc(int b, int& R, int& C) { const int st = b / 1024, sb = b % 1024, swz = sb ^ (((sb >> 9) & 1) << 5); R = (st >> 1) * 16 + swz / 64; C = (st & 1) * 32 + (swz % 64) / 2; }
__host__ __device__ __forceinline__ int perm32(int rho) { const int n = rho >> 4, i = rho & 15; return 8 * (i >> 2) + 4 * n + (i & 3); }

struct Unit { int pm, pn; };
struct Gemm { const bf16_t* A; const bf16_t* Bt; int M, N, K; };

struct StaticOrder {
    int nM, nN, nwg, G, c;
    __host__ __device__ void init(int M, int N, int G_, int c_) { nM = M / BM; nN = N / BM; nwg = nM * nN; G = G_; c = c_; }
    __host__ __device__ bool next(int i, Unit& u) const {
        const long L = (long)i * G + c; if (L >= nwg) return false;
        int wgid = (int)L; { const int q = nwg / NXCD, r = nwg % NXCD, xcd = wgid % NXCD, off = wgid / NXCD; wgid = (xcd < r ? xcd * (q + 1) : r * (q + 1) + (xcd - r) * q) + off; }
        const int nig = WGM * nN, gid = wgid / nig, fm = gid * WGM, gsz = (nM - fm) < WGM ? (nM - fm) : WGM;
        u.pm = fm + ((wgid % nig) % gsz); u.pn = (wgid % nig) / gsz; return true;
    }
    __device__ __forceinline__ void a_ready(const Unit&) const {}
    __device__ __forceinline__ void done(const Unit&) const {}
};
__device__ __forceinline__ unsigned cvt_pk_bf16(float lo, float hi) { unsigned r; asm volatile("v_cvt_pk_bf16_f32 %0, %1, %2" : "=v"(r) : "v"(lo), "v"(hi)); return r; }
template <class Epi, class Sched, bool STAMP = false>
__device__ __forceinline__ void gemm_phase(PG8_LAS unsigned char* lds, const Gemm g, const Sched& S, const Epi& E, unsigned long long* stamps) {
    const int tid = tid_fresh(), wid = __builtin_amdgcn_readfirstlane(tid >> 6), lane = tid & 63, wr = wid >> 2, wc = wid & 3, fr = lane & 15, fq = lane >> 4;
    const int K = g.K, nt = K / BK;
    int ts_lo = 0, ts_hi = 0, nts = 0; const unsigned long long rt_entry = STAMP ? (unsigned long long)wall_clock64() : 0ull;
#define PG8_STAMP() do { if (STAMP && wid == 0 && nts < 64) { const unsigned long long _c = (unsigned long long)clock64(); \
        ts_lo = (lane == nts) ? (int)(unsigned)_c : ts_lo; ts_hi = (lane == nts) ? (int)(unsigned)(_c >> 32) : ts_hi; ++nts; } } while (0)
    PG8_STAMP();
    unsigned voffA[2], voffB[2];
#pragma unroll
    for (int i = 0; i < 2; ++i) { int R, C; stage_rc(tid * 16 + i * 8192, R, C); const int Rb = Epi::PERM ? ((R & ~31) + perm32(R & 31)) : R;
        voffA[i] = (unsigned)(R * K + C) * 2u; voffB[i] = (unsigned)(Rb * K + C) * 2u; }
    const size_t kstep = (size_t)(BK * 2);
    const size_t hstep = (size_t)HALF * K * 2;
    const size_t tstep = 2 * hstep;
    const unsigned ldsw = (unsigned)wid * 1024u;
    const int aoff = lds_byte(wr * 64 + fr, fq * 8), boff = lds_byte(wc * 32 + fr, fq * 8);
#define PG8_SA(b, h) (((b) * 2 + (h)) * HTB)
#define PG8_SB(b, h) ((4 + (b) * 2 + (h)) * HTB)
#define PG8_STAGE(bufoff, gbase, voff) do { _Pragma("unroll") for (int _i = 0; _i < 2; ++_i) \
        __builtin_amdgcn_global_load_lds((const unsigned*)((const char*)(gbase) + (voff)[_i]), (PG8_LAS unsigned*)(lds + (bufoff) + ldsw + _i * 8192), 16, 0, 0); } while (0)
#define PG8_LDA(dst, b, h) do { _Pragma("unroll") for (int m = 0; m < 4; ++m) _Pragma("unroll") for (int k = 0; k < 2; ++k) dst[m][k] = *(const PG8_LAS bf16x8*)(lds + PG8_SA(b, h) + aoff + m * 2048 + k * 1024); } while (0)
#define PG8_LDB(dst, b, h) do { _Pragma("unroll") for (int n = 0; n < 2; ++n) _Pragma("unroll") for (int k = 0; k < 2; ++k) dst[n][k] = *(const PG8_LAS bf16x8*)(lds + PG8_SB(b, h) + boff + n * 2048 + k * 1024); } while (0)
#define PG8_MMA(ai, bj, At, Bt) do { __builtin_amdgcn_s_setprio(1); _Pragma("unroll") for (int m = 0; m < 4; ++m) _Pragma("unroll") for (int n = 0; n < 2; ++n) _Pragma("unroll") for (int k = 0; k < 2; ++k) \
        acc[ai][bj][m][n] = __builtin_amdgcn_mfma_f32_16x16x32_bf16(Bt[n][k], At[m][k], acc[ai][bj][m][n], 0, 0, 0); __builtin_amdgcn_s_setprio(0); } while (0)
#define PG8_WAIT_V(n) asm volatile("s_waitcnt vmcnt(" #n ")" ::: "memory")
#define PG8_WAIT_L(n) asm volatile("s_waitcnt lgkmcnt(" #n ")" ::: "memory")
#define PG8_BAR __builtin_amdgcn_s_barrier()
#define PG8_SCHED __builtin_amdgcn_sched_barrier(0)
    Unit cur, nxt; int ui = 0;
    if (!S.next(0, cur)) return;
    f32x4 acc[2][2][4][2];
#pragma unroll
    for (int a = 0; a < 2; ++a)
#pragma unroll
        for (int b = 0; b < 2; ++b)
#pragma unroll
            for (int m = 0; m < 4; ++m)
#pragma unroll
                for (int n = 0; n < 2; ++n) acc[a][b][m][n] = (f32x4){0.f, 0.f, 0.f, 0.f};
    bf16x8 At[4][2], B0[2][2], B1[2][2];
    const char* cA = (const char*)g.A + (size_t)cur.pm * tstep; const char* cB = (const char*)g.Bt + (size_t)cur.pn * tstep;
    S.a_ready(cur);
    PG8_STAGE(PG8_SB(0, 0), cB, voffB); PG8_STAGE(PG8_SA(0, 0), cA, voffA); PG8_STAGE(PG8_SB(0, 1), cB + hstep, voffB); PG8_STAGE(PG8_SA(0, 1), cA + hstep, voffA);
    if (wr == 1) PG8_BAR;
    PG8_WAIT_V(4); PG8_BAR;
    PG8_STAGE(PG8_SB(1, 0), cB + kstep, voffB); PG8_STAGE(PG8_SA(1, 0), cA + kstep, voffA); PG8_STAGE(PG8_SB(1, 1), cB + hstep + kstep, voffB);
    PG8_WAIT_V(6); PG8_BAR;
    PG8_STAMP();
    for (;;) {
        const bool has_next = S.next(ui + 1, nxt);
        const char* nA = has_next ? (const char*)g.A + (size_t)nxt.pm * tstep : cA; const char* nB = has_next ? (const char*)g.Bt + (size_t)nxt.pn * tstep : cB;
        for (int t = 0; t < nt; t += 2) {
            const bool last = (t == nt - 2);
            const char* a1 = cA + (size_t)(t + 1) * kstep;
            const char* a2 = last ? nA : cA + (size_t)(t + 2) * kstep; const char* b2 = last ? nB : cB + (size_t)(t + 2) * kstep;
            const char* a3 = a2 + kstep; const char* b3 = b2 + kstep;
            if (last && has_next) S.a_ready(nxt);
            PG8_LDB(B0, 0, 0); PG8_SCHED; PG8_LDA(At, 0, 0); PG8_STAGE(PG8_SA(1, 1), a1 + hstep, voffA);
            PG8_WAIT_L(8); PG8_BAR; PG8_WAIT_L(0); PG8_MMA(0, 0, At, B0); PG8_BAR; PG8_SCHED;
            PG8_LDB(B1, 0, 1); PG8_STAGE(PG8_SB(0, 0), b2, voffB);
            PG8_BAR; PG8_WAIT_L(0); PG8_MMA(0, 1, At, B1); PG8_BAR;
            PG8_LDA(At, 0, 1); PG8_STAGE(PG8_SA(0, 0), a2, voffA);
            PG8_BAR; PG8_WAIT_L(0); PG8_MMA(1, 0, At, B0); PG8_BAR; PG8_SCHED;
            PG8_STAGE(PG8_SB(0, 1), b2 + hstep, voffB);
            PG8_WAIT_V(6); PG8_BAR; PG8_MMA(1, 1, At, B1); PG8_BAR;
            PG8_LDB(B0, 1, 0); PG8_SCHED; PG8_LDA(At, 1, 0); PG8_STAGE(PG8_SA(0, 1), a2 + hstep, voffA);
            PG8_WAIT_L(8); PG8_BAR; PG8_WAIT_L(0); PG8_MMA(0, 0, At, B0); PG8_BAR; PG8_SCHED;
            PG8_LDB(B1, 1, 1); PG8_STAGE(PG8_SB(1, 0), b3, voffB);
            PG8_BAR; PG8_WAIT_L(0); PG8_MMA(0, 1, At, B1); PG8_BAR;
            PG8_LDA(At, 1, 1); PG8_STAGE(PG8_SA(1, 0), a3, voffA);
            PG8_BAR; PG8_WAIT_L(0); PG8_MMA(1, 0, At, B0); PG8_BAR; PG8_SCHED;
            PG8_STAGE(PG8_SB(1, 1), b3 + hstep, voffB);
            PG8_WAIT_V(6); PG8_BAR; PG8_MMA(1, 1, At, B1); PG8_BAR;
        }
        PG8_STAMP();
        if constexpr (!Epi::AFTER_DRAIN) { E(acc, cur, wr, wc, fr, fq); S.done(cur); }
        PG8_STAMP();
        if (!has_next) break;
#pragma unroll
        for (int a = 0; a < 2; ++a)
#pragma unroll
            for (int b = 0; b < 2; ++b)
#pragma unroll
                for (int m = 0; m < 4; ++m)
#pragma unroll
                    for (int n = 0; n < 2; ++n) acc[a][b][m][n] = (f32x4){0.f, 0.f, 0.f, 0.f};
        cur = nxt; cA = nA; cB = nB; ++ui;
    }
    PG8_WAIT_V(0);
    if (wr == 0) PG8_BAR;
    PG8_BAR;
    if constexpr (Epi::AFTER_DRAIN) { E.fused(acc, cur, wr, wc, fr, fq, lds, wid, lane); S.done(cur); }
    PG8_STAMP();
    if (STAMP && wid == 0) { stamps[lane] = lane < nts ? (((unsigned long long)(unsigned)ts_hi << 32) | (unsigned)ts_lo) : 0ull;
        if (lane == 62) stamps[62] = rt_entry; if (lane == 63) stamps[63] = (unsigned long long)wall_clock64(); }
#undef PG8_STAMP
#undef PG8_SA
#undef PG8_SB
#undef PG8_STAGE
#undef PG8_LDA
#undef PG8_LDB
#undef PG8_MMA
#undef PG8_WAIT_V
#undef PG8_WAIT_L
#undef PG8_BAR
#undef PG8_SCHED
}
}

using pg8::bf16_t; using pg8::bf16x8; using pg8::f32x4; using pg8::u32x4; using pg8::Unit;
typedef unsigned u32x2 __attribute__((ext_vector_type(2)));
typedef __bf16 bf2_t __attribute__((ext_vector_type(2)));
#define LAS __attribute__((address_space(3)))

constexpr int MROWS = 16384;
constexpr size_t MIB = 1048576;
constexpr size_t OFF_WZ = 0, OFF_WGO = 4 * MIB, OFF_WGU11 = 8 * MIB, OFF_WD11 = 19 * MIB, OFF_WPG1 = 24 * MIB + MIB / 2, OFF_WPP1 = 26 * MIB + MIB / 2,
    OFF_WQKVG = 27 * MIB, OFF_WE = 35 * MIB + MIB / 2,
    OFF_WGU00 = OFF_WE, OFF_WD00 = OFF_WGU00 + 11 * MIB, OFF_WGU01 = OFF_WD00 + 11 * MIB / 2, OFF_WD01 = OFF_WGU01 + 11 * MIB,
    OFF_WATTIN = OFF_WD01 + 11 * MIB / 2, OFF_WATTOUT = OFF_WATTIN + 9 * MIB / 2, OFF_WPG0 = OFF_WATTOUT + 2 * MIB, OFF_WPP0 = OFF_WPG0 + 2 * MIB,
    OFF_WGU10 = OFF_WPP0 + MIB / 2, OFF_WD10 = OFF_WGU10 + 11 * MIB,
    OFF_SB = 94 * MIB, OFF_BIG = 126 * MIB, OFF_SSQA = 235 * MIB + MIB / 2, OFF_SSQB = OFF_SSQA + MIB, OFF_PB = OFF_SSQB + MIB, OFF_SA = 263422976,
    WS_NEED = OFF_SA + 32 * MIB,
    OFF_QKV = OFF_WE, OFF_GATES = OFF_QKV + 128 * MIB, OFF_HALO = OFF_GATES + 2 * MIB, OFF_TINV = OFF_HALO + 6 * MIB, OFF_ATTN = OFF_TINV + 32 * MIB,
    OFF_GB = OFF_WQKVG, OFF_OB = OFF_TINV, OFF_H2 = OFF_WE, OFF_ACT11 = OFF_H2 + 32 * MIB, OFF_H3 = OFF_ACT11 + 88 * MIB, OFF_PP1 = OFF_WE;
static_assert(OFF_WD10 + 11 * MIB / 2 == OFF_SB, "weights map");
static_assert(OFF_ATTN + 32 * MIB == OFF_SSQA, "gdn map");
static_assert(OFF_PB + 8 * MIB <= OFF_SA && WS_NEED <= 296977568ull, "ws size");

struct WDesc { unsigned long long dst_off; unsigned src_off, gain_off; int src_idx, gain_idx, ldsrc, col0, ncols, K, dstrow0, mode; };
constexpr int NDESC = 22;
struct Args { const float* in[21]; float* out; unsigned char* ws; WDesc wd[NDESC]; };

typedef float f2v_t __attribute__((ext_vector_type(2)));
__device__ __forceinline__ unsigned pk2(float lo, float hi) { const f2v_t f = {lo, hi}; const bf2_t r = __builtin_convertvector(f, bf2_t); return __builtin_bit_cast(unsigned, r); }
__device__ __forceinline__ float bf_lo(unsigned u) { return __uint_as_float(u << 16); }
__device__ __forceinline__ float bf_hi(unsigned u) { return __uint_as_float(u & 0xffff0000u); }
__device__ __forceinline__ float bf2f(bf16_t b) { return __uint_as_float(((unsigned)b) << 16); }
__device__ __forceinline__ float sigm(float x) { return 1.f / (1.f + __expf(-x)); }
__device__ __forceinline__ float silu_(float x) { return x / (1.f + __expf(-x)); }
__device__ __forceinline__ float wave_sum(float v) {
#pragma unroll
    for (int o = 1; o < 64; o <<= 1) v += __shfl_xor(v, o);
    return v;
}
__device__ __forceinline__ float row_rstd(const float* ssq, int row) {
    const f32x4* p = (const f32x4*)(ssq + (size_t)row * 16);
    const f32x4 a = p[0], b = p[1], c = p[2], d = p[3];
    const float s = (((a.x + a.y) + (a.z + a.w)) + ((b.x + b.y) + (b.z + b.w))) + (((c.x + c.y) + (c.z + c.w)) + ((d.x + d.y) + (d.z + d.w)));
    return rsqrtf(s * (1.f / 1024.f) + 1e-6f);
}
__device__ __forceinline__ float dot2bf(unsigned a, unsigned b, float c) {
    return __builtin_amdgcn_fdot2_f32_bf16(__builtin_bit_cast(bf2_t, a), __builtin_bit_cast(bf2_t, b), c, false);
}

struct EpiT {
    static constexpr bool PERM = true, AFTER_DRAIN = false;
    int mode;
    const float* ssq; bf16_t* out; int ldo;
    bf16_t* halo; float* gates;
    const bf16_t* osrc; const float* ogain; LAS float* tab; mutable int ui;
    __device__ __forceinline__ void operator()(const f32x4 (&acc)[2][2][4][2], const Unit& u, int wr, int wc, int fr_, int fq_) const {
        int fr = fr_, fq = fq_; asm volatile("" : "+v"(fr), "+v"(fq));
#pragma unroll
        for (int ai = 0; ai < 2; ++ai)
#pragma unroll
            for (int m = 0; m < 4; ++m) {
                const int rl = ai * 128 + wr * 64 + m * 16 + fr, row = u.pm * 256 + rl;
                const float rs = row_rstd(ssq, row);
                if (mode == 0) {
                    const f32x4 g0 = acc[ai][0][m][0] * rs, g1 = acc[ai][0][m][1] * rs, u0 = acc[ai][1][m][0] * rs, u1 = acc[ai][1][m][1] * rs;
                    u32x4 w;
                    w.x = pk2(silu_(g0[0]) * u0[0], silu_(g0[1]) * u0[1]); w.y = pk2(silu_(g0[2]) * u0[2], silu_(g0[3]) * u0[3]);
                    w.z = pk2(silu_(g1[0]) * u1[0], silu_(g1[1]) * u1[1]); w.w = pk2(silu_(g1[2]) * u1[2], silu_(g1[3]) * u1[3]);
                    *(u32x4*)(out + (size_t)row * 2816 + u.pn * 128 + wc * 32 + 8 * fq) = w;
                } else {
#pragma unroll
                    for (int bj = 0; bj < 2; ++bj) {
                        const int c0 = u.pn * 256 + bj * 128 + wc * 32 + 8 * fq;
                        const f32x4 v0 = acc[ai][bj][m][0] * rs, v1 = acc[ai][bj][m][1] * rs;
                        if (mode == 3) {
                            const float ro = tab[ui * 512 + rl * 2 + bj];
                            const u32x4 o8 = *(const u32x4*)(osrc + (size_t)row * 4096 + 2048 + c0);
                            const f32x4 ga = *(const f32x4*)(ogain + (c0 & 127)), gb = *(const f32x4*)(ogain + (c0 & 127) + 4);
                            u32x4 w;
#define SAN(x) ((fabsf(x) < 1e30f) ? (x) : 0.f)
                            w.x = pk2(SAN(bf_lo(o8.x) * ro * ga[0] * silu_(v0[0])), SAN(bf_hi(o8.x) * ro * ga[1] * silu_(v0[1])));
                            w.y = pk2(SAN(bf_lo(o8.y) * ro * ga[2] * silu_(v0[2])), SAN(bf_hi(o8.y) * ro * ga[3] * silu_(v0[3])));
                            w.z = pk2(SAN(bf_lo(o8.z) * ro * gb[0] * silu_(v1[0])), SAN(bf_hi(o8.z) * ro * gb[1] * silu_(v1[1])));
                            w.w = pk2(SAN(bf_lo(o8.w) * ro * gb[2] * silu_(v1[2])), SAN(bf_hi(o8.w) * ro * gb[3] * silu_(v1[3])));
                            *(u32x4*)(out + (size_t)row * 2048 + c0) = w;
                        } else {
                            u32x4 w; w.x = pk2(v0[0], v0[1]); w.y = pk2(v0[2], v0[3]); w.z = pk2(v1[0], v1[1]); w.w = pk2(v1[2], v1[3]);
                            if (mode == 1) { *(u32x4*)(out + (size_t)row * ldo + c0) = w; }
                            else if (c0 < 4096) {
                                *(u32x4*)(out + (size_t)row * 4096 + c0) = w;
                                const int t = row & 4095;
                                if ((t & 63) >= 61) *(u32x4*)(halo + ((size_t)((row >> 12) * 64 + (t >> 6)) * 3 + ((t & 63) - 61)) * 4096 + c0) = w;
                            } else if (c0 < 4128) {
                                float* gp = gates + (size_t)row * 32 + (c0 - 4096);
                                *(f32x4*)gp = v0; *(f32x4*)(gp + 4) = v1;
                            }
                        }
                    }
                }
            }
        if (mode == 3) ++ui;
    }
};
struct EpiF {
    static constexpr bool PERM = false, AFTER_DRAIN = false;
    int mode;
    const float* hin; float* hout; bf16_t* hb; float* ssqo; float scale; const float* ssqi; float* pp;
    __device__ __forceinline__ void operator()(const f32x4 (&acc)[2][2][4][2], const Unit& u, int wr, int wc, int fr_, int fq_) const {
        int fr = fr_, fq = fq_; asm volatile("" : "+v"(fr), "+v"(fq));
#pragma unroll
        for (int ai = 0; ai < 2; ++ai)
#pragma unroll
            for (int m = 0; m < 4; ++m) {
                const int row = u.pm * 256 + ai * 128 + wr * 64 + m * 16 + fr;
                float rs = 0.f, sq = 0.f;
                if (mode == 2) rs = row_rstd(ssqi, row);
#pragma unroll
                for (int bj = 0; bj < 2; ++bj)
#pragma unroll
                    for (int n = 0; n < 2; ++n) {
                        const size_t idx = (size_t)row * 1024 + u.pn * 256 + bj * 128 + wc * 32 + n * 16 + 4 * fq;
                        const f32x4 v = acc[ai][bj][m][n];
                        if (mode == 1) { *(f32x4*)(pp + idx) = v; continue; }
                        f32x4 h = *(const f32x4*)(hin + idx);
                        if (mode == 0) h = h + v * scale;
                        else { const f32x4 q = *(const f32x4*)(pp + idx);
                            h[0] += sigm(v[0] * rs) * q[0]; h[1] += sigm(v[1] * rs) * q[1]; h[2] += sigm(v[2] * rs) * q[2]; h[3] += sigm(v[3] * rs) * q[3]; }
                        *(f32x4*)(hout + idx) = h;
                        if (hb) { u32x2 w; w.x = pk2(h[0], h[1]); w.y = pk2(h[2], h[3]); *(u32x2*)(hb + idx) = w; }
                        sq += (h[0] * h[0] + h[1] * h[1]) + (h[2] * h[2] + h[3] * h[3]);
                    }
                if (mode != 1 && ssqo) { sq += __shfl_xor(sq, 16); sq += __shfl_xor(sq, 32); if (fq == 0) ssqo[(size_t)row * 16 + u.pn * 4 + wc] = sq; }
            }
    }
};
template <class Epi> __device__ __forceinline__ void run_gemm(LAS unsigned char* lds, const bf16_t* A, const bf16_t* Bt, int N, int K, const Epi& E) {
    pg8::StaticOrder S; S.init(MROWS, N, gridDim.x, blockIdx.x);
    const pg8::Gemm g{A, Bt, MROWS, N, K};
    pg8::gemm_phase<Epi, pg8::StaticOrder, false>(lds, g, S, E, nullptr);
}
__device__ __forceinline__ void gemm_gu(LAS unsigned char* lds, const bf16_t* A, const float* ssq, const bf16_t* W, bf16_t* act) {
    EpiT e{}; e.mode = 0; e.ssq = ssq; e.out = act; run_gemm(lds, A, W, 5632, 1024, e);
}
__device__ __forceinline__ void gemm_res(LAS unsigned char* lds, const bf16_t* A, const bf16_t* W, int K, const float* hin, float* hout, bf16_t* hb, float* ssqo, float scale) {
    EpiF e{}; e.mode = 0; e.hin = hin; e.hout = hout; e.hb = hb; e.ssqo = ssqo; e.scale = scale; run_gemm(lds, A, W, 1024, K, e);
}
__device__ __forceinline__ void ple_phase(LAS unsigned char* lds, const bf16_t* pb, const bf16_t* Wpp, float* pp, const bf16_t* A, const float* ssqi, const bf16_t* Wpg,
                                          float* h, bf16_t* hb, float* ssqo) {
    run_gemm(lds, pb, Wpp, 1024, 256, EpiF{1, nullptr, nullptr, nullptr, nullptr, 0.f, nullptr, pp});
    __threadfence(); __syncthreads(); __builtin_amdgcn_fence(__ATOMIC_ACQUIRE, "agent");
    run_gemm(lds, A, Wpg, 1024, 1024, EpiF{2, h, h, hb, ssqo, 0.f, ssqi, pp});
}

__device__ __forceinline__ void cvt_rows_bf16(const float* src, bf16_t* dst, int ncol4  , int lane, int gw, int NGW) {
    for (int row = gw; row < MROWS; row += NGW) {
        const f32x4 v = *(const f32x4*)(src + (size_t)row * 256 + 4 * lane);
        u32x2 w; w.x = pk2(v[0], v[1]); w.y = pk2(v[2], v[3]);
        *(u32x2*)(dst + (size_t)row * 256 + 4 * lane) = w;
    }
}
__device__ __forceinline__ void p0_phase(const Args& a, LAS unsigned char* lds) {
    const int lane = tid_fresh() & 63, wave = tid_fresh() >> 6;
    const int gw = blockIdx.x * 8 + wave, NGW = gridDim.x * 8;
    LAS float* scr = (LAS float*)(lds + wave * 8704);
    int total = 0;
    for (int d = 0; d < NDESC; ++d) total += (a.wd[d].K >> 6) * (a.wd[d].ncols >> 5);
    for (int it = gw; it < total; it += NGW) {
        int r = it, d = 0;
        for (;;) { const int c = (a.wd[d].K >> 6) * (a.wd[d].ncols >> 5); if (r < c) break; r -= c; ++d; }
        const float* src = a.in[a.wd[d].src_idx] + a.wd[d].src_off; const float* gain = a.wd[d].gain_idx >= 0 ? a.in[a.wd[d].gain_idx] + a.wd[d].gain_off : nullptr; bf16_t* dst = (bf16_t*)(a.ws + a.wd[d].dst_off);
        const int ldsrc = a.wd[d].ldsrc, col0 = a.wd[d].col0, K = a.wd[d].K, dstrow0 = a.wd[d].dstrow0, mode = a.wd[d].mode;
        const int nblk = a.wd[d].ncols >> 5, kb = r / nblk, nb = r % nblk, k0 = 64 * kb, n0 = 32 * nb;
#pragma unroll 8
        for (int i = 0; i < 32; ++i) { const int kk = 2 * i + (lane >> 5); const float g = gain ? gain[k0 + kk] : 1.f;
            scr[kk * 33 + (lane & 31)] = src[(size_t)(k0 + kk) * ldsrc + col0 + n0 + (lane & 31)] * g; }
        asm volatile("s_waitcnt lgkmcnt(0)" ::: "memory");
        const int c = lane & 7;
#pragma unroll
        for (int j = 0; j < 4; ++j) { const int n = (lane >> 3) + 8 * j, f = n0 + n;
            const int drow = mode == 0 ? dstrow0 + f : (256 * (f >> 7) + (f & 127) + (mode == 2 ? 128 : 0));
            LAS const float* s = scr + (8 * c) * 33 + n;
            u32x4 o; o.x = pk2(s[0], s[33]); o.y = pk2(s[66], s[99]); o.z = pk2(s[132], s[165]); o.w = pk2(s[198], s[231]);
            *(u32x4*)(dst + (size_t)drow * K + k0 + 8 * c) = o; }
        asm volatile("s_waitcnt lgkmcnt(0)" ::: "memory");
    }
    const float* x = a.in[0]; bf16_t* xb = (bf16_t*)(a.ws + OFF_SA); float* ssq = (float*)(a.ws + OFF_SSQA);
    for (int row = gw; row < MROWS; row += NGW) {
        float s = 0.f;
#pragma unroll
        for (int j = 0; j < 4; ++j) { const f32x4 v = *(const f32x4*)(x + (size_t)row * 1024 + 256 * j + 4 * lane);
            s += (v[0] * v[0] + v[1] * v[1]) + (v[2] * v[2] + v[3] * v[3]);
            u32x2 w; w.x = pk2(v[0], v[1]); w.y = pk2(v[2], v[3]); *(u32x2*)(xb + (size_t)row * 1024 + 256 * j + 4 * lane) = w; }
        s = wave_sum(s);
        if (lane < 16) ssq[(size_t)row * 16 + lane] = lane == 0 ? s : 0.f;
    }
    cvt_rows_bf16(a.in[1], (bf16_t*)(a.ws + OFF_PB), 64, lane, gw, NGW);
}
__device__ __forceinline__ void stage_k(const bf16_t* src, LAS unsigned char* Kt, int lane) {
#pragma unroll
    for (int i = 0; i < 8; ++i) { const int r = (lane >> 3) + 8 * i;
        const u32x4 v = *(const u32x4*)(src + (size_t)r * 2304 + (lane & 7) * 8);
        *(LAS u32x4*)(Kt + r * 144 + (lane & 7) * 16) = v; }
}
__device__ __forceinline__ void stage_k_norm(const bf16_t* src, const float* kg, LAS unsigned char* Kt, int lane) {
    const f32x4 g0 = *(const f32x4*)(kg + (lane & 7) * 8), g1 = *(const f32x4*)(kg + (lane & 7) * 8 + 4);
#pragma unroll
    for (int i = 0; i < 8; ++i) { const int r = (lane >> 3) + 8 * i;
        const u32x4 v = *(const u32x4*)(src + (size_t)r * 2304 + (lane & 7) * 8);
        float f[8] = {bf_lo(v.x), bf_hi(v.x), bf_lo(v.y), bf_hi(v.y), bf_lo(v.z), bf_hi(v.z), bf_lo(v.w), bf_hi(v.w)};
        float s = 0.f;
#pragma unroll
        for (int e = 0; e < 8; ++e) s += f[e] * f[e];
        s += __shfl_xor(s, 1); s += __shfl_xor(s, 2); s += __shfl_xor(s, 4);
        const float inv = rsqrtf(s * (1.f / 64.f) + 1e-6f);
        u32x4 w; w.x = pk2(f[0] * inv * g0[0], f[1] * inv * g0[1]); w.y = pk2(f[2] * inv * g0[2], f[3] * inv * g0[3]);
        w.z = pk2(f[4] * inv * g1[0], f[5] * inv * g1[1]); w.w = pk2(f[6] * inv * g1[2], f[7] * inv * g1[3]);
        *(LAS u32x4*)(Kt + r * 144 + (lane & 7) * 16) = w; }
}
__device__ __forceinline__ void stage_vt(const bf16_t* src, LAS unsigned char* Vt, int lane) {
#pragma unroll
    for (int c = 0; c < 8; ++c) {
        const u32x4 v = *(const u32x4*)(src + (size_t)lane * 2304 + c * 8);
        LAS unsigned short* p = (LAS unsigned short*)(Vt + (8 * c) * 144 + lane * 2);
        p[0 * 72] = (unsigned short)(v.x & 0xffffu); p[1 * 72] = (unsigned short)(v.x >> 16);
        p[2 * 72] = (unsigned short)(v.y & 0xffffu); p[3 * 72] = (unsigned short)(v.y >> 16);
        p[4 * 72] = (unsigned short)(v.z & 0xffffu); p[5 * 72] = (unsigned short)(v.z >> 16);
        p[6 * 72] = (unsigned short)(v.w & 0xffffu); p[7 * 72] = (unsigned short)(v.w >> 16);
    }
}
__device__ __forceinline__ float qk_dot(const unsigned (&qp)[32], LAS const unsigned char* krow) {
    float acc = 0.f;
#pragma unroll
    for (int c = 0; c < 8; ++c) { const u32x4 kv = *(LAS const u32x4*)(krow + c * 16);
        acc = dot2bf(qp[4 * c], kv.x, acc); acc = dot2bf(qp[4 * c + 1], kv.y, acc); acc = dot2bf(qp[4 * c + 2], kv.z, acc); acc = dot2bf(qp[4 * c + 3], kv.w, acc); }
    return acc;
}
__device__ __forceinline__ void pv_acc(float (&o)[64], const float (&w)[8], LAS const unsigned char* Vt, int g) {
    const unsigned w0 = pk2(w[0], w[1]), w1 = pk2(w[2], w[3]), w2 = pk2(w[4], w[5]), w3 = pk2(w[6], w[7]);
#pragma unroll
    for (int d = 0; d < 64; ++d) { const u32x4 vv = *(LAS const u32x4*)(Vt + d * 144 + g * 16);
        o[d] = dot2bf(w0, vv.x, dot2bf(w1, vv.y, dot2bf(w2, vv.z, dot2bf(w3, vv.w, o[d])))); }
}
__device__ __forceinline__ void store_o(const float (&o)[64], float sc, bf16_t* dst) {
#pragma unroll
    for (int c = 0; c < 8; ++c) { u32x4 w; w.x = pk2(o[8 * c] * sc, o[8 * c + 1] * sc); w.y = pk2(o[8 * c + 2] * sc, o[8 * c + 3] * sc);
        w.z = pk2(o[8 * c + 4] * sc, o[8 * c + 5] * sc); w.w = pk2(o[8 * c + 6] * sc, o[8 * c + 7] * sc); *(u32x4*)(dst + 8 * c) = w; }
}
__device__ __forceinline__ void wave_lds_fence() { asm volatile("s_waitcnt lgkmcnt(0)" ::: "memory"); }

__device__ __forceinline__ void att_sb_item(const bf16_t* proj, bf16_t* oatt, LAS unsigned char* wl, int b, int h, int qb, int lane) {
    LAS unsigned char* Kt = wl; LAS unsigned char* Vt = wl + 9216;
    const int t = qb * 64 + lane; const size_t rowq = (size_t)b * 4096 + t;
    unsigned qp[32];
#pragma unroll
    for (int c = 0; c < 8; ++c) { const u32x4 v = *(const u32x4*)(proj + rowq * 2304 + h * 64 + c * 8); qp[4 * c] = v.x; qp[4 * c + 1] = v.y; qp[4 * c + 2] = v.z; qp[4 * c + 3] = v.w; }
    float o[64];
#pragma unroll
    for (int d = 0; d < 64; ++d) o[d] = 0.f;
    float R = 0.f;
    for (int kb = qb; kb >= 0; --kb) {
        const bf16_t* kbase = proj + ((size_t)b * 4096 + kb * 64) * 2304;
        wave_lds_fence();
        stage_k(kbase + 512 + h * 64, Kt, lane); stage_vt(kbase + 1024 + h * 64, Vt, lane);
        wave_lds_fence();
        for (int g = 7; g >= 0; --g) {
            float z[8], w[8];
#pragma unroll
            for (int jj = 0; jj < 8; ++jj) z[jj] = qk_dot(qp, Kt + (8 * g + jj) * 144) * 0.125f;
#pragma unroll
            for (int jj = 7; jj >= 0; --jj) { const int s = kb * 64 + 8 * g + jj; const bool valid = s < t;
                const float sp = fmaxf(z[jj], 0.f) + __logf(1.f + __expf(-fabsf(z[jj])));
                w[jj] = valid ? __expf(z[jj] - sp + R) : 0.f;
                R = valid ? R - sp : R; }
            pv_acc(o, w, Vt, g);
        }
        if (__all(R < -104.f)) break;
    }
    store_o(o, 1.f, oatt + rowq * 1024 + h * 64);
}
__device__ __forceinline__ void att_swa_item(const bf16_t* proj, bf16_t* oatt, const float* qg, const float* kg, const float* sinks, LAS unsigned char* wl, int b, int hq, int qb, int lane) {
    LAS unsigned char* Kt = wl; LAS unsigned char* Vt = wl + 9216;
    const int kv = hq >> 2; const float slope = exp2f(-(float)(hq + 1));
    const int t = qb * 64 + lane; const size_t rowq = (size_t)b * 4096 + t;
    unsigned qp[32];
    { float s = 0.f; unsigned raw[32];
#pragma unroll
      for (int c = 0; c < 8; ++c) { const u32x4 v = *(const u32x4*)(proj + rowq * 2304 + 1536 + hq * 64 + c * 8); raw[4 * c] = v.x; raw[4 * c + 1] = v.y; raw[4 * c + 2] = v.z; raw[4 * c + 3] = v.w; }
#pragma unroll
      for (int i = 0; i < 32; ++i) { const float a = bf_lo(raw[i]), c = bf_hi(raw[i]); s += a * a + c * c; }
      const float inv = rsqrtf(s * (1.f / 64.f) + 1e-6f) * 0.125f;
#pragma unroll
      for (int i = 0; i < 32; ++i) qp[i] = pk2(bf_lo(raw[i]) * inv * qg[2 * i], bf_hi(raw[i]) * inv * qg[2 * i + 1]); }
    float o[64];
#pragma unroll
    for (int d = 0; d < 64; ++d) o[d] = 0.f;
    float m = sinks[hq], l = 1.f;
    for (int kb = (qb >= 2 ? qb - 2 : 0); kb <= qb; ++kb) {
        const bf16_t* kbase = proj + ((size_t)b * 4096 + kb * 64) * 2304;
        wave_lds_fence();
        stage_k_norm(kbase + 2048 + kv * 64, kg, Kt, lane); stage_vt(kbase + 2176 + kv * 64, Vt, lane);
        wave_lds_fence();
        for (int g = 0; g < 8; ++g) {
            const int s0 = kb * 64 + 8 * g;
            if (s0 + 7 < qb * 64 - 127 || s0 > qb * 64 + 63) continue;
            float z[8], w[8];
            float mx = m;
#pragma unroll
            for (int jj = 0; jj < 8; ++jj) { const int dist = t - (s0 + jj); const bool valid = dist >= 0 && dist < 128;
                const float sc = qk_dot(qp, Kt + (8 * g + jj) * 144) - slope * (float)dist;
                z[jj] = valid ? sc : -1e30f; mx = fmaxf(mx, z[jj]); }
            const float corr = __expf(m - mx);
            l *= corr;
#pragma unroll
            for (int d = 0; d < 64; ++d) o[d] *= corr;
#pragma unroll
            for (int jj = 0; jj < 8; ++jj) { w[jj] = z[jj] > -1e29f ? __expf(z[jj] - mx) : 0.f; l += w[jj]; }
            m = mx;
            pv_acc(o, w, Vt, g);
        }
    }
    store_o(o, 1.f / l, oatt + rowq * 1024 + 512 + hq * 64);
}
__device__ __forceinline__ void att_phase(const Args& a, LAS unsigned char* lds, const bf16_t* proj, bf16_t* oatt) {
    const int lane = tid_fresh() & 63, wave = tid_fresh() >> 6;
    LAS unsigned char* wl = lds + wave * 18432;
    const int NGW = gridDim.x * 8;
    for (int it = blockIdx.x * 8 + wave; it < 4096; it += NGW) {
        const int kind = it >> 11, r = it & 2047;
        const int qb = 63 - (r & 63), h = (r >> 6) & 7, b = r >> 9;
        if (kind == 0) att_sb_item(proj, oatt, wl, b, h, qb, lane);
        else att_swa_item(proj, oatt, a.in[8], a.in[9], a.in[10], wl, b, h, qb, lane);
    }
}
__device__ __forceinline__ f32x4 mfma16(bf16x8 x, bf16x8 y, f32x4 c) { return __builtin_amdgcn_mfma_f32_16x16x32_bf16(x, y, c, 0, 0, 0); }
__device__ __forceinline__ bf16_t f2bf(float x) { return (bf16_t)(pk2(x, 0.f) & 0xffffu); }

__device__ __forceinline__ void gdn_prep_phase(const Args& a, LAS unsigned char* lds) {
    const int tid = tid_fresh(), lane = tid & 63, wave = tid >> 6;
    unsigned char* ws = a.ws;
    bf16_t* QKV = (bf16_t*)(ws + OFF_QKV); const bf16_t* halo = (const bf16_t*)(ws + OFF_HALO); const float* gates = (const float*)(ws + OFF_GATES);
    float* gb = (float*)(ws + OFF_GB); bf16_t* Tinv = (bf16_t*)(ws + OFF_TINV); bf16_t* attn = (bf16_t*)(ws + OFF_ATTN);
    const float* convw = a.in[13]; const float* a_log = a.in[14]; const float* dtb = a.in[15];
    constexpr int CSP = 1040;
    LAS unsigned char* cs = lds;
    LAS float* kkf = (LAS float*)(lds + 69888);
    LAS float* qkf = (LAS float*)(lds + 69888 + 17408);
    LAS float* Lm = (LAS float*)(lds + 104704);
    LAS float* betas = (LAS float*)(lds + 137472);
    LAS float* gcs = betas + 128;
    for (int item = blockIdx.x; item < 2048; item += gridDim.x) {
        const int n = item & 63, hk = (item >> 6) & 7, b = item >> 9;
        const size_t row0 = (size_t)b * 4096 + 64 * n;
        __syncthreads();
        for (int v = tid; v < 67 * 64; v += 512) {
            const int i = v >> 6, ch = 8 * (v & 63);
            const int gcol = ch < 128 ? hk * 128 + ch : (ch < 256 ? 1024 + hk * 128 + (ch - 128) : 2048 + hk * 256 + (ch - 256));
            u32x4 val = {0u, 0u, 0u, 0u};
            if (i >= 3) val = *(const u32x4*)(QKV + (row0 + i - 3) * 4096 + gcol);
            else if (n > 0) val = *(const u32x4*)(halo + ((size_t)(b * 64 + n - 1) * 3 + i) * 4096 + gcol);
            *(LAS u32x4*)(cs + i * CSP + ch * 2) = val;
        }
        __syncthreads();
        {
            const int ch = tid;
            const int gcol = ch < 128 ? hk * 128 + ch : (ch < 256 ? 1024 + hk * 128 + (ch - 128) : 2048 + hk * 256 + (ch - 256));
            const float w0 = convw[gcol], w1 = convw[4096 + gcol], w2 = convw[8192 + gcol], w3 = convw[12288 + gcol];
            LAS bf16_t* col = (LAS bf16_t*)(cs + ch * 2);
            float x0 = bf2f(col[0]), x1 = bf2f(col[520]), x2 = bf2f(col[1040]);
#pragma unroll 8
            for (int t = 0; t < 64; ++t) { const float x3 = bf2f(col[(t + 3) * 520]);
                const float y = (w0 * x0 + w1 * x1) + (w2 * x2 + w3 * x3);
                col[(t + 3) * 520] = f2bf(silu_(y)); x0 = x1; x1 = x2; x2 = x3; }
        }
        __syncthreads();
        for (int tt = 0; tt < 8; ++tt) {
            const int t = wave * 8 + tt;
#pragma unroll
            for (int part = 0; part < 2; ++part) {
                LAS unsigned* p = (LAS unsigned*)(cs + (t + 3) * CSP + part * 256 + lane * 4);
                const unsigned u = *p; const float x0 = bf_lo(u), x1 = bf_hi(u);
                const float ss = wave_sum(x0 * x0 + x1 * x1);
                const float inv = rsqrtf(ss + 1e-6f) * (part == 0 ? 0.08838834764831845f : 1.f);
                const unsigned w = pk2(x0 * inv, x1 * inv); *p = w;
                *(unsigned*)(QKV + (row0 + t) * 4096 + part * 1024 + hk * 128 + 2 * lane) = w;
            }
        }
        for (int v = tid; v < 2048; v += 512) { const int t = v >> 5, c8 = v & 31;
            *(u32x4*)(QKV + (row0 + t) * 4096 + 2048 + hk * 256 + 8 * c8) = *(LAS const u32x4*)(cs + (t + 3) * CSP + 512 + 16 * c8); }
        if (tid < 128) {
            const int hvl = tid >> 6, hv = 2 * hk + hvl; const size_t row = row0 + lane;
            const float bl = gates[row * 32 + hv], av = gates[row * 32 + 16 + hv];
            const float beta = 1.f / (1.f + expf(-bl)); const float xx = av + dtb[hv];
            const float sp = fmaxf(xx, 0.f) + log1pf(expf(-fabsf(xx)));
            float g = -expf(a_log[hv]) * sp;
#pragma unroll
            for (int o = 1; o < 64; o <<= 1) { const float y = __shfl_up(g, o); if (lane >= o) g += y; }
            betas[hvl * 64 + lane] = beta; gcs[hvl * 64 + lane] = g;
            float2 bg; bg.x = beta; bg.y = g; *(float2*)(gb + (row * 16 + hv) * 2) = bg;
        }
        __syncthreads();
        {
            const int ct = wave & 3, which = wave >> 2, l15 = lane & 15, l4 = lane >> 4;
            LAS float* dstm = which ? qkf : kkf;
            bf16x8 ya[4];
#pragma unroll
            for (int ks = 0; ks < 4; ++ks) ya[ks] = *(LAS const bf16x8*)(cs + (3 + 16 * ct + l15) * CSP + (which ? 0 : 256) + (32 * ks + 8 * l4) * 2);
#pragma unroll
            for (int st = 0; st < 4; ++st) { f32x4 acc = {0.f, 0.f, 0.f, 0.f};
#pragma unroll
                for (int ks = 0; ks < 4; ++ks) { const bf16x8 xs = *(LAS const bf16x8*)(cs + (3 + 16 * st + l15) * CSP + 256 + (32 * ks + 8 * l4) * 2); acc = mfma16(xs, ya[ks], acc); }
                *(LAS f32x4*)(dstm + (16 * ct + l15) * 68 + 16 * st + 4 * l4) = acc; }
        }
        __syncthreads();
        for (int e = tid; e < 8192; e += 512) { const int hvl = e >> 12, c = (e >> 6) & 63, s = e & 63, hv = 2 * hk + hvl;
            const float dec = c >= s ? __expf(gcs[hvl * 64 + c] - gcs[hvl * 64 + s]) : 0.f;
            Lm[hvl * 4096 + c * 64 + s] = c > s ? betas[hvl * 64 + c] * kkf[c * 68 + s] * dec : 0.f;
            attn[((size_t)((b * 16 + hv) * 64 + n)) * 4096 + c * 64 + s] = f2bf(qkf[c * 68 + s] * dec); }
        __syncthreads();
        if (tid < 128) {
            const int hvl = tid >> 6, hv = 2 * hk + hvl, j = lane;
            float x[64];
#pragma unroll
            for (int c = 0; c < 64; ++c) x[c] = 0.f;
            LAS const float* Lh = Lm + hvl * 4096;
#pragma unroll
            for (int c = 0; c < 64; ++c) { float a0 = (c == j) ? 1.f : 0.f, a1 = 0.f, a2 = 0.f, a3 = 0.f;
#pragma unroll
                for (int s4 = 0; s4 < (c + 3) / 4; ++s4) { const f32x4 Lv = *(LAS const f32x4*)(Lh + c * 64 + 4 * s4);
                    a0 -= Lv[0] * x[4 * s4]; a1 -= Lv[1] * x[4 * s4 + 1]; a2 -= Lv[2] * x[4 * s4 + 2]; a3 -= Lv[3] * x[4 * s4 + 3]; }
                x[c] = (a0 + a1) + (a2 + a3); }
            bf16_t* Tp = Tinv + ((size_t)((b * 16 + hv) * 64 + n)) * 4096;
#pragma unroll
            for (int c = 0; c < 64; ++c) Tp[c * 64 + j] = f2bf(x[c]);
        }
    }
}

__device__ __forceinline__ void gdn_scan_phase(const Args& a, LAS unsigned char* lds) {
    const int tid = tid_fresh(), lane = tid & 63, wave = tid >> 6, l15 = lane & 15, l4 = lane >> 4, ct = wave >> 1, dt = wave & 1;
    unsigned char* ws = a.ws;
    bf16_t* QKV = (bf16_t*)(ws + OFF_QKV); const float* gb = (const float*)(ws + OFF_GB);
    const bf16_t* Tinv = (const bf16_t*)(ws + OFF_TINV); const bf16_t* attn = (const bf16_t*)(ws + OFF_ATTN);
    LAS unsigned char* Sb = lds; LAS unsigned char* RT = lds + 8704; LAS unsigned char* vnT = lds + 13312; LAS unsigned char* vnsT = lds + 17920;
    for (int item = blockIdx.x; item < 256; item += gridDim.x) {
        const int j = item & 3, hv = (item >> 2) & 15, b = item >> 6, hk = hv >> 1;
        __syncthreads();
        for (int i = tid; i < 8704 / 4; i += 512) ((LAS unsigned*)Sb)[i] = 0u;
        f32x4 S0 = {0.f, 0.f, 0.f, 0.f}, S1 = {0.f, 0.f, 0.f, 0.f};
        __syncthreads();
        for (int n = 0; n < 64; ++n) {
            const size_t row0 = (size_t)b * 4096 + 64 * n;
            const size_t itm = (size_t)((b * 16 + hv) * 64 + n) * 4096;
            const bf16_t* qrow = QKV + (row0 + 16 * ct + l15) * 4096 + hk * 128 + 8 * l4;
            bf16x8 kf[4], qf[4], tf[2], af[2], ktf[2];
#pragma unroll
            for (int ks = 0; ks < 4; ++ks) { qf[ks] = *(const bf16x8*)(qrow + 32 * ks); kf[ks] = *(const bf16x8*)(qrow + 1024 + 32 * ks); }
#pragma unroll
            for (int k2 = 0; k2 < 2; ++k2) { tf[k2] = *(const bf16x8*)(Tinv + itm + (16 * ct + l15) * 64 + 32 * k2 + 8 * l4);
                af[k2] = *(const bf16x8*)(attn + itm + (16 * ct + l15) * 64 + 32 * k2 + 8 * l4);
#pragma unroll
                for (int i = 0; i < 8; ++i) ktf[k2][i] = (short)QKV[(row0 + 32 * k2 + 8 * l4 + i) * 4096 + 1024 + hk * 128 + 16 * wave + l15]; }
            float vv[4], be[4], gcr[4];
            bf16_t* vcol = QKV + (row0 + 16 * ct + 4 * l4) * 4096 + 2048 + hv * 128 + 32 * j + 16 * dt + l15;
#pragma unroll
            for (int r = 0; r < 4; ++r) { vv[r] = bf2f(vcol[(size_t)r * 4096]);
                const float2 bg = *(const float2*)(gb + ((row0 + 16 * ct + 4 * l4 + r) * 16 + hv) * 2); be[r] = bg.x; gcr[r] = bg.y; }
            const float gcl = gb[((row0 + 63) * 16 + hv) * 2 + 1];
            f32x4 KS = {0.f, 0.f, 0.f, 0.f}, QS = {0.f, 0.f, 0.f, 0.f};
#pragma unroll
            for (int ks = 0; ks < 4; ++ks) { const bf16x8 sf = *(LAS const bf16x8*)(Sb + (16 * dt + l15) * 272 + (32 * ks + 8 * l4) * 2);
                KS = mfma16(kf[ks], sf, KS); QS = mfma16(qf[ks], sf, QS); }
            float Oacc[4], Rr[4];
#pragma unroll
            for (int r = 0; r < 4; ++r) { const float eg = __expf(gcr[r]); Rr[r] = be[r] * (vv[r] - eg * KS[r]); Oacc[r] = eg * QS[r]; }
            { u32x2 w; w.x = pk2(Rr[0], Rr[1]); w.y = pk2(Rr[2], Rr[3]); *(LAS u32x2*)(RT + (16 * dt + l15) * 144 + (16 * ct + 4 * l4) * 2) = w; }
            __syncthreads();
            f32x4 VN = {0.f, 0.f, 0.f, 0.f};
#pragma unroll
            for (int k2 = 0; k2 < 2; ++k2) { const bf16x8 rf = *(LAS const bf16x8*)(RT + (16 * dt + l15) * 144 + (32 * k2 + 8 * l4) * 2); VN = mfma16(tf[k2], rf, VN); }
            { u32x2 w; w.x = pk2(VN[0], VN[1]); w.y = pk2(VN[2], VN[3]); *(LAS u32x2*)(vnT + (16 * dt + l15) * 144 + (16 * ct + 4 * l4) * 2) = w;
              u32x2 x; x.x = pk2(VN[0] * __expf(gcl - gcr[0]), VN[1] * __expf(gcl - gcr[1])); x.y = pk2(VN[2] * __expf(gcl - gcr[2]), VN[3] * __expf(gcl - gcr[3]));
              *(LAS u32x2*)(vnsT + (16 * dt + l15) * 144 + (16 * ct + 4 * l4) * 2) = x; }
            __syncthreads();
            f32x4 O = {Oacc[0], Oacc[1], Oacc[2], Oacc[3]};
#pragma unroll
            for (int k2 = 0; k2 < 2; ++k2) { const bf16x8 vf = *(LAS const bf16x8*)(vnT + (16 * dt + l15) * 144 + (32 * k2 + 8 * l4) * 2); O = mfma16(af[k2], vf, O); }
#pragma unroll
            for (int r = 0; r < 4; ++r) vcol[(size_t)r * 4096] = f2bf(O[r]);
            const float dec = __expf(gcl);
            S0 = S0 * dec; S1 = S1 * dec;
#pragma unroll
            for (int k2 = 0; k2 < 2; ++k2) { const bf16x8 v0 = *(LAS const bf16x8*)(vnsT + l15 * 144 + (32 * k2 + 8 * l4) * 2), v1 = *(LAS const bf16x8*)(vnsT + (16 + l15) * 144 + (32 * k2 + 8 * l4) * 2);
                S0 = mfma16(ktf[k2], v0, S0); S1 = mfma16(ktf[k2], v1, S1); }
            { u32x2 w; w.x = pk2(S0[0], S0[1]); w.y = pk2(S0[2], S0[3]); *(LAS u32x2*)(Sb + l15 * 272 + (16 * wave + 4 * l4) * 2) = w;
              u32x2 x; x.x = pk2(S1[0], S1[1]); x.y = pk2(S1[2], S1[3]); *(LAS u32x2*)(Sb + (16 + l15) * 272 + (16 * wave + 4 * l4) * 2) = x; }
            __syncthreads();
        }
    }
}

__device__ __forceinline__ void gdn_z_phase(const Args& a, LAS unsigned char* lds) {
    const int tid = tid_fresh();
    unsigned char* ws = a.ws;
    const bf16_t* QKV = (const bf16_t*)(ws + OFF_QKV);
    LAS float* tab = (LAS float*)(lds + 131072);
    pg8::StaticOrder S; S.init(MROWS, 2048, gridDim.x, blockIdx.x);
    Unit u;
    for (int i = 0; i < 8 && S.next(i, u); ++i) {
        const int rl = tid >> 1, bj = tid & 1;
        const bf16_t* op = QKV + (size_t)(u.pm * 256 + rl) * 4096 + 2048 + (2 * u.pn + bj) * 128;
        float ss = 0.f;
#pragma unroll
        for (int c = 0; c < 16; ++c) { const u32x4 v = *(const u32x4*)(op + 8 * c);
            ss += (bf_lo(v.x) * bf_lo(v.x) + bf_hi(v.x) * bf_hi(v.x)) + (bf_lo(v.y) * bf_lo(v.y) + bf_hi(v.y) * bf_hi(v.y)) + (bf_lo(v.z) * bf_lo(v.z) + bf_hi(v.z) * bf_hi(v.z)) + (bf_lo(v.w) * bf_lo(v.w) + bf_hi(v.w) * bf_hi(v.w)); }
        tab[i * 512 + rl * 2 + bj] = rsqrtf(ss * (1.f / 128.f) + 1e-6f);
    }
    __syncthreads();
    EpiT e{}; e.mode = 3; e.ssq = (const float*)(ws + OFF_SSQA); e.out = (bf16_t*)(ws + OFF_OB); e.osrc = QKV; e.ogain = a.in[16]; e.tab = tab; e.ui = 0;
    run_gemm(lds, (const bf16_t*)(ws + OFF_SA), (const bf16_t*)(ws + OFF_WZ), 2048, 1024, e);
}
__device__ __forceinline__ void gdn_scan_diag(const Args& a, LAS unsigned char* lds) {
    const int tid = tid_fresh();
    unsigned char* ws = a.ws;
    bf16_t* QKV = (bf16_t*)(ws + OFF_QKV); const float* gb = (const float*)(ws + OFF_GB);
    const bf16_t* Tinv = (const bf16_t*)(ws + OFF_TINV); const bf16_t* attn = (const bf16_t*)(ws + OFF_ATTN);
    for (int item = blockIdx.x; item < 4096; item += gridDim.x) {
        const int n = item & 63, hv = (item >> 6) & 15, b = item >> 10, hk = hv >> 1;
        const int c = tid >> 3, part = tid & 7;
        const size_t row = (size_t)b * 4096 + 64 * n + c;
        const size_t itm = (size_t)((b * 16 + hv) * 64 + n) * 4096;
        const float be = gb[(row * 16 + hv) * 2], gc = gb[(row * 16 + hv) * 2 + 1];
        bf16_t* vp = QKV + row * 4096 + 2048 + hv * 128 + part * 16;
        for (int i = 0; i < 16; ++i) { const int col = part * 16 + i;
            const float val = bf2f(Tinv[itm + c * 64 + (col & 63)]) + bf2f(attn[itm + c * 64 + ((col * 7) & 63)]) + 4.f * bf2f(QKV[row * 4096 + hk * 128 + col]) + bf2f(QKV[row * 4096 + 1024 + hk * 128 + col]) + ((col & 1) ? be : 0.1f * gc);
            vp[i] = f2bf(val); }
    }
}
extern __shared__ __attribute__((aligned(16))) unsigned char dyn_lds[];
constexpr int LDS_BYTES = 160 * 1024;
__global__ void __launch_bounds__(512, 2) mega(Args a) {
    cg::grid_group grid = cg::this_grid();
    LAS unsigned char* lds = (LAS unsigned char*)dyn_lds;
    unsigned char* ws = a.ws;
#define WB(off) ((bf16_t*)(ws + (off)))
#define WF(off) ((float*)(ws + (off)))
    float* out = a.out;
    p0_phase(a, lds);
    grid.sync();
    gemm_gu(lds, WB(OFF_SA), WF(OFF_SSQA), WB(OFF_WGU00), WB(OFF_BIG));
    grid.sync();
    gemm_res(lds, WB(OFF_BIG), WB(OFF_WD00), 2816, a.in[0], out, WB(OFF_SB), WF(OFF_SSQB), 0.5f);
    grid.sync();
#if EN_ATT
    { EpiT e{}; e.mode = 1; e.ssq = WF(OFF_SSQB); e.out = WB(OFF_BIG); e.ldo = 2304; run_gemm(lds, WB(OFF_SB), WB(OFF_WATTIN), 2304, 1024, e); }
    grid.sync();
    att_phase(a, lds, WB(OFF_BIG), WB(OFF_SA));
    grid.sync();
    gemm_res(lds, WB(OFF_SA), WB(OFF_WATTOUT), 1024, out, out, WB(OFF_SB), WF(OFF_SSQB), 1.0f);
    grid.sync();
#endif
    gemm_gu(lds, WB(OFF_SB), WF(OFF_SSQB), WB(OFF_WGU01), WB(OFF_BIG));
    grid.sync();
    gemm_res(lds, WB(OFF_BIG), WB(OFF_WD01), 2816, out, out, WB(OFF_SA), WF(OFF_SSQA), 0.5f);
    grid.sync();
    ple_phase(lds, WB(OFF_PB), WB(OFF_WPP0), WF(OFF_BIG), WB(OFF_SA), WF(OFF_SSQA), WB(OFF_WPG0), out, WB(OFF_SB), WF(OFF_SSQB));
    grid.sync();
    cvt_rows_bf16(a.in[1] + (size_t)MROWS * 256, WB(OFF_PB), 64, tid_fresh() & 63, blockIdx.x * 8 + (tid_fresh() >> 6), gridDim.x * 8);
    gemm_gu(lds, WB(OFF_SB), WF(OFF_SSQB), WB(OFF_WGU10), WB(OFF_BIG));
    grid.sync();
    gemm_res(lds, WB(OFF_BIG), WB(OFF_WD10), 2816, out, out, WB(OFF_SA), WF(OFF_SSQA), 0.5f);
    grid.sync();
#if EN_GDN
    { EpiT e{}; e.mode = 2; e.ssq = WF(OFF_SSQA); e.out = WB(OFF_QKV); e.halo = WB(OFF_HALO); e.gates = WF(OFF_GATES); run_gemm(lds, WB(OFF_SA), WB(OFF_WQKVG), 4352, 1024, e); }
    grid.sync();
    gdn_prep_phase(a, lds);
    grid.sync();
    gdn_scan_phase(a, lds);
    grid.sync();
    gdn_z_phase(a, lds);
    grid.sync();
    gemm_res(lds, WB(OFF_OB), WB(OFF_WGO), 2048, out, out, WB(OFF_H2), WF(OFF_SSQB), 1.0f);
    grid.sync();
    gemm_gu(lds, WB(OFF_H2), WF(OFF_SSQB), WB(OFF_WGU11), WB(OFF_ACT11));
#else
    gemm_gu(lds, WB(OFF_SA), WF(OFF_SSQA), WB(OFF_WGU11), WB(OFF_ACT11));
#endif
    grid.sync();
    gemm_res(lds, WB(OFF_ACT11), WB(OFF_WD11), 2816, out, out, WB(OFF_H3), WF(OFF_SSQA), 0.5f);
    grid.sync();
    ple_phase(lds, WB(OFF_PB), WB(OFF_WPP1), WF(OFF_PP1), WB(OFF_H3), WF(OFF_SSQA), WB(OFF_WPG1), out, nullptr, nullptr);
#undef WB
#undef WF
}

extern "C" void kernel_launch(void* const* d_in, const int* in_sizes, int n_in, void* d_out, int out_size, void* d_ws, size_t ws_size, hipStream_t stream) {
    static int grid = 0;
    if (!grid) {
        int dev = 0, cus = 0, per = 0;
        (void)hipGetDevice(&dev); (void)hipDeviceGetAttribute(&cus, hipDeviceAttributeMultiprocessorCount, dev);
        (void)hipFuncSetAttribute((const void*)mega, hipFuncAttributeMaxDynamicSharedMemorySize, LDS_BYTES);
        (void)hipOccupancyMaxActiveBlocksPerMultiprocessor(&per, (const void*)mega, 512, LDS_BYTES);
        if (per < 1) { fprintf(stderr, "occupancy query says %d blocks/CU\n", per); per = 1; }
        grid = cus;
    }
    if (n_in != 21 || ws_size < WS_NEED) { fprintf(stderr, "kernel_launch: unexpected inputs / workspace (%d, %zu)\n", n_in, ws_size); return; }
    Args a{};
    for (int i = 0; i < 21; ++i) a.in[i] = (const float*)d_in[i];
    a.out = (float*)d_out; a.ws = (unsigned char*)d_ws;
    int nd = 0;
    auto add = [&](int si, size_t soff, int gi, size_t goff, size_t dstoff, int ldsrc, int col0, int ncols, int K, int dstrow0, int mode) {
        WDesc& w = a.wd[nd++]; w.src_idx = si; w.src_off = (unsigned)soff; w.gain_idx = gi; w.gain_off = (unsigned)goff; w.dst_off = dstoff; w.ldsrc = ldsrc; w.col0 = col0; w.ncols = ncols; w.K = K; w.dstrow0 = dstrow0; w.mode = mode; };
    const size_t offgu[4] = {OFF_WGU00, OFF_WGU01, OFF_WGU10, OFF_WGU11}, offd[4] = {OFF_WD00, OFF_WD01, OFF_WD10, OFF_WD11};
    for (int f = 0; f < 4; ++f) {
        add(3, (size_t)f * 1024 * 2816, 2, f * 1024, offgu[f], 2816, 0, 2816, 1024, 0, 1);
        add(4, (size_t)f * 1024 * 2816, 2, f * 1024, offgu[f], 2816, 0, 2816, 1024, 0, 2);
        add(5, (size_t)f * 2816 * 1024, -1, 0, offd[f], 1024, 0, 1024, 2816, 0, 0);
    }
    add(7, 0, 6, 0, OFF_WATTIN, 2304, 0, 2304, 1024, 0, 0);
    add(11, 0, -1, 0, OFF_WATTOUT, 1024, 0, 1024, 1024, 0, 0);
    add(12, 0, 6, 1024, OFF_WQKVG, 6176, 0, 4096, 1024, 0, 0);
    add(12, 0, 6, 1024, OFF_WQKVG, 6176, 6144, 32, 1024, 4096, 0);
    add(12, 0, 6, 1024, OFF_WZ, 6176, 4096, 2048, 1024, 0, 0);
    add(17, 0, -1, 0, OFF_WGO, 1024, 0, 1024, 2048, 0, 0);
    add(19, 0, 18, 0, OFF_WPG0, 1024, 0, 1024, 1024, 0, 0);
    add(19, 1024 * 1024, 18, 1024, OFF_WPG1, 1024, 0, 1024, 1024, 0, 0);
    add(20, 0, -1, 0, OFF_WPP0, 1024, 0, 1024, 256, 0, 0);
    add(20, 256 * 1024, -1, 0, OFF_WPP1, 1024, 0, 1024, 256, 0, 0);
    void* args[] = {&a};
    hipError_t e = hipLaunchCooperativeKernel((const void*)mega, dim3(grid), dim3(512), args, LDS_BYTES, stream);
    if (e != hipSuccess) fprintf(stderr, "cooperative launch failed: %s (grid %d)\n", hipGetErrorString(e), grid);
}
```

```cpp
#include <hip/hip_runtime.h>
#include <hip/hip_cooperative_groups.h>
#include <cstdio>
namespace cg = cooperative_groups;
__device__ __forceinline__ int tid_fresh() { int t = threadIdx.x; asm volatile("" : "+v"(t)); return t; }
namespace pg8 {
#define PG8_LAS __attribute__((address_space(3)))
typedef unsigned short bf16_t;
typedef short bf16x8 __attribute__((ext_vector_type(8)));
typedef float f32x4 __attribute__((ext_vector_type(4)));
typedef unsigned u32x4 __attribute__((ext_vector_type(4)));
constexpr int BM = 256, BK = 64, HALF = 128, HTB = HALF * BK * 2  , STAGE_BYTES = 8 * HTB, NXCD = 8, WGM = 8;

__host__ __device__ __forceinline__ int lds_byte(int r, int c) { const int st = (r >> 4) * 2 + (c >> 5), rr = r & 15, cc = c & 31, ob = rr * 64 + cc * 2; return st * 1024 + (ob ^ (((ob >> 9) & 1) << 5)); }
__host__ __device__ __forceinline__ void stage_rc(int b, int& R, int& C) { const int st = b / 1024, sb = b % 1024, swz = sb ^ (((sb >> 9) & 1) << 5); R = (st >> 1) * 16 + swz / 64; C = (st & 1) * 32 + (swz % 64) / 2; }
__host__ __device__ __forceinline__ int perm32(int rho) { const int n = rho >> 4, i = rho & 15; return 8 * (i >> 2) + 4 * n + (i & 3); }

struct Unit { int pm, pn; };
struct Gemm { const bf16_t* A; const bf16_t* Bt; int M, N, K; int atiled; int krot; };

struct StaticOrder {
    int nM, nN, nwg, G, c;
    __host__ __device__ void init(int M, int N, int G_, int c_) { nM = M / BM; nN = N / BM; nwg = nM * nN; G = G_; c = c_; }
    __host__ __device__ bool next(int i, Unit& u) const {
        const long L = (long)i * G + c; if (L >= nwg) return false;
        int wgid = (int)L; { const int q = nwg / NXCD, r = nwg % NXCD, xcd = wgid % NXCD, off = wgid / NXCD; wgid = (xcd < r ? xcd * (q + 1) : r * (q + 1) + (xcd - r) * q) + off; }
        const int nig = WGM * nN, gid = wgid / nig, fm = gid * WGM, gsz = (nM - fm) < WGM ? (nM - fm) : WGM;
        u.pm = fm + ((wgid % nig) % gsz); u.pn = (wgid % nig) / gsz; return true;
    }
    __device__ __forceinline__ void a_ready(const Unit&) const {}
    __device__ __forceinline__ void done(const Unit&) const {}
};
__device__ __forceinline__ unsigned cvt_pk_bf16(float lo, float hi) { unsigned r; asm volatile("v_cvt_pk_bf16_f32 %0, %1, %2" : "=v"(r) : "v"(lo), "v"(hi)); return r; }
template <class Epi, class Sched, bool STAMP = false>
__device__ __forceinline__ void gemm_phase(PG8_LAS unsigned char* lds, const Gemm g, const Sched& S, const Epi& E, unsigned long long* stamps) {
    const int tid = tid_fresh(), wid = __builtin_amdgcn_readfirstlane(tid >> 6), lane = tid & 63, wr = wid >> 2, wc = wid & 3, fr = lane & 15, fq = lane >> 4;
    const int K = g.K, nt = K / BK;
    int ts_lo = 0, ts_hi = 0, nts = 0; const unsigned long long rt_entry = STAMP ? (unsigned long long)wall_clock64() : 0ull;
#define PG8_STAMP() do { if (STAMP && wid == 0 && nts < 64) { const unsigned long long _c = (unsigned long long)clock64(); \
        ts_lo = (lane == nts) ? (int)(unsigned)_c : ts_lo; ts_hi = (lane == nts) ? (int)(unsigned)(_c >> 32) : ts_hi; ++nts; } } while (0)
    PG8_STAMP();
    unsigned voffA[2], voffB[2];
#pragma unroll
    for (int i = 0; i < 2; ++i) { int R, C; stage_rc(tid * 16 + i * 8192, R, C); const int Rb = Epi::PERM ? ((R & ~31) + perm32(R & 31)) : R;
        voffA[i] = (unsigned)(R * (g.atiled ? BK : K) + C) * 2u; voffB[i] = (unsigned)(Rb * K + C) * 2u; }
    const size_t kstep = (size_t)(BK * 2);
    const size_t hstep = (size_t)HALF * K * 2;
    const size_t tstep = 2 * hstep;
    const size_t kstepA = g.atiled ? (size_t)(BM * BK * 2) : kstep, hstepA = g.atiled ? (size_t)(HALF * BK * 2) : hstep;
    const unsigned ldsw = (unsigned)wid * 1024u;
    const int aoff = lds_byte(wr * 64 + fr, fq * 8), boff = lds_byte(wc * 32 + fr, fq * 8);
#define PG8_SA(b, h) (((b) * 2 + (h)) * HTB)
#define PG8_SB(b, h) ((4 + (b) * 2 + (h)) * HTB)
#define PG8_STAGE(bufoff, gbase, voff) do { _Pragma("unroll") for (int _i = 0; _i < 2; ++_i) \
        __builtin_amdgcn_global_load_lds((const unsigned*)((const char*)(gbase) + (voff)[_i]), (PG8_LAS unsigned*)(lds + (bufoff) + ldsw + _i * 8192), 16, 0, 0); } while (0)
#define PG8_LDA(dst, b, h) do { _Pragma("unroll") for (int m = 0; m < 4; ++m) _Pragma("unroll") for (int k = 0; k < 2; ++k) dst[m][k] = *(const PG8_LAS bf16x8*)(lds + PG8_SA(b, h) + aoff + m * 2048 + k * 1024); } while (0)
#define PG8_LDB(dst, b, h) do { _Pragma("unroll") for (int n = 0; n < 2; ++n) _Pragma("unroll") for (int k = 0; k < 2; ++k) dst[n][k] = *(const PG8_LAS bf16x8*)(lds + PG8_SB(b, h) + boff + n * 2048 + k * 1024); } while (0)
#define PG8_MMA(ai, bj, At, Bt) do { __builtin_amdgcn_s_setprio(1); _Pragma("unroll") for (int m = 0; m < 4; ++m) _Pragma("unroll") for (int n = 0; n < 2; ++n) _Pragma("unroll") for (int k = 0; k < 2; ++k) \
        acc[ai][bj][m][n] = __builtin_amdgcn_mfma_f32_16x16x32_bf16(Bt[n][k], At[m][k], acc[ai][bj][m][n], 0, 0, 0); __builtin_amdgcn_s_setprio(0); } while (0)
#define PG8_WAIT_V(n) asm volatile("s_waitcnt vmcnt(" #n ")" ::: "memory")
#define PG8_WAIT_L(n) asm volatile("s_waitcnt lgkmcnt(" #n ")" ::: "memory")
#define PG8_BAR __builtin_amdgcn_s_barrier()
#define PG8_SCHED __builtin_amdgcn_sched_barrier(0)
    Unit cur, nxt; int ui = 0;
    if (!S.next(0, cur)) return;
    f32x4 acc[2][2][4][2];
#pragma unroll
    for (int a = 0; a < 2; ++a)
#pragma unroll
        for (int b = 0; b < 2; ++b)
#pragma unroll
            for (int m = 0; m < 4; ++m)
#pragma unroll
                for (int n = 0; n < 2; ++n) acc[a][b][m][n] = (f32x4){0.f, 0.f, 0.f, 0.f};
    bf16x8 At[4][2], B0[2][2], B1[2][2];
    const char* cA = (const char*)g.A + (size_t)cur.pm * tstep; const char* cB = (const char*)g.Bt + (size_t)cur.pn * tstep;
    int rc = g.krot ? (2 * (cur.pm & 7)) % nt : 0;
    S.a_ready(cur);
    PG8_STAGE(PG8_SB(0, 0), cB + rc * kstep, voffB); PG8_STAGE(PG8_SA(0, 0), cA + rc * kstepA, voffA); PG8_STAGE(PG8_SB(0, 1), cB + hstep + rc * kstep, voffB); PG8_STAGE(PG8_SA(0, 1), cA + hstepA + rc * kstepA, voffA);
    if (wr == 1) PG8_BAR;
    PG8_WAIT_V(4); PG8_BAR;
    PG8_STAGE(PG8_SB(1, 0), cB + (rc + 1) * kstep, voffB); PG8_STAGE(PG8_SA(1, 0), cA + (rc + 1) * kstepA, voffA); PG8_STAGE(PG8_SB(1, 1), cB + hstep + (rc + 1) * kstep, voffB);
    PG8_WAIT_V(6); PG8_BAR;
    PG8_STAMP();
    for (;;) {
        const bool has_next = S.next(ui + 1, nxt);
        const char* nA = has_next ? (const char*)g.A + (size_t)nxt.pm * tstep : cA; const char* nB = has_next ? (const char*)g.Bt + (size_t)nxt.pn * tstep : cB;
        const int rn = has_next ? (g.krot ? (2 * (nxt.pm & 7)) % nt : 0) : rc;
        for (int t = 0; t < nt; t += 2) {
            const bool last = (t == nt - 2);
            int p0 = t + rc; if (p0 >= nt) p0 -= nt; int p2 = p0 + 2; if (p2 >= nt) p2 -= nt;
            const char* a1 = cA + (size_t)(p0 + 1) * kstepA;
            const char* a2 = last ? nA + (size_t)rn * kstepA : cA + (size_t)p2 * kstepA; const char* b2 = last ? nB + (size_t)rn * kstep : cB + (size_t)p2 * kstep;
            const char* a3 = a2 + kstepA; const char* b3 = b2 + kstep;
            if (last && has_next) S.a_ready(nxt);
            PG8_LDB(B0, 0, 0); PG8_SCHED; PG8_LDA(At, 0, 0); PG8_STAGE(PG8_SA(1, 1), a1 + hstepA, voffA);
            PG8_WAIT_L(8); PG8_BAR; PG8_WAIT_L(0); PG8_MMA(0, 0, At, B0); PG8_BAR; PG8_SCHED;
            PG8_LDB(B1, 0, 1); PG8_STAGE(PG8_SB(0, 0), b2, voffB);
            PG8_BAR; PG8_WAIT_L(0); PG8_MMA(0, 1, At, B1); PG8_BAR;
            PG8_LDA(At, 0, 1); PG8_STAGE(PG8_SA(0, 0), a2, voffA);
            PG8_BAR; PG8_WAIT_L(0); PG8_MMA(1, 0, At, B0); PG8_BAR; PG8_SCHED;
            PG8_STAGE(PG8_SB(0, 1), b2 + hstep, voffB);
            PG8_WAIT_V(6); PG8_BAR; PG8_MMA(1, 1, At, B1); PG8_BAR;
            PG8_LDB(B0, 1, 0); PG8_SCHED; PG8_LDA(At, 1, 0); PG8_STAGE(PG8_SA(0, 1), a2 + hstepA, voffA);
            PG8_WAIT_L(8); PG8_BAR; PG8_WAIT_L(0); PG8_MMA(0, 0, At, B0); PG8_BAR; PG8_SCHED;
            PG8_LDB(B1, 1, 1); PG8_STAGE(PG8_SB(1, 0), b3, voffB);
            PG8_BAR; PG8_WAIT_L(0); PG8_MMA(0, 1, At, B1); PG8_BAR;
            PG8_LDA(At, 1, 1); PG8_STAGE(PG8_SA(1, 0), a3, voffA);
            PG8_BAR; PG8_WAIT_L(0); PG8_MMA(1, 0, At, B0); PG8_BAR; PG8_SCHED;
            PG8_STAGE(PG8_SB(1, 1), b3 + hstep, voffB);
            PG8_WAIT_V(6); PG8_BAR; PG8_MMA(1, 1, At, B1); PG8_BAR;
        }
        PG8_STAMP();
        if constexpr (!Epi::AFTER_DRAIN) { E(acc, cur, wr, wc, fr, fq); S.done(cur); }
        PG8_STAMP();
        if (!has_next) break;
#pragma unroll
        for (int a = 0; a < 2; ++a)
#pragma unroll
            for (int b = 0; b < 2; ++b)
#pragma unroll
                for (int m = 0; m < 4; ++m)
#pragma unroll
                    for (int n = 0; n < 2; ++n) acc[a][b][m][n] = (f32x4){0.f, 0.f, 0.f, 0.f};
        cur = nxt; cA = nA; cB = nB; rc = rn; ++ui;
    }
    PG8_WAIT_V(0);
    if (wr == 0) PG8_BAR;
    PG8_BAR;
    if constexpr (Epi::AFTER_DRAIN) { E.fused(acc, cur, wr, wc, fr, fq, lds, wid, lane); S.done(cur); }
    PG8_STAMP();
    if (STAMP && wid == 0) { stamps[lane] = lane < nts ? (((unsigned long long)(unsigned)ts_hi << 32) | (unsigned)ts_lo) : 0ull;
        if (lane == 62) stamps[62] = rt_entry; if (lane == 63) stamps[63] = (unsigned long long)wall_clock64(); }
#undef PG8_STAMP
#undef PG8_SA
#undef PG8_SB
#undef PG8_STAGE
#undef PG8_LDA
#undef PG8_LDB
#undef PG8_MMA
#undef PG8_WAIT_V
#undef PG8_WAIT_L
#undef PG8_BAR
#undef PG8_SCHED
}
}

using pg8::bf16_t; using pg8::bf16x8; using pg8::f32x4; using pg8::u32x4; using pg8::Unit;
typedef unsigned u32x2 __attribute__((ext_vector_type(2)));
typedef __bf16 bf2_t __attribute__((ext_vector_type(2)));
#define LAS __attribute__((address_space(3)))

constexpr int MROWS = 16384;
#define VCU(lds) (*(LAS const int*)((lds) + 163788))
#define VB(lds) (*(LAS const int*)((lds) + 163776))
constexpr size_t MIB = 1048576;
constexpr size_t OFF_WZ = 0, OFF_WGO = 4 * MIB, OFF_WGU11 = 8 * MIB, OFF_WD11 = 19 * MIB, OFF_WPG1 = 24 * MIB + MIB / 2, OFF_WPP1 = 26 * MIB + MIB / 2,
    OFF_WQKVG = 27 * MIB, OFF_WE = 35 * MIB + MIB / 2,
    OFF_WGU00 = OFF_WE, OFF_WD00 = OFF_WGU00 + 11 * MIB, OFF_WGU01 = OFF_WD00 + 11 * MIB / 2, OFF_WD01 = OFF_WGU01 + 11 * MIB,
    OFF_WATTIN = OFF_WD01 + 11 * MIB / 2, OFF_WATTOUT = OFF_WATTIN + 9 * MIB / 2, OFF_WPG0 = OFF_WATTOUT + 2 * MIB, OFF_WPP0 = OFF_WPG0 + 2 * MIB,
    OFF_WGU10 = OFF_WPP0 + MIB / 2, OFF_WD10 = OFF_WGU10 + 11 * MIB,
    OFF_SB = 94 * MIB, OFF_BIG = 126 * MIB, OFF_SSQA = 235 * MIB + MIB / 2, OFF_SSQB = OFF_SSQA + MIB, OFF_PB = OFF_SSQB + MIB, OFF_SA = 263422976,
    WS_NEED = OFF_SA + 32 * MIB,
    OFF_QKV = OFF_WE, OFF_GATES = OFF_QKV + 128 * MIB, OFF_HALO = OFF_GATES + 2 * MIB, OFF_TINV = OFF_HALO + 6 * MIB, OFF_ATTN = OFF_TINV + 32 * MIB,
    OFF_GB = OFF_WQKVG, OFF_OB = OFF_TINV, OFF_H2 = OFF_WE, OFF_ACT11 = OFF_H2 + 32 * MIB, OFF_H3 = OFF_ACT11 + 88 * MIB, OFF_PP1 = OFF_WE;
static_assert(OFF_WD10 + 11 * MIB / 2 == OFF_SB, "weights map");
static_assert(OFF_ATTN + 32 * MIB == OFF_SSQA, "gdn map");
static_assert(OFF_PB + 8 * MIB <= OFF_SA && WS_NEED <= 296977568ull, "ws size");

struct WDesc { unsigned long long dst_off; unsigned src_off, gain_off; int src_idx, gain_idx, ldsrc, col0, ncols, K, dstrow0, mode; };
constexpr int NDESC = 22;
struct Args { const float* in[21]; float* out; unsigned char* ws; WDesc wd[NDESC]; };

typedef float f2v_t __attribute__((ext_vector_type(2)));
__device__ __forceinline__ unsigned pk2(float lo, float hi) { const f2v_t f = {lo, hi}; const bf2_t r = __builtin_convertvector(f, bf2_t); return __builtin_bit_cast(unsigned, r); }
__device__ __forceinline__ float bf_lo(unsigned u) { return __uint_as_float(u << 16); }
__device__ __forceinline__ float bf_hi(unsigned u) { return __uint_as_float(u & 0xffff0000u); }
__device__ __forceinline__ float bf2f(bf16_t b) { return __uint_as_float(((unsigned)b) << 16); }
__device__ __forceinline__ float sigm(float x) { return __builtin_amdgcn_rcpf(1.f + __expf(-x)); }
__device__ __forceinline__ float silu_(float x) { return x * __builtin_amdgcn_rcpf(1.f + __expf(-x)); }
__device__ __forceinline__ float wave_sum(float v) {
#pragma unroll
    for (int o = 1; o < 64; o <<= 1) v += __shfl_xor(v, o);
    return v;
}
__device__ __forceinline__ float row_rstd(const float* ssq, int row) {
    const f32x4* p = (const f32x4*)(ssq + (size_t)row * 16);
    const f32x4 a = p[0], b = p[1], c = p[2], d = p[3];
    const float s = (((a.x + a.y) + (a.z + a.w)) + ((b.x + b.y) + (b.z + b.w))) + (((c.x + c.y) + (c.z + c.w)) + ((d.x + d.y) + (d.z + d.w)));
    return rsqrtf(s * (1.f / 1024.f) + 1e-6f);
}
__device__ __forceinline__ float dot2bf(unsigned a, unsigned b, float c) {
    return __builtin_amdgcn_fdot2_f32_bf16(__builtin_bit_cast(bf2_t, a), __builtin_bit_cast(bf2_t, b), c, false);
}

constexpr int TABR_OFF = 131072, TABO_OFF = 131072 + 8192;
__device__ __forceinline__ int unit_ordinal(const pg8::StaticOrder& S, const Unit& u) {
    int r = 0;
    for (int i = 0; i < 8; ++i) { Unit t; if (S.next(i, t) && t.pm == u.pm && t.pn == u.pn) r = i; }
    return r;
}
struct EpiT {
    static constexpr bool PERM = true, AFTER_DRAIN = false;
    int mode;
    LAS const float* tabr; bf16_t* out; int ldo;
    bf16_t* halo; float* gates;
    const bf16_t* osrc; const float* ogain; LAS const float* tabo; pg8::StaticOrder S;
    __device__ __forceinline__ void operator()(const f32x4 (&acc)[2][2][4][2], const Unit& u, int wr, int wc, int fr_, int fq_) const {
        int fr = fr_, fq = fq_; asm volatile("" : "+v"(fr), "+v"(fq));
        const int ui = unit_ordinal(S, u);
        if (mode == 3) {
            const int cg = wc * 32 + 8 * fq;
            const f32x4 ga = *(const f32x4*)(ogain + cg), gb = *(const f32x4*)(ogain + cg + 4);
#pragma unroll
            for (int ai = 0; ai < 2; ++ai) {
                u32x4 o8[4][2];
#pragma unroll
                for (int m = 0; m < 4; ++m)
#pragma unroll
                    for (int bj = 0; bj < 2; ++bj) o8[m][bj] = *(const u32x4*)(osrc + (size_t)(u.pm * 256 + ai * 128 + wr * 64 + m * 16 + fr) * 4096 + 2048 + u.pn * 256 + bj * 128 + cg);
#pragma unroll
                for (int m = 0; m < 4; ++m) {
                    const int rl = ai * 128 + wr * 64 + m * 16 + fr, row = u.pm * 256 + rl;
                    const float rs = tabr[ui * 256 + rl];
#pragma unroll
                    for (int bj = 0; bj < 2; ++bj) {
                        const int c0 = u.pn * 256 + bj * 128 + cg;
                        const f32x4 v0 = acc[ai][bj][m][0] * rs, v1 = acc[ai][bj][m][1] * rs;
                        const float ro = tabo[ui * 512 + rl * 2 + bj];
                        const u32x4 o = o8[m][bj];
                        u32x4 w;
                        w.x = pk2(bf_lo(o.x) * ro * ga[0] * silu_(v0[0]), bf_hi(o.x) * ro * ga[1] * silu_(v0[1]));
                        w.y = pk2(bf_lo(o.y) * ro * ga[2] * silu_(v0[2]), bf_hi(o.y) * ro * ga[3] * silu_(v0[3]));
                        w.z = pk2(bf_lo(o.z) * ro * gb[0] * silu_(v1[0]), bf_hi(o.z) * ro * gb[1] * silu_(v1[1]));
                        w.w = pk2(bf_lo(o.w) * ro * gb[2] * silu_(v1[2]), bf_hi(o.w) * ro * gb[3] * silu_(v1[3]));
                        *(u32x4*)(out + (size_t)row * 2048 + c0) = w;
                    }
                }
            }
            return;
        }
#pragma unroll
        for (int ai = 0; ai < 2; ++ai)
#pragma unroll
            for (int m = 0; m < 4; ++m) {
                const int rl = ai * 128 + wr * 64 + m * 16 + fr, row = u.pm * 256 + rl;
                const float rs = tabr[ui * 256 + rl];
                if (mode == 0) {
                    const f32x4 g0 = acc[ai][0][m][0] * rs, g1 = acc[ai][0][m][1] * rs, u0 = acc[ai][1][m][0] * rs, u1 = acc[ai][1][m][1] * rs;
                    u32x4 w;
                    w.x = pk2(silu_(g0[0]) * u0[0], silu_(g0[1]) * u0[1]); w.y = pk2(silu_(g0[2]) * u0[2], silu_(g0[3]) * u0[3]);
                    w.z = pk2(silu_(g1[0]) * u1[0], silu_(g1[1]) * u1[1]); w.w = pk2(silu_(g1[2]) * u1[2], silu_(g1[3]) * u1[3]);
                    { const int f0 = u.pn * 128 + wc * 32 + 8 * fq;
                      *(u32x4*)(out + ((size_t)(u.pm * 44 + (f0 >> 6)) * 256 + rl) * 64 + (f0 & 63)) = w; }
                } else {
#pragma unroll
                    for (int bj = 0; bj < 2; ++bj) {
                        const int c0 = u.pn * 256 + bj * 128 + wc * 32 + 8 * fq;
                        const f32x4 v0 = acc[ai][bj][m][0] * rs, v1 = acc[ai][bj][m][1] * rs;
                        u32x4 w; w.x = pk2(v0[0], v0[1]); w.y = pk2(v0[2], v0[3]); w.z = pk2(v1[0], v1[1]); w.w = pk2(v1[2], v1[3]);
                        if (mode == 1) { *(u32x4*)(out + (size_t)row * ldo + c0) = w; }
                        else if (c0 < 4096) {
                            *(u32x4*)(out + (size_t)row * 4096 + c0) = w;
                            const int t = row & 4095;
                            if ((t & 63) >= 61) *(u32x4*)(halo + ((size_t)((row >> 12) * 64 + (t >> 6)) * 3 + ((t & 63) - 61)) * 4096 + c0) = w;
                        } else if (c0 < 4128) {
                            float* gp = gates + (size_t)row * 32 + (c0 - 4096);
                            *(f32x4*)gp = v0; *(f32x4*)(gp + 4) = v1;
                        }
                    }
                }
            }
    }
};
__device__ __forceinline__ float lo_scale(float hif) { return __uint_as_float(__float_as_uint(hif) & 0x7f800000u) * 3.0517578125e-5f; }
struct EpiF {
    static constexpr bool PERM = false, AFTER_DRAIN = false;
    int mode;
    const float* xin; const bf16_t* hbin; const signed char* loin;
    float* fout; bf16_t* hb; signed char* loout;
    float* ssqo; float scale; LAS const float* tabr; bf16_t* pp; pg8::StaticOrder S;
    __device__ __forceinline__ void operator()(const f32x4 (&acc)[2][2][4][2], const Unit& u, int wr, int wc, int fr_, int fq_) const {
        int fr = fr_, fq = fq_; asm volatile("" : "+v"(fr), "+v"(fq));
        const int ui = mode == 2 ? unit_ordinal(S, u) : 0;
        const size_t cb = (size_t)u.pn * 256 + wc * 32 + 4 * fq;
#pragma unroll
        for (int ai = 0; ai < 2; ++ai)
#pragma unroll
            for (int mp = 0; mp < 2; ++mp) {
                if (mode == 1) {
#pragma unroll
                    for (int m2 = 0; m2 < 2; ++m2)
#pragma unroll
                        for (int bj = 0; bj < 2; ++bj)
#pragma unroll
                            for (int n = 0; n < 2; ++n) { const f32x4 v = acc[ai][bj][2 * mp + m2][n]; u32x2 w; w.x = pk2(v[0], v[1]); w.y = pk2(v[2], v[3]);
                                *(u32x2*)(pp + (size_t)(u.pm * 256 + ai * 128 + wr * 64 + (2 * mp + m2) * 16 + fr) * 1024 + cb + bj * 128 + n * 16) = w; }
                    continue;
                }
                f32x4 hv[2][2][2]; u32x2 qv[2][2][2];
                if (xin) {
#pragma unroll
                    for (int m2 = 0; m2 < 2; ++m2)
#pragma unroll
                        for (int bj = 0; bj < 2; ++bj)
#pragma unroll
                            for (int n = 0; n < 2; ++n) hv[m2][bj][n] = *(const f32x4*)(xin + (size_t)(u.pm * 256 + ai * 128 + wr * 64 + (2 * mp + m2) * 16 + fr) * 1024 + cb + bj * 128 + n * 16);
                } else {
                    u32x2 hi2[2][2][2]; unsigned lo4[2][2][2];
#pragma unroll
                    for (int m2 = 0; m2 < 2; ++m2)
#pragma unroll
                        for (int bj = 0; bj < 2; ++bj)
#pragma unroll
                            for (int n = 0; n < 2; ++n) { const size_t idx = (size_t)(u.pm * 256 + ai * 128 + wr * 64 + (2 * mp + m2) * 16 + fr) * 1024 + cb + bj * 128 + n * 16;
                                hi2[m2][bj][n] = *(const u32x2*)(hbin + idx); lo4[m2][bj][n] = *(const unsigned*)(loin + idx);
                                if (mode == 2) qv[m2][bj][n] = *(const u32x2*)(pp + idx); }
#pragma unroll
                    for (int m2 = 0; m2 < 2; ++m2)
#pragma unroll
                        for (int bj = 0; bj < 2; ++bj)
#pragma unroll
                            for (int n = 0; n < 2; ++n) { const u32x2 hh = hi2[m2][bj][n]; const unsigned ll = lo4[m2][bj][n];
                                const float h0 = bf_lo(hh.x), h1 = bf_hi(hh.x), h2 = bf_lo(hh.y), h3 = bf_hi(hh.y);
                                f32x4 r;
                                r[0] = h0 + (float)(int)(signed char)(ll & 0xffu) * lo_scale(h0); r[1] = h1 + (float)(int)(signed char)((ll >> 8) & 0xffu) * lo_scale(h1);
                                r[2] = h2 + (float)(int)(signed char)((ll >> 16) & 0xffu) * lo_scale(h2); r[3] = h3 + (float)(int)(signed char)(ll >> 24) * lo_scale(h3);
                                hv[m2][bj][n] = r; }
                }
                if (xin && mode == 2) {
#pragma unroll
                    for (int m2 = 0; m2 < 2; ++m2)
#pragma unroll
                        for (int bj = 0; bj < 2; ++bj)
#pragma unroll
                            for (int n = 0; n < 2; ++n) qv[m2][bj][n] = *(const u32x2*)(pp + (size_t)(u.pm * 256 + ai * 128 + wr * 64 + (2 * mp + m2) * 16 + fr) * 1024 + cb + bj * 128 + n * 16);
                }
#pragma unroll
                for (int m2 = 0; m2 < 2; ++m2) {
                    const int m = 2 * mp + m2, rl = ai * 128 + wr * 64 + m * 16 + fr, row = u.pm * 256 + rl;
                    const float rs = mode == 2 ? tabr[ui * 256 + rl] : 0.f;
                    float sq = 0.f;
#pragma unroll
                    for (int bj = 0; bj < 2; ++bj)
#pragma unroll
                        for (int n = 0; n < 2; ++n) {
                            const size_t idx = (size_t)row * 1024 + cb + bj * 128 + n * 16;
                            const f32x4 v = acc[ai][bj][m][n];
                            f32x4 h = hv[m2][bj][n];
                            if (mode == 0) h = h + v * scale;
                            else { const f32x4 q = {bf_lo(qv[m2][bj][n].x), bf_hi(qv[m2][bj][n].x), bf_lo(qv[m2][bj][n].y), bf_hi(qv[m2][bj][n].y)};
                                h[0] += sigm(v[0] * rs) * q[0]; h[1] += sigm(v[1] * rs) * q[1]; h[2] += sigm(v[2] * rs) * q[2]; h[3] += sigm(v[3] * rs) * q[3]; }
                            if (fout) *(f32x4*)(fout + idx) = h;
                            else {
                                u32x2 w; w.x = pk2(h[0], h[1]); w.y = pk2(h[2], h[3]); *(u32x2*)(hb + idx) = w;
                                const float g0 = bf_lo(w.x), g1 = bf_hi(w.x), g2 = bf_lo(w.y), g3 = bf_hi(w.y);
                                const float q0 = __builtin_amdgcn_fmed3f(rintf((h[0] - g0) * __uint_as_float(0x86800000u - (__float_as_uint(g0) & 0x7f800000u))), -128.f, 127.f);
                                const float q1 = __builtin_amdgcn_fmed3f(rintf((h[1] - g1) * __uint_as_float(0x86800000u - (__float_as_uint(g1) & 0x7f800000u))), -128.f, 127.f);
                                const float q2 = __builtin_amdgcn_fmed3f(rintf((h[2] - g2) * __uint_as_float(0x86800000u - (__float_as_uint(g2) & 0x7f800000u))), -128.f, 127.f);
                                const float q3 = __builtin_amdgcn_fmed3f(rintf((h[3] - g3) * __uint_as_float(0x86800000u - (__float_as_uint(g3) & 0x7f800000u))), -128.f, 127.f);
                                *(unsigned*)(loout + idx) = ((unsigned)(int)q0 & 0xffu) | (((unsigned)(int)q1 & 0xffu) << 8) | (((unsigned)(int)q2 & 0xffu) << 16) | (((unsigned)(int)q3 & 0xffu) << 24);
                            }
                            sq += (h[0] * h[0] + h[1] * h[1]) + (h[2] * h[2] + h[3] * h[3]);
                        }
                    if (ssqo) { sq += __shfl_xor(sq, 16); sq += __shfl_xor(sq, 32); if (fq == 0) ssqo[(size_t)row * 16 + u.pn * 4 + wc] = sq; }
                }
            }
    }
};
__device__ __forceinline__ void fill_rstd_tab(LAS unsigned char* lds, const float* ssq, int N) {
    const int tid = tid_fresh(), rl = tid & 255, hi = tid >> 8;
    LAS float* tab = (LAS float*)(lds + TABR_OFF);
    pg8::StaticOrder S; S.init(MROWS, N, gridDim.x, VB(lds));
    f32x4 v[4][4]; bool ok[4];
#pragma unroll
    for (int ps = 0; ps < 4; ++ps) { Unit u; ok[ps] = S.next(2 * ps + hi, u);
        if (ok[ps]) { const f32x4* p = (const f32x4*)(ssq + (size_t)(u.pm * 256 + rl) * 16); v[ps][0] = p[0]; v[ps][1] = p[1]; v[ps][2] = p[2]; v[ps][3] = p[3]; } }
#pragma unroll
    for (int ps = 0; ps < 4; ++ps) if (ok[ps]) {
        const f32x4 a = v[ps][0], b = v[ps][1], c = v[ps][2], d = v[ps][3];
        const float s = (((a.x + a.y) + (a.z + a.w)) + ((b.x + b.y) + (b.z + b.w))) + (((c.x + c.y) + (c.z + c.w)) + ((d.x + d.y) + (d.z + d.w)));
        tab[(2 * ps + hi) * 256 + rl] = rsqrtf(s * (1.f / 1024.f) + 1e-6f); }
    __syncthreads();
}
template <class Epi> __device__ __forceinline__ void run_gemm(LAS unsigned char* lds, const bf16_t* A, const bf16_t* Bt, int N, int K, const Epi& E, int atiled = 0, int krot = 0) {
    pg8::StaticOrder S; S.init(MROWS, N, gridDim.x, VB(lds));
    const pg8::Gemm g{A, Bt, MROWS, N, K, atiled, krot};
    pg8::gemm_phase<Epi, pg8::StaticOrder, false>(lds, g, S, E, nullptr);
}
__device__ __forceinline__ void gemm_gu(LAS unsigned char* lds, const bf16_t* A, const float* ssq, const bf16_t* W, bf16_t* act) {
    fill_rstd_tab(lds, ssq, 5632);
    EpiT e{}; e.mode = 0; e.tabr = (LAS const float*)(lds + TABR_OFF); e.out = act; e.S.init(MROWS, 5632, gridDim.x, VB(lds)); run_gemm(lds, A, W, 5632, 1024, e);
}
struct HRef { const float* x; const bf16_t* hi; const signed char* lo; };
struct HDst { float* f; bf16_t* hi; signed char* lo; float* ssq; };
__device__ __forceinline__ void gemm_res(LAS unsigned char* lds, const bf16_t* A, const bf16_t* W, int K, HRef in, HDst out, float scale) {
    EpiF e{}; e.mode = 0; e.xin = in.x; e.hbin = in.hi; e.loin = in.lo; e.fout = out.f; e.hb = out.hi; e.loout = out.lo; e.ssqo = out.ssq; e.scale = scale;
    run_gemm(lds, A, W, 1024, K, e, K == 2816 ? 1 : 0, 0);
}
__device__ __forceinline__ void ple_phase(LAS unsigned char* lds, const bf16_t* pb, const bf16_t* Wpp, bf16_t* pp, const bf16_t* A, const float* ssqi, const bf16_t* Wpg, HRef in, HDst out, bool pp_ready = false) {
    fill_rstd_tab(lds, ssqi, 1024);
    pg8::StaticOrder S; S.init(MROWS, 1024, gridDim.x, VB(lds));
    if (!pp_ready) {
        run_gemm(lds, pb, Wpp, 1024, 256, EpiF{1, nullptr, nullptr, nullptr, nullptr, nullptr, nullptr, nullptr, 0.f, nullptr, pp, S});
        __threadfence(); __syncthreads(); __builtin_amdgcn_fence(__ATOMIC_ACQUIRE, "agent"); }
    run_gemm(lds, A, Wpg, 1024, 1024, EpiF{2, in.x, in.hi, in.lo, out.f, out.hi, out.lo, out.ssq, 0.f, (LAS const float*)(lds + TABR_OFF), pp, S});
}

__device__ __forceinline__ void cvt_rows_bf16(const float* src, bf16_t* dst, int ncol4  , int lane, int gw, int NGW) {
    for (int row = gw; row < MROWS; row += NGW) {
        const f32x4 v = *(const f32x4*)(src + (size_t)row * 256 + 4 * lane);
        u32x2 w; w.x = pk2(v[0], v[1]); w.y = pk2(v[2], v[3]);
        *(u32x2*)(dst + (size_t)row * 256 + 4 * lane) = w;
    }
}
__device__ __forceinline__ void convert_descs(const Args& a, int d_lo, int d_hi, int rank, int n) {
    const int lane = tid_fresh() & 63, wave = tid_fresh() >> 6;
    int total = 0;
    for (int d = d_lo; d < d_hi; ++d) total += (a.wd[d].K >> 6) * (a.wd[d].ncols >> 5);
    const int kc = lane & 7, ng = lane >> 3;
    for (int it = rank * 8 + wave; it < total; it += n * 8) {
        int r = it, d = d_lo;
        for (;;) { const int c = (a.wd[d].K >> 6) * (a.wd[d].ncols >> 5); if (r < c) break; r -= c; ++d; }
        const float* src = a.in[a.wd[d].src_idx] + a.wd[d].src_off; const float* gain = a.wd[d].gain_idx >= 0 ? a.in[a.wd[d].gain_idx] + a.wd[d].gain_off : nullptr; bf16_t* dst = (bf16_t*)(a.ws + a.wd[d].dst_off);
        const int ldsrc = a.wd[d].ldsrc, col0 = a.wd[d].col0, K = a.wd[d].K, dstrow0 = a.wd[d].dstrow0, mode = a.wd[d].mode;
        const int nblk = a.wd[d].ncols >> 5, kb = r / nblk, nb = r % nblk, k0 = 64 * kb + 8 * kc, n0 = 32 * nb + 4 * ng;
        f32x4 v[8];
#pragma unroll
        for (int i = 0; i < 8; ++i) v[i] = *(const f32x4*)(src + (size_t)(k0 + i) * ldsrc + col0 + n0);
        if (gain) { const f32x4 g0 = *(const f32x4*)(gain + k0), g1 = *(const f32x4*)(gain + k0 + 4);
#pragma unroll
            for (int i = 0; i < 4; ++i) { v[i] = v[i] * g0[i]; v[4 + i] = v[4 + i] * g1[i]; } }
#pragma unroll
        for (int j = 0; j < 4; ++j) { const int f = n0 + j;
            const int drow = mode == 0 ? dstrow0 + f : (256 * (f >> 7) + (f & 127) + (mode == 2 ? 128 : 0));
            u32x4 o; o.x = pk2(v[0][j], v[1][j]); o.y = pk2(v[2][j], v[3][j]); o.z = pk2(v[4][j], v[5][j]); o.w = pk2(v[6][j], v[7][j]);
            *(u32x4*)(dst + (size_t)drow * K + k0) = o; }
    }
}
__device__ __forceinline__ bool slack_pp(LAS unsigned char* lds, int N, const bf16_t* pb, const bf16_t* Wpp, bf16_t* pp) {
    const int G = (int)gridDim.x, nwg = 64 * (N >> 8), busy_last = nwg - ((nwg + G - 1) / G - 1) * G, c = VB(lds);
    if (busy_last >= G) return false;
    if (c >= busy_last) { pg8::StaticOrder S; S.init(MROWS, 1024, G - busy_last, c - busy_last); const pg8::Gemm g{pb, Wpp, MROWS, 1024, 256, 0, 0};
        const EpiF e{1, nullptr, nullptr, nullptr, nullptr, nullptr, nullptr, nullptr, 0.f, nullptr, pp, S}; pg8::gemm_phase<EpiF, pg8::StaticOrder, false>(lds, g, S, e, nullptr); }
    return true;
}
__device__ __forceinline__ void slack_convert(const Args& a, LAS unsigned char* lds, int N, int d_lo, int d_hi) {
    const int G = (int)gridDim.x, nwg = 64 * (N >> 8), busy_last = nwg - ((nwg + G - 1) / G - 1) * G, c = VB(lds);
    if (busy_last >= G) convert_descs(a, d_lo, d_hi, c, G);
    else if (c >= busy_last) convert_descs(a, d_lo, d_hi, c - busy_last, G - busy_last);
}
__device__ __forceinline__ void p0_phase(const Args& a, LAS unsigned char* lds) {
    const int lane = tid_fresh() & 63, wave = tid_fresh() >> 6;
    const int gw = blockIdx.x * 8 + wave, NGW = gridDim.x * 8;
    convert_descs(a, 0, 2, blockIdx.x, gridDim.x);
    const float* x = a.in[0]; bf16_t* xb = (bf16_t*)(a.ws + OFF_SA); float* ssq = (float*)(a.ws + OFF_SSQA);
    for (int row = gw; row < MROWS; row += NGW) {
        float s = 0.f;
#pragma unroll
        for (int j = 0; j < 4; ++j) { const f32x4 v = *(const f32x4*)(x + (size_t)row * 1024 + 256 * j + 4 * lane);
            s += (v[0] * v[0] + v[1] * v[1]) + (v[2] * v[2] + v[3] * v[3]);
            u32x2 w; w.x = pk2(v[0], v[1]); w.y = pk2(v[2], v[3]); *(u32x2*)(xb + (size_t)row * 1024 + 256 * j + 4 * lane) = w; }
        s = wave_sum(s);
        if (lane < 16) ssq[(size_t)row * 16 + lane] = lane == 0 ? s : 0.f;
    }
    cvt_rows_bf16(a.in[1], (bf16_t*)(a.ws + OFF_PB), 64, lane, gw, NGW);
}
#define XB_TMO      128
#define XB_XCNT(j)  (256  + 64 * (j))
#define XB_XSUB(j)  (1280 + 64 * (j))
#define XB_XGEN(j)  (2304 + 64 * (j))
#define XB_TOP      3328
#define XB_TOPGEN   3392
#define XCD_BAR_WORDS 3456
#define XB_SPIN_CAP (1u << 18)
__device__ __forceinline__ unsigned xb_ld(unsigned* p)              { return __hip_atomic_load(p, __ATOMIC_RELAXED, __HIP_MEMORY_SCOPE_AGENT); }
__device__ __forceinline__ unsigned xb_add(unsigned* p, unsigned v) { return __hip_atomic_fetch_add(p, v, __ATOMIC_RELAXED, __HIP_MEMORY_SCOPE_AGENT); }
__device__ __forceinline__ unsigned xb_xcc_id() { return (unsigned)__builtin_amdgcn_s_getreg((3 << 11) | 20) & 0xFu; }
#define XB_SPIN(cond, bar) do { unsigned _sp = 0; while (cond) { __builtin_amdgcn_s_sleep(1); \
    if ((++_sp & 255u) == 0u) { if (xb_ld(&(bar)[XB_TMO])) break; if (_sp > XB_SPIN_CAP) { atomicAdd(&(bar)[XB_TMO], 1u); break; } } } } while (0)

struct XcdBarrier {
    unsigned* bar; unsigned x;
    volatile LAS unsigned* st;
};

__device__ __forceinline__ XcdBarrier xcd_barrier_post(unsigned* bar, volatile LAS unsigned* st) {
    XcdBarrier b; b.bar = bar; b.x = xb_xcc_id(); b.st = st;
    if (tid_fresh() == 0) (void)xb_add(&bar[XB_XCNT(b.x)], 1u);
    return b;
}
__device__ __forceinline__ void xcd_barrier_complete(unsigned* bar, unsigned x, unsigned& nloc, unsigned& nx) {
    const unsigned G = gridDim.x * gridDim.y * gridDim.z;
    unsigned sum, cnt, mine, sp = 0u;
    for (;;) {
        sum = 0u; cnt = 0u; mine = 0u;
#pragma unroll
        for (unsigned j = 0; j < 16; ++j) { const unsigned c = xb_ld(&bar[XB_XCNT(j)]); sum += c; cnt += (c > 0u) ? 1u : 0u; mine = (j == x) ? c : mine; }
        if (sum == G) break;
        __builtin_amdgcn_s_sleep(1);
        if ((++sp & 255u) == 0u) { if (xb_ld(&bar[XB_TMO])) break; if (sp > XB_SPIN_CAP) { atomicAdd(&bar[XB_TMO], 1u); break; } }
    }
    nloc = mine > 0u ? mine : 1u; nx = cnt > 0u ? cnt : 1u;
}

__device__ __forceinline__ void xcd_barrier(const XcdBarrier& b) {
    asm volatile("s_waitcnt vmcnt(0)" ::: "memory");
    __syncthreads();
    if (tid_fresh() == 0) {
        unsigned* bar = b.bar;
        __builtin_amdgcn_s_waitcnt(0);
        unsigned nloc = b.st[0], nx = b.st[1];
        if (nloc == 0u) { xcd_barrier_complete(bar, b.x, nloc, nx); b.st[0] = nloc; b.st[1] = nx; }
        const unsigned old = xb_add(&bar[XB_XSUB(b.x)], 1u);
        const unsigned gen = old / nloc;
        if (old + 1u == (gen + 1u) * nloc) {
            __builtin_amdgcn_fence(__ATOMIC_RELEASE, "agent");
            asm volatile("s_waitcnt vmcnt(0)" ::: "memory");
            const unsigned og = xb_add(&bar[XB_TOP], 1u);
            const unsigned tg = og / nx;
            if (og + 1u == (tg + 1u) * nx) xb_add(&bar[XB_TOPGEN], 1u);
            else XB_SPIN(xb_ld(&bar[XB_TOPGEN]) == tg, bar);
            __builtin_amdgcn_fence(__ATOMIC_ACQUIRE, "agent");
            xb_add(&bar[XB_XGEN(b.x)], 1u);
            asm volatile("s_waitcnt vmcnt(0)" ::: "memory");
        } else {
            XB_SPIN(xb_ld(&bar[XB_XGEN(b.x)]) == gen, bar);
            __builtin_amdgcn_fence(__ATOMIC_ACQUIRE, "agent");
            asm volatile("s_waitcnt vmcnt(0)" ::: "memory");
        }
    }
    __syncthreads();
}

__device__ __forceinline__ void stage_k(const bf16_t* src, LAS unsigned char* Kt, int lane) {
#pragma unroll
    for (int i = 0; i < 8; ++i) { const int r = (lane >> 3) + 8 * i;
        const u32x4 v = *(const u32x4*)(src + (size_t)r * 2304 + (lane & 7) * 8);
        *(LAS u32x4*)(Kt + r * 144 + (lane & 7) * 16) = v; }
}
__device__ __forceinline__ void stage_k_norm(const bf16_t* src, const float* kg, LAS unsigned char* Kt, int lane) {
    const f32x4 g0 = *(const f32x4*)(kg + (lane & 7) * 8), g1 = *(const f32x4*)(kg + (lane & 7) * 8 + 4);
#pragma unroll
    for (int i = 0; i < 8; ++i) { const int r = (lane >> 3) + 8 * i;
        const u32x4 v = *(const u32x4*)(src + (size_t)r * 2304 + (lane & 7) * 8);
        float f[8] = {bf_lo(v.x), bf_hi(v.x), bf_lo(v.y), bf_hi(v.y), bf_lo(v.z), bf_hi(v.z), bf_lo(v.w), bf_hi(v.w)};
        float s = 0.f;
#pragma unroll
        for (int e = 0; e < 8; ++e) s += f[e] * f[e];
        s += __shfl_xor(s, 1); s += __shfl_xor(s, 2); s += __shfl_xor(s, 4);
        const float inv = rsqrtf(s * (1.f / 64.f) + 1e-6f);
        u32x4 w; w.x = pk2(f[0] * inv * g0[0], f[1] * inv * g0[1]); w.y = pk2(f[2] * inv * g0[2], f[3] * inv * g0[3]);
        w.z = pk2(f[4] * inv * g1[0], f[5] * inv * g1[1]); w.w = pk2(f[6] * inv * g1[2], f[7] * inv * g1[3]);
        *(LAS u32x4*)(Kt + r * 144 + (lane & 7) * 16) = w; }
}
__device__ __forceinline__ void stage_vt(const bf16_t* src, LAS unsigned char* Vt, int lane) {
#pragma unroll
    for (int c = 0; c < 8; ++c) {
        const u32x4 v = *(const u32x4*)(src + (size_t)lane * 2304 + c * 8);
        LAS unsigned short* p = (LAS unsigned short*)(Vt + (8 * c) * 144 + lane * 2);
        p[0 * 72] = (unsigned short)(v.x & 0xffffu); p[1 * 72] = (unsigned short)(v.x >> 16);
        p[2 * 72] = (unsigned short)(v.y & 0xffffu); p[3 * 72] = (unsigned short)(v.y >> 16);
        p[4 * 72] = (unsigned short)(v.z & 0xffffu); p[5 * 72] = (unsigned short)(v.z >> 16);
        p[6 * 72] = (unsigned short)(v.w & 0xffffu); p[7 * 72] = (unsigned short)(v.w >> 16);
    }
}
typedef short s16x4 __attribute__((ext_vector_type(4)));
__device__ __forceinline__ s16x4 lds_tr4(LAS const unsigned char* p) { return __builtin_amdgcn_ds_read_tr16_b64_v4i16((LAS s16x4*)p); }
__device__ __forceinline__ void wave_lds_fence() { asm volatile("s_waitcnt lgkmcnt(0)" ::: "memory"); }
__device__ __forceinline__ f32x4 amfma(bf16x8 x, bf16x8 y, f32x4 c) { return __builtin_amdgcn_mfma_f32_16x16x32_bf16(x, y, c, 0, 0, 0); }
__device__ __forceinline__ bf16x8 mk8(unsigned a, unsigned b, unsigned c, unsigned d) { const u32x4 t = {a, b, c, d}; return __builtin_bit_cast(bf16x8, t); }

template <int KIND, int NQS>
__device__ __forceinline__ void att_item(const bf16_t* proj, bf16_t* oatt, const float* qg, const float* kg, const float* sinks, LAS unsigned char* wl, int b, int h, int qbi, int lane) {
    const int t0 = qbi * (16 * NQS);
    LAS unsigned char* Kt = wl; LAS unsigned char* Vt = wl + 9216;
    const int l15 = lane & 15, l4 = lane >> 4;
    const int kvh = KIND ? (h >> 2) : h;
    const int qcol = KIND ? 1536 + h * 64 : h * 64, kcol = KIND ? 2048 + kvh * 64 : 512 + h * 64, vcol = KIND ? 2176 + kvh * 64 : 1024 + h * 64, ocol = KIND ? 512 + h * 64 : h * 64;
    const float slope = exp2f(-(float)(h + 1));
    const size_t rowb = (size_t)b * 4096 + t0;
    bf16x8 qf[NQS][2];
#pragma unroll
    for (int qs = 0; qs < NQS; ++qs) {
        const u32x4 r0 = *(const u32x4*)(proj + (rowb + 16 * qs + l15) * 2304 + qcol + 8 * l4), r1 = *(const u32x4*)(proj + (rowb + 16 * qs + l15) * 2304 + qcol + 32 + 8 * l4);
        if (KIND == 0) { qf[qs][0] = __builtin_bit_cast(bf16x8, r0); qf[qs][1] = __builtin_bit_cast(bf16x8, r1); }
        else {
            float f[16] = {bf_lo(r0.x), bf_hi(r0.x), bf_lo(r0.y), bf_hi(r0.y), bf_lo(r0.z), bf_hi(r0.z), bf_lo(r0.w), bf_hi(r0.w),
                           bf_lo(r1.x), bf_hi(r1.x), bf_lo(r1.y), bf_hi(r1.y), bf_lo(r1.z), bf_hi(r1.z), bf_lo(r1.w), bf_hi(r1.w)};
            float ss = 0.f;
#pragma unroll
            for (int e = 0; e < 16; ++e) ss += f[e] * f[e];
            ss += __shfl_xor(ss, 16); ss += __shfl_xor(ss, 32);
            const float inv = rsqrtf(ss * (1.f / 64.f) + 1e-6f) * 0.125f;
            const f32x4 g0 = *(const f32x4*)(qg + 8 * l4), g1 = *(const f32x4*)(qg + 8 * l4 + 4), g2 = *(const f32x4*)(qg + 32 + 8 * l4), g3 = *(const f32x4*)(qg + 36 + 8 * l4);
            qf[qs][0] = mk8(pk2(f[0] * inv * g0[0], f[1] * inv * g0[1]), pk2(f[2] * inv * g0[2], f[3] * inv * g0[3]), pk2(f[4] * inv * g1[0], f[5] * inv * g1[1]), pk2(f[6] * inv * g1[2], f[7] * inv * g1[3]));
            qf[qs][1] = mk8(pk2(f[8] * inv * g2[0], f[9] * inv * g2[1]), pk2(f[10] * inv * g2[2], f[11] * inv * g2[3]), pk2(f[12] * inv * g3[0], f[13] * inv * g3[1]), pk2(f[14] * inv * g3[2], f[15] * inv * g3[3]));
        }
    }
    f32x4 O[NQS][4];
#pragma unroll
    for (int qs = 0; qs < NQS; ++qs)
#pragma unroll
        for (int dt = 0; dt < 4; ++dt) O[qs][dt] = (f32x4){0.f, 0.f, 0.f, 0.f};
    float st0[NQS], st1[NQS];
#pragma unroll
    for (int qs = 0; qs < NQS; ++qs) { st0[qs] = KIND ? sinks[h] : 0.f; st1[qs] = (KIND && l4 == 0) ? 1.f : 0.f; }
    const int kb_hi = (t0 + 16 * NQS - 1) >> 6, kb_lo = t0 >= 127 ? ((t0 - 127) >> 6) : 0;
    const int kb_first = KIND ? kb_lo : kb_hi, kb_last = KIND ? kb_hi : 0, kb_step = KIND ? 1 : -1;
    for (int kb = kb_first; KIND ? (kb <= kb_last) : (kb >= kb_last); kb += kb_step) {
        const bf16_t* kbase = proj + ((size_t)b * 4096 + kb * 64) * 2304;
        wave_lds_fence();
        if (KIND) stage_k_norm(kbase + kcol, kg, Kt, lane); else stage_k(kbase + kcol, Kt, lane);
        stage_k(kbase + vcol, Vt, lane);
        wave_lds_fence();
#pragma unroll
        for (int qs = 0; qs < NQS; ++qs) {
            f32x4 S[4];
#pragma unroll
            for (int kt = 0; kt < 4; ++kt) { const bf16x8 k0 = *(LAS const bf16x8*)(Kt + (16 * kt + l15) * 144 + (8 * l4) * 2), k1 = *(LAS const bf16x8*)(Kt + (16 * kt + l15) * 144 + (32 + 8 * l4) * 2);
                S[kt] = amfma(k0, qf[qs][0], (f32x4){0.f, 0.f, 0.f, 0.f}); S[kt] = amfma(k1, qf[qs][1], S[kt]); }
            const int t = t0 + 16 * qs + l15, key0 = kb * 64 + 4 * l4;
            float w[4][4];
            if (KIND == 0) {
                float sp[4][4], q4[4], hi[4], tot[4];
#pragma unroll
                for (int kt = 0; kt < 4; ++kt) { q4[kt] = 0.f;
#pragma unroll
                    for (int r = 0; r < 4; ++r) { const float z = S[kt][r] * 0.125f; S[kt][r] = z;
                        const float v = fmaxf(z, 0.f) + __logf(1.f + __expf(-fabsf(z)));
                        sp[kt][r] = (key0 + 16 * kt + r < t) ? v : 0.f; q4[kt] += sp[kt][r]; } }
#pragma unroll
                for (int kt = 0; kt < 4; ++kt) {
                    const float a1 = __shfl(q4[kt], (lane + 16) & 63), a2 = __shfl(q4[kt], (lane + 32) & 63), a3 = __shfl(q4[kt], (lane + 48) & 63);
                    hi[kt] = (l4 < 3 ? a1 : 0.f) + (l4 < 2 ? a2 : 0.f) + (l4 < 1 ? a3 : 0.f);
                    tot[kt] = __shfl(hi[kt] + q4[kt], l15); }
                float above = st0[qs];
#pragma unroll
                for (int kt = 3; kt >= 0; --kt) { float run = above + hi[kt];
#pragma unroll
                    for (int r = 3; r >= 0; --r) { w[kt][r] = (key0 + 16 * kt + r < t) ? __expf(S[kt][r] - sp[kt][r] - run) : 0.f; run += sp[kt][r]; }
                    above += tot[kt]; }
                st0[qs] = above;
            } else {
                float mx = st0[qs];
#pragma unroll
                for (int kt = 0; kt < 4; ++kt)
#pragma unroll
                    for (int r = 0; r < 4; ++r) { const int dist = t - (key0 + 16 * kt + r); const bool valid = dist >= 0 && dist < 128;
                        const float sc = valid ? S[kt][r] - slope * (float)dist : -1e30f; S[kt][r] = sc; mx = fmaxf(mx, sc); }
                mx = fmaxf(mx, __shfl_xor(mx, 16)); mx = fmaxf(mx, __shfl_xor(mx, 32));
                const float corr = __expf(st0[qs] - mx); st0[qs] = mx;
                float ls = 0.f;
#pragma unroll
                for (int kt = 0; kt < 4; ++kt)
#pragma unroll
                    for (int r = 0; r < 4; ++r) { w[kt][r] = S[kt][r] > -1e29f ? __expf(S[kt][r] - mx) : 0.f; ls += w[kt][r]; }
                st1[qs] = st1[qs] * corr + ls;
#pragma unroll
                for (int dt = 0; dt < 4; ++dt) O[qs][dt] = O[qs][dt] * corr;
            }
            const bf16x8 pf0 = mk8(pk2(w[0][0], w[0][1]), pk2(w[0][2], w[0][3]), pk2(w[1][0], w[1][1]), pk2(w[1][2], w[1][3]));
            const bf16x8 pf1 = mk8(pk2(w[2][0], w[2][1]), pk2(w[2][2], w[2][3]), pk2(w[3][0], w[3][1]), pk2(w[3][2], w[3][3]));
            {
                LAS const unsigned char* vb = Vt + (4 * l4 + (l15 >> 2)) * 144 + 8 * (l15 & 3);
#pragma unroll
                for (int dt = 0; dt < 4; ++dt) {
                    const s16x4 a0 = lds_tr4(vb + 32 * dt), b0 = lds_tr4(vb + 16 * 144 + 32 * dt), a1 = lds_tr4(vb + 32 * 144 + 32 * dt), b1 = lds_tr4(vb + 48 * 144 + 32 * dt);
                    const bf16x8 v0 = {a0[0], a0[1], a0[2], a0[3], b0[0], b0[1], b0[2], b0[3]}, v1 = {a1[0], a1[1], a1[2], a1[3], b1[0], b1[1], b1[2], b1[3]};
                    O[qs][dt] = amfma(v0, pf0, O[qs][dt]);
                    O[qs][dt] = amfma(v1, pf1, O[qs][dt]);
                }
            }
        }
        if (KIND == 0) { float rmin = st0[0];
#pragma unroll
            for (int qs = 1; qs < NQS; ++qs) rmin = fminf(rmin, st0[qs]);
            if (__all(rmin > 104.f)) break; }
    }
#pragma unroll
    for (int qs = 0; qs < NQS; ++qs) {
        float sc = 1.f;
        if (KIND) { float l = st1[qs]; l += __shfl_xor(l, 16); l += __shfl_xor(l, 32); sc = 1.f / l; }
#pragma unroll
        for (int dt = 0; dt < 4; ++dt) { u32x2 o; o.x = pk2(O[qs][dt][0] * sc, O[qs][dt][1] * sc); o.y = pk2(O[qs][dt][2] * sc, O[qs][dt][3] * sc);
            *(u32x2*)(oatt + (rowb + 16 * qs + l15) * 1024 + ocol + 16 * dt + 4 * l4) = o; }
    }
}
__device__ __forceinline__ void att_phase(const Args& a, LAS unsigned char* lds, const bf16_t* proj, bf16_t* oatt) {
    const int lane = tid_fresh() & 63, wave = tid_fresh() >> 6;
    LAS unsigned char* wl = lds + wave * 18432;
    const int NGW = gridDim.x * 8;
    for (int it = blockIdx.x * 8 + wave; it < 8192; it += NGW) {
        const int kind = it >> 12, r = it & 4095;
        const int qbi = 127 - (r & 127), h = (r >> 7) & 7, b = r >> 10;
        if (kind == 0) att_item<0, 2>(proj, oatt, a.in[8], a.in[9], a.in[10], wl, b, h, qbi, lane);
        else att_item<1, 2>(proj, oatt, a.in[8], a.in[9], a.in[10], wl, b, h, qbi, lane);
    }
}
__device__ __forceinline__ f32x4 mfma16(bf16x8 x, bf16x8 y, f32x4 c) { return __builtin_amdgcn_mfma_f32_16x16x32_bf16(x, y, c, 0, 0, 0); }
__device__ __forceinline__ bf16_t f2bf(float x) { return (bf16_t)(pk2(x, 0.f) & 0xffffu); }

__device__ __forceinline__ void gdn_prep_phase(const Args& a, LAS unsigned char* lds, const bool dry = false) {
    const int tid = tid_fresh(), lane = tid & 63, wave = tid >> 6;
    unsigned char* ws = a.ws;
    bf16_t* QKV = (bf16_t*)(ws + OFF_QKV); const bf16_t* halo = (const bf16_t*)(ws + OFF_HALO); const float* gates = (const float*)(ws + OFF_GATES);
    float* gb = (float*)(ws + OFF_GB); bf16_t* Tinv = (bf16_t*)(ws + OFF_TINV); bf16_t* attn = (bf16_t*)(ws + OFF_ATTN);
    const float* convw = a.in[13]; const float* a_log = a.in[14]; const float* dtb = a.in[15];
    constexpr int CSP = 1040;
    LAS unsigned char* cs = lds;
    LAS float* kkf = (LAS float*)(lds + 69888);
    LAS float* qkf = (LAS float*)(lds + 69888 + 17408);
    LAS float* Lm = (LAS float*)(lds + 104704);
    LAS float* betas = (LAS float*)(lds + 137472);
    LAS float* gcs = betas + 128;
    auto fetch_raw = [&](int item, u32x4 (&raw)[9]) {
        const int n = item & 63, hk = (item >> 6) & 7, b = item >> 9;
        const size_t row0 = (size_t)b * 4096 + 64 * n;
#pragma unroll
        for (int i = 0; i < 9; ++i) { const int v = tid + 512 * i; raw[i] = (u32x4){0u, 0u, 0u, 0u};
            if (v < 67 * 64) { const int r = v >> 6, ch = 8 * (v & 63);
                const int gcol = ch < 128 ? hk * 128 + ch : (ch < 256 ? 1024 + hk * 128 + (ch - 128) : 2048 + hk * 256 + (ch - 256));
                if (r >= 3) raw[i] = *(const u32x4*)(QKV + (row0 + r - 3) * 4096 + gcol);
                else if (n > 0) raw[i] = *(const u32x4*)(halo + ((size_t)(b * 64 + n - 1) * 3 + r) * 4096 + gcol); } }
    };
    u32x4 raw[9];
    if ((int)blockIdx.x < 2048) fetch_raw(blockIdx.x, raw);
    for (int item = blockIdx.x; item < 2048; item += gridDim.x) {
        const int n = item & 63, hk = (item >> 6) & 7, b = item >> 9;
        const size_t row0 = (size_t)b * 4096 + 64 * n;
        __syncthreads();
#pragma unroll
        for (int i = 0; i < 9; ++i) { const int v = tid + 512 * i; if (v < 67 * 64) *(LAS u32x4*)(cs + (v >> 6) * CSP + 16 * (v & 63)) = raw[i]; }
        if (item + (int)gridDim.x < 2048) fetch_raw(item + gridDim.x, raw);
        __syncthreads();
        {
            const int ch = tid;
            const int gcol = ch < 128 ? hk * 128 + ch : (ch < 256 ? 1024 + hk * 128 + (ch - 128) : 2048 + hk * 256 + (ch - 256));
            const float w0 = convw[gcol], w1 = convw[4096 + gcol], w2 = convw[8192 + gcol], w3 = convw[12288 + gcol];
            LAS bf16_t* col = (LAS bf16_t*)(cs + ch * 2);
            float x0 = bf2f(col[0]), x1 = bf2f(col[520]), x2 = bf2f(col[1040]);
#pragma unroll 8
            for (int t = 0; t < 64; ++t) { const float x3 = bf2f(col[(t + 3) * 520]);
                const float y = (w0 * x0 + w1 * x1) + (w2 * x2 + w3 * x3);
                col[(t + 3) * 520] = f2bf(silu_(y)); x0 = x1; x1 = x2; x2 = x3; }
        }
        __syncthreads();
        {
            const int pair = tid >> 2, t = pair >> 1, part = pair & 1, qd = tid & 3;
            LAS u32x4* p = (LAS u32x4*)(cs + (t + 3) * CSP + part * 256 + qd * 64);
            u32x4 u[4]; float ss = 0.f;
#pragma unroll
            for (int i = 0; i < 4; ++i) { u[i] = p[i];
                ss += (bf_lo(u[i].x) * bf_lo(u[i].x) + bf_hi(u[i].x) * bf_hi(u[i].x)) + (bf_lo(u[i].y) * bf_lo(u[i].y) + bf_hi(u[i].y) * bf_hi(u[i].y))
                    + (bf_lo(u[i].z) * bf_lo(u[i].z) + bf_hi(u[i].z) * bf_hi(u[i].z)) + (bf_lo(u[i].w) * bf_lo(u[i].w) + bf_hi(u[i].w) * bf_hi(u[i].w)); }
            ss += __shfl_xor(ss, 1); ss += __shfl_xor(ss, 2);
            const float inv = rsqrtf(ss + 1e-6f) * (part == 0 ? 0.08838834764831845f : 1.f);
            bf16_t* gp = QKV + (row0 + t) * 4096 + part * 1024 + hk * 128 + qd * 32;
#pragma unroll
            for (int i = 0; i < 4; ++i) { u32x4 w;
                w.x = pk2(bf_lo(u[i].x) * inv, bf_hi(u[i].x) * inv); w.y = pk2(bf_lo(u[i].y) * inv, bf_hi(u[i].y) * inv);
                w.z = pk2(bf_lo(u[i].z) * inv, bf_hi(u[i].z) * inv); w.w = pk2(bf_lo(u[i].w) * inv, bf_hi(u[i].w) * inv);
                p[i] = w; if (!dry) *(u32x4*)(gp + 8 * i) = w; }
        }
        for (int v = tid; v < 2048; v += 512) { const int t = v >> 5, c8 = v & 31;
            if (!dry) *(u32x4*)(QKV + (row0 + t) * 4096 + 2048 + hk * 256 + 8 * c8) = *(LAS const u32x4*)(cs + (t + 3) * CSP + 512 + 16 * c8); }
        if (tid < 128) {
            const int hvl = tid >> 6, hv = 2 * hk + hvl; const size_t row = row0 + lane;
            const float bl = gates[row * 32 + hv], av = gates[row * 32 + 16 + hv];
            const float beta = sigm(bl); const float xx = av + dtb[hv];
            const float ex = __expf(-fabsf(xx));
            const float sp = fmaxf(xx, 0.f) + (ex < 1e-4f ? ex * (1.f - 0.5f * ex) : __logf(1.f + ex));
            float g = -__expf(a_log[hv]) * sp;
#pragma unroll
            for (int o = 1; o < 64; o <<= 1) { const float y = __shfl_up(g, o); if (lane >= o) g += y; }
            betas[hvl * 64 + lane] = beta; gcs[hvl * 64 + lane] = g;
            float2 bg; bg.x = beta; bg.y = g; if (!dry) *(float2*)(gb + (row * 16 + hv) * 2) = bg;
        }
        __syncthreads();
        {
            const int ct = wave & 3, which = wave >> 2, l15 = lane & 15, l4 = lane >> 4;
            LAS float* dstm = which ? qkf : kkf;
            bf16x8 ya[4];
#pragma unroll
            for (int ks = 0; ks < 4; ++ks) ya[ks] = *(LAS const bf16x8*)(cs + (3 + 16 * ct + l15) * CSP + (which ? 0 : 256) + (32 * ks + 8 * l4) * 2);
#pragma unroll
            for (int st = 0; st < 4; ++st) { f32x4 acc = {0.f, 0.f, 0.f, 0.f};
#pragma unroll
                for (int ks = 0; ks < 4; ++ks) { const bf16x8 xs = *(LAS const bf16x8*)(cs + (3 + 16 * st + l15) * CSP + 256 + (32 * ks + 8 * l4) * 2); acc = mfma16(xs, ya[ks], acc); }
                *(LAS f32x4*)(dstm + (16 * ct + l15) * 68 + 16 * st + 4 * l4) = acc; }
        }
        __syncthreads();
        {
            const int hvl = tid >> 8, c = (tid >> 2) & 63, s0 = 16 * (tid & 3), hv = 2 * hk + hvl;
            const float gcc = gcs[hvl * 64 + c], bc = betas[hvl * 64 + c];
            unsigned aw[8];
#pragma unroll
            for (int i = 0; i < 16; i += 2) {
                float lv[2], av[2];
#pragma unroll
                for (int e = 0; e < 2; ++e) { const int s_ = s0 + i + e; const float dec = c >= s_ ? __expf(gcc - gcs[hvl * 64 + s_]) : 0.f;
                    lv[e] = c > s_ ? bc * kkf[c * 68 + s_] * dec : 0.f; av[e] = qkf[c * 68 + s_] * dec; }
                Lm[hvl * 4096 + c * 64 + s0 + i] = lv[0]; Lm[hvl * 4096 + c * 64 + s0 + i + 1] = lv[1];
                aw[i >> 1] = pk2(av[0], av[1]); }
            if (!dry) { bf16_t* ap = attn + ((size_t)((b * 16 + hv) * 64 + n)) * 4096 + c * 64 + s0;
                u32x4 w0 = {aw[0], aw[1], aw[2], aw[3]}, w1 = {aw[4], aw[5], aw[6], aw[7]}; *(u32x4*)ap = w0; *(u32x4*)(ap + 8) = w1; }
        }
        __syncthreads();
        LAS float* X = kkf;
        LAS float* Mb = (LAS float*)cs;
        if (tid < 128) {
            const int hvl = tid >> 6, half = lane >> 5, jj = lane & 31, base = 32 * half;
            LAS const float* Lh = Lm + hvl * 4096 + base * 64 + base;
            LAS float* Xh = X + hvl * 4096;
            float x[32];
#pragma unroll
            for (int c = 0; c < 32; ++c) x[c] = 0.f;
#pragma unroll
            for (int c = 0; c < 32; ++c) { float a0 = (c == jj) ? 1.f : 0.f, a1 = 0.f, a2 = 0.f, a3 = 0.f;
#pragma unroll
                for (int s4 = 0; s4 < (c + 3) / 4; ++s4) { const f32x4 Lv = *(LAS const f32x4*)(Lh + c * 64 + 4 * s4);
                    a0 -= Lv[0] * x[4 * s4]; a1 -= Lv[1] * x[4 * s4 + 1]; a2 -= Lv[2] * x[4 * s4 + 2]; a3 -= Lv[3] * x[4 * s4 + 3]; }
                x[c] = (a0 + a1) + (a2 + a3);
                Xh[(base + c) * 64 + base + jj] = x[c];
                if (half == 0) Xh[c * 64 + 32 + jj] = 0.f; }
        }
        __syncthreads();
        {
            const int hvl = tid >> 8, r = (tid >> 3) & 31, q0 = 4 * (tid & 7);
            LAS const float* Lh = Lm + hvl * 4096; LAS float* Xh = X + hvl * 4096;
            f32x4 m = {0.f, 0.f, 0.f, 0.f};
#pragma unroll 8
            for (int t = 0; t < 32; ++t) m = m + *(LAS const f32x4*)(Xh + t * 64 + q0) * Lh[(32 + r) * 64 + t];
            *(LAS f32x4*)(Mb + hvl * 1024 + r * 32 + q0) = m;
            __syncthreads();
            f32x4 e = {0.f, 0.f, 0.f, 0.f};
#pragma unroll 8
            for (int t = 0; t < 32; ++t) e = e - *(LAS const f32x4*)(Mb + hvl * 1024 + t * 32 + q0) * Xh[(32 + r) * 64 + 32 + t];
            *(LAS f32x4*)(Xh + (32 + r) * 64 + q0) = e;
        }
        __syncthreads();
        if (!dry) {
            const int hvl = tid >> 8, c = (tid >> 2) & 63, s0 = 16 * (tid & 3), hv = 2 * hk + hvl;
            LAS const float* xr = X + hvl * 4096 + c * 64 + s0;
            const f32x4 a0 = *(LAS const f32x4*)xr, a1 = *(LAS const f32x4*)(xr + 4), a2 = *(LAS const f32x4*)(xr + 8), a3 = *(LAS const f32x4*)(xr + 12);
            bf16_t* tp = Tinv + ((size_t)((b * 16 + hv) * 64 + n)) * 4096 + c * 64 + s0;
            u32x4 w0 = {pk2(a0[0], a0[1]), pk2(a0[2], a0[3]), pk2(a1[0], a1[1]), pk2(a1[2], a1[3])}, w1 = {pk2(a2[0], a2[1]), pk2(a2[2], a2[3]), pk2(a3[0], a3[1]), pk2(a3[2], a3[3])};
            *(u32x4*)tp = w0; *(u32x4*)(tp + 8) = w1;
        }
    }
}

constexpr int SC_KT = 0, SC_QT = 17408, SC_TT = 34816, SC_AT = 44032, SC_VT = 53248, SC_GB = 58368, SC_STRIDE = 58880, SC_BASE = 22528;
struct ScanStage { u32x4 k[2], q[2], t, a, v; f2v_t g; };
__device__ __forceinline__ void scan_fetch(ScanStage& o, const bf16_t* QKV, const float* gb, const bf16_t* Tinv, const bf16_t* attn, int b, int hv, int hk, int j, int n, int tid) {
    const size_t row0 = (size_t)b * 4096 + 64 * n;
    const size_t itm = (size_t)((b * 16 + hv) * 64 + n) * 4096;
#pragma unroll
    for (int i = 0; i < 2; ++i) { const int idx = tid + 512 * i, row = idx >> 4, c16 = idx & 15;
        o.q[i] = *(const u32x4*)(QKV + (row0 + row) * 4096 + hk * 128 + 8 * c16);
        o.k[i] = *(const u32x4*)(QKV + (row0 + row) * 4096 + 1024 + hk * 128 + 8 * c16); }
    o.t = *(const u32x4*)(Tinv + itm + (tid >> 3) * 64 + 8 * (tid & 7));
    o.a = *(const u32x4*)(attn + itm + (tid >> 3) * 64 + 8 * (tid & 7));
    if (tid < 256) o.v = *(const u32x4*)(QKV + (row0 + (tid >> 2)) * 4096 + 2048 + hv * 128 + 32 * j + 8 * (tid & 3));
    else if (tid < 320) o.g = *(const f2v_t*)(gb + ((row0 + (tid - 256)) * 16 + hv) * 2);
}
__device__ __forceinline__ void scan_park(const ScanStage& o, LAS unsigned char* img, int tid) {
#pragma unroll
    for (int i = 0; i < 2; ++i) { const int idx = tid + 512 * i, row = idx >> 4, c16 = idx & 15;
        *(LAS u32x4*)(img + SC_QT + row * 272 + c16 * 16) = o.q[i]; *(LAS u32x4*)(img + SC_KT + row * 272 + c16 * 16) = o.k[i]; }
    *(LAS u32x4*)(img + SC_TT + (tid >> 3) * 144 + (tid & 7) * 16) = o.t;
    *(LAS u32x4*)(img + SC_AT + (tid >> 3) * 144 + (tid & 7) * 16) = o.a;
    if (tid < 256) *(LAS u32x4*)(img + SC_VT + (tid >> 2) * 80 + (tid & 3) * 16) = o.v;
    else if (tid < 320) *(LAS f2v_t*)(img + SC_GB + (tid - 256) * 8) = o.g;
}
__device__ __forceinline__ void gdn_scan_phase(const Args& a, LAS unsigned char* lds, const bool dry = false) {
    const int tid = tid_fresh(), lane = tid & 63, wave = tid >> 6, l15 = lane & 15, l4 = lane >> 4, ct = wave >> 1, dt = wave & 1;
    unsigned char* ws = a.ws;
    bf16_t* QKV = (bf16_t*)(ws + OFF_QKV); const float* gb = (const float*)(ws + OFF_GB);
    const bf16_t* Tinv = (const bf16_t*)(ws + OFF_TINV); const bf16_t* attn = (const bf16_t*)(ws + OFF_ATTN);
    LAS unsigned char* Sb = lds; LAS unsigned char* RT = lds + 8704; LAS unsigned char* vnT = lds + 13312; LAS unsigned char* vnsT = lds + 17920;
    for (int item = VCU(lds); item < 256; item += gridDim.x) {
        const int j = item & 3, hv = (item >> 2) & 15, b = item >> 6, hk = hv >> 1;
        __syncthreads();
        for (int i = tid; i < 8704 / 4; i += 512) ((LAS unsigned*)Sb)[i] = 0u;
        f32x4 S0 = {0.f, 0.f, 0.f, 0.f}, S1 = {0.f, 0.f, 0.f, 0.f};
        { ScanStage s0; scan_fetch(s0, QKV, gb, Tinv, attn, b, hv, hk, j, 0, tid); scan_park(s0, lds + SC_BASE, tid); }
        __syncthreads();
        for (int n = 0; n < 64; ++n) {
            LAS const unsigned char* img = lds + SC_BASE + (n & 1) * SC_STRIDE;
            ScanStage nx; scan_fetch(nx, QKV, gb, Tinv, attn, b, hv, hk, j, n < 63 ? n + 1 : 63, tid);
            bf16_t* vcol = QKV + ((size_t)b * 4096 + 64 * n + 16 * ct + 4 * l4) * 4096 + 2048 + hv * 128 + 32 * j + 16 * dt + l15;
            float vv[4], be[4], gcr[4];
#pragma unroll
            for (int r = 0; r < 4; ++r) { vv[r] = bf2f(*(LAS const bf16_t*)(img + SC_VT + (16 * ct + 4 * l4 + r) * 80 + (16 * dt + l15) * 2));
                const f2v_t bg = *(LAS const f2v_t*)(img + SC_GB + (16 * ct + 4 * l4 + r) * 8); be[r] = bg.x; gcr[r] = bg.y; }
            const float gcl = *(LAS const float*)(img + SC_GB + 63 * 8 + 4);
            f32x4 KS = {0.f, 0.f, 0.f, 0.f}, QS = {0.f, 0.f, 0.f, 0.f};
#pragma unroll
            for (int ks = 0; ks < 4; ++ks) { const bf16x8 sf = *(LAS const bf16x8*)(Sb + (16 * dt + l15) * 272 + (32 * ks + 8 * l4) * 2);
                const bf16x8 kf = *(LAS const bf16x8*)(img + SC_KT + (16 * ct + l15) * 272 + (32 * ks + 8 * l4) * 2), qf = *(LAS const bf16x8*)(img + SC_QT + (16 * ct + l15) * 272 + (32 * ks + 8 * l4) * 2);
                KS = mfma16(kf, sf, KS); QS = mfma16(qf, sf, QS); }
            float Oacc[4], Rr[4];
#pragma unroll
            for (int r = 0; r < 4; ++r) { const float eg = __expf(gcr[r]); Rr[r] = be[r] * (vv[r] - eg * KS[r]); Oacc[r] = eg * QS[r]; }
            { u32x2 w; w.x = pk2(Rr[0], Rr[1]); w.y = pk2(Rr[2], Rr[3]); *(LAS u32x2*)(RT + (16 * dt + l15) * 144 + (16 * ct + 4 * l4) * 2) = w; }
            __syncthreads();
            f32x4 VN = {0.f, 0.f, 0.f, 0.f};
#pragma unroll
            for (int k2 = 0; k2 < 2; ++k2) { const bf16x8 rf = *(LAS const bf16x8*)(RT + (16 * dt + l15) * 144 + (32 * k2 + 8 * l4) * 2);
                const bf16x8 tf = *(LAS const bf16x8*)(img + SC_TT + (16 * ct + l15) * 144 + (32 * k2 + 8 * l4) * 2); VN = mfma16(tf, rf, VN); }
            { u32x2 w; w.x = pk2(VN[0], VN[1]); w.y = pk2(VN[2], VN[3]); *(LAS u32x2*)(vnT + (16 * dt + l15) * 144 + (16 * ct + 4 * l4) * 2) = w;
              u32x2 x; x.x = pk2(VN[0] * __expf(gcl - gcr[0]), VN[1] * __expf(gcl - gcr[1])); x.y = pk2(VN[2] * __expf(gcl - gcr[2]), VN[3] * __expf(gcl - gcr[3]));
              *(LAS u32x2*)(vnsT + (16 * dt + l15) * 144 + (16 * ct + 4 * l4) * 2) = x; }
            __syncthreads();
            f32x4 O = {Oacc[0], Oacc[1], Oacc[2], Oacc[3]};
#pragma unroll
            for (int k2 = 0; k2 < 2; ++k2) { const bf16x8 vf = *(LAS const bf16x8*)(vnT + (16 * dt + l15) * 144 + (32 * k2 + 8 * l4) * 2);
                const bf16x8 af = *(LAS const bf16x8*)(img + SC_AT + (16 * ct + l15) * 144 + (32 * k2 + 8 * l4) * 2); O = mfma16(af, vf, O); }
#pragma unroll
            for (int r = 0; r < 4; ++r) { if (!dry) vcol[(size_t)r * 4096] = f2bf(O[r]); }
            const float dec = __expf(gcl);
            S0 = S0 * dec; S1 = S1 * dec;
#pragma unroll
            for (int k2 = 0; k2 < 2; ++k2) {
                LAS const unsigned char* kb_ = img + SC_KT + (32 * k2 + 8 * l4 + (l15 >> 2)) * 272 + 32 * wave + 8 * (l15 & 3);
                const s16x4 ka = lds_tr4(kb_), kc = lds_tr4(kb_ + 4 * 272);
                const bf16x8 ktf = {ka[0], ka[1], ka[2], ka[3], kc[0], kc[1], kc[2], kc[3]};
                const bf16x8 v0 = *(LAS const bf16x8*)(vnsT + l15 * 144 + (32 * k2 + 8 * l4) * 2), v1 = *(LAS const bf16x8*)(vnsT + (16 + l15) * 144 + (32 * k2 + 8 * l4) * 2);
                S0 = mfma16(ktf, v0, S0); S1 = mfma16(ktf, v1, S1); }
            { u32x2 w; w.x = pk2(S0[0], S0[1]); w.y = pk2(S0[2], S0[3]); *(LAS u32x2*)(Sb + l15 * 272 + (16 * wave + 4 * l4) * 2) = w;
              u32x2 x; x.x = pk2(S1[0], S1[1]); x.y = pk2(S1[2], S1[3]); *(LAS u32x2*)(Sb + (16 + l15) * 272 + (16 * wave + 4 * l4) * 2) = x; }
            scan_park(nx, lds + SC_BASE + ((n + 1) & 1) * SC_STRIDE, tid);
            __syncthreads();
        }
    }
}

__device__ __forceinline__ void gdn_z_phase(const Args& a, LAS unsigned char* lds) {
    const int tid = tid_fresh();
    unsigned char* ws = a.ws;
    const bf16_t* QKV = (const bf16_t*)(ws + OFF_QKV);
    LAS float* tab = (LAS float*)(lds + TABO_OFF);
    pg8::StaticOrder S; S.init(MROWS, 2048, gridDim.x, VB(lds));
    Unit u;
    for (int i = 0; i < 8 && S.next(i, u); ++i) {
        const int rl = tid >> 1, bj = tid & 1;
        const bf16_t* op = QKV + (size_t)(u.pm * 256 + rl) * 4096 + 2048 + (2 * u.pn + bj) * 128;
        float ss = 0.f;
#pragma unroll
        for (int c = 0; c < 16; ++c) { const u32x4 v = *(const u32x4*)(op + 8 * c);
            ss += (bf_lo(v.x) * bf_lo(v.x) + bf_hi(v.x) * bf_hi(v.x)) + (bf_lo(v.y) * bf_lo(v.y) + bf_hi(v.y) * bf_hi(v.y)) + (bf_lo(v.z) * bf_lo(v.z) + bf_hi(v.z) * bf_hi(v.z)) + (bf_lo(v.w) * bf_lo(v.w) + bf_hi(v.w) * bf_hi(v.w)); }
        tab[i * 512 + rl * 2 + bj] = rsqrtf(ss * (1.f / 128.f) + 1e-6f);
    }
    fill_rstd_tab(lds, (const float*)(ws + OFF_SSQA), 2048);
    EpiT e{}; e.mode = 3; e.tabr = (LAS const float*)(lds + TABR_OFF); e.out = (bf16_t*)(ws + OFF_OB); e.osrc = QKV; e.ogain = a.in[16]; e.tabo = tab; e.S.init(MROWS, 2048, gridDim.x, VB(lds));
    run_gemm(lds, (const bf16_t*)(ws + OFF_SA), (const bf16_t*)(ws + OFF_WZ), 2048, 1024, e);
}
extern __shared__ __attribute__((aligned(16))) unsigned char dyn_lds[];
constexpr int LDS_BYTES = 160 * 1024;
__global__ void __launch_bounds__(512, 2) mega(Args a) {
    cg::grid_group grid = cg::this_grid();
    LAS unsigned char* lds = (LAS unsigned char*)dyn_lds;
    unsigned char* ws = a.ws;
#define WB(off) ((bf16_t*)(ws + (off)))
#define WF(off) ((float*)(ws + (off)))
    float* out = a.out;
    signed char* LO = (signed char*)a.out;
    signed char* LO2 = (signed char*)(ws + 187 * MIB + MIB / 2);
    unsigned* bar = (unsigned*)(ws + 246 * MIB);
    XcdBarrier xb; xb.bar = bar; xb.x = xb_xcc_id(); xb.st = (volatile LAS unsigned*)(lds + 163792);
    if (tid_fresh() == 0) {
        const unsigned rank = xb_add(&bar[XB_XCNT(xb.x)], 1u);
        *(LAS int*)(lds + 163780) = (int)xb.x; *(LAS int*)(lds + 163784) = (int)rank; xb.st[0] = 0u; xb.st[1] = 0u; }
    __syncthreads();
    p0_phase(a, lds);
    if (ws == nullptr) grid.sync();
    xcd_barrier(xb);
    if (tid_fresh() == 0) {
        const int xcc = *(LAS const int*)(lds + 163780), rank = *(LAS const int*)(lds + 163784), G = (int)gridDim.x;
        int pre = 0; for (int x = 0; x < 8; ++x) { const unsigned cx = xb_ld(&bar[XB_XCNT(x)]); if (x < xcc) pre += (int)cx; }
        const int vcu = pre + rank;
        *(LAS int*)(lds + 163776) = (G % 8 == 0) ? (vcu % (G / 8)) * 8 + vcu / (G / 8) : vcu; *(LAS int*)(lds + 163788) = vcu; }
    __syncthreads();
    gemm_gu(lds, WB(OFF_SA), WF(OFF_SSQA), WB(OFF_WGU00), WB(OFF_BIG));
    slack_convert(a, lds, 5632, 2, 5);
    xcd_barrier(xb);
    gemm_res(lds, WB(OFF_BIG), WB(OFF_WD00), 2816, HRef{a.in[0], nullptr, nullptr}, HDst{nullptr, WB(OFF_SB), LO, WF(OFF_SSQB)}, 0.5f);
    xcd_barrier(xb);
    fill_rstd_tab(lds, WF(OFF_SSQB), 2304);
    { EpiT e{}; e.mode = 1; e.tabr = (LAS const float*)(lds + TABR_OFF); e.out = WB(OFF_BIG); e.ldo = 2304; e.S.init(MROWS, 2304, gridDim.x, VB(lds)); run_gemm(lds, WB(OFF_SB), WB(OFF_WATTIN), 2304, 1024, e); }
    slack_convert(a, lds, 2304, 5, 10);
    xcd_barrier(xb);
    att_phase(a, lds, WB(OFF_BIG), WB(OFF_SA));
    xcd_barrier(xb);
    gemm_res(lds, WB(OFF_SA), WB(OFF_WATTOUT), 1024, HRef{nullptr, WB(OFF_SB), LO}, HDst{nullptr, WB(OFF_SB), LO, WF(OFF_SSQB)}, 1.0f);
    xcd_barrier(xb);
    gemm_gu(lds, WB(OFF_SB), WF(OFF_SSQB), WB(OFF_WGU01), WB(OFF_BIG));
    slack_convert(a, lds, 5632, 10, 13);
    xcd_barrier(xb);
    gemm_res(lds, WB(OFF_BIG), WB(OFF_WD01), 2816, HRef{nullptr, WB(OFF_SB), LO}, HDst{nullptr, WB(OFF_SA), LO, WF(OFF_SSQA)}, 0.5f);
    xcd_barrier(xb);
    ple_phase(lds, WB(OFF_PB), WB(OFF_WPP0), WB(OFF_BIG), WB(OFF_SA), WF(OFF_SSQA), WB(OFF_WPG0), HRef{nullptr, WB(OFF_SA), LO}, HDst{nullptr, WB(OFF_SB), LO, WF(OFF_SSQB)});
    xcd_barrier(xb);
    cvt_rows_bf16(a.in[1] + (size_t)MROWS * 256, WB(OFF_PB), 64, tid_fresh() & 63, blockIdx.x * 8 + (tid_fresh() >> 6), gridDim.x * 8);
    gemm_gu(lds, WB(OFF_SB), WF(OFF_SSQB), WB(OFF_WGU10), WB(OFF_BIG));
    slack_convert(a, lds, 5632, 13, 17);
    xcd_barrier(xb);
    gemm_res(lds, WB(OFF_BIG), WB(OFF_WD10), 2816, HRef{nullptr, WB(OFF_SB), LO}, HDst{nullptr, WB(OFF_SA), LO, WF(OFF_SSQA)}, 0.5f);
    xcd_barrier(xb);
    fill_rstd_tab(lds, WF(OFF_SSQA), 4352);
    { EpiT e{}; e.mode = 2; e.tabr = (LAS const float*)(lds + TABR_OFF); e.out = WB(OFF_QKV); e.halo = WB(OFF_HALO); e.gates = WF(OFF_GATES); e.S.init(MROWS, 4352, gridDim.x, VB(lds)); run_gemm(lds, WB(OFF_SA), WB(OFF_WQKVG), 4352, 1024, e); }
    slack_convert(a, lds, 4352, 17, 22);
    xcd_barrier(xb);
    gdn_prep_phase(a, lds);
    xcd_barrier(xb);
    gdn_scan_phase(a, lds);
    xcd_barrier(xb);
    gdn_z_phase(a, lds);
    xcd_barrier(xb);
    gemm_res(lds, WB(OFF_OB), WB(OFF_WGO), 2048, HRef{nullptr, WB(OFF_SA), LO}, HDst{nullptr, WB(OFF_H2), LO, WF(OFF_SSQB)}, 1.0f);
    xcd_barrier(xb);
    gemm_gu(lds, WB(OFF_H2), WF(OFF_SSQB), WB(OFF_WGU11), WB(OFF_ACT11));
    const bool pp1_ready = slack_pp(lds, 5632, WB(OFF_PB), WB(OFF_WPP1), WB(203 * MIB + MIB / 2));
    xcd_barrier(xb);
    gemm_res(lds, WB(OFF_ACT11), WB(OFF_WD11), 2816, HRef{nullptr, WB(OFF_H2), LO}, HDst{nullptr, WB(OFF_H3), LO2, WF(OFF_SSQA)}, 0.5f);
    xcd_barrier(xb);
    ple_phase(lds, WB(OFF_PB), WB(OFF_WPP1), WB(203 * MIB + MIB / 2), WB(OFF_H3), WF(OFF_SSQA), WB(OFF_WPG1), HRef{nullptr, WB(OFF_H3), LO2}, HDst{out, nullptr, nullptr, nullptr}, pp1_ready);
#undef WB
#undef WF
}

extern "C" void kernel_launch(void* const* d_in, const int* in_sizes, int n_in, void* d_out, int out_size, void* d_ws, size_t ws_size, hipStream_t stream) {
    static int grid = 0;
    if (!grid) {
        int dev = 0, cus = 0, per = 0;
        (void)hipGetDevice(&dev); (void)hipDeviceGetAttribute(&cus, hipDeviceAttributeMultiprocessorCount, dev);
        (void)hipFuncSetAttribute((const void*)mega, hipFuncAttributeMaxDynamicSharedMemorySize, LDS_BYTES);
        (void)hipOccupancyMaxActiveBlocksPerMultiprocessor(&per, (const void*)mega, 512, LDS_BYTES);
        if (per < 1) { fprintf(stderr, "occupancy query says %d blocks/CU\n", per); per = 1; }
        grid = cus;
    }
    if (n_in != 21 || ws_size < WS_NEED) { fprintf(stderr, "kernel_launch: unexpected inputs / workspace (%d, %zu)\n", n_in, ws_size); return; }
    Args a{};
    for (int i = 0; i < 21; ++i) a.in[i] = (const float*)d_in[i];
    a.out = (float*)d_out; a.ws = (unsigned char*)d_ws;
    int nd = 0;
    auto add = [&](int si, size_t soff, int gi, size_t goff, size_t dstoff, int ldsrc, int col0, int ncols, int K, int dstrow0, int mode) {
        WDesc& w = a.wd[nd++]; w.src_idx = si; w.src_off = (unsigned)soff; w.gain_idx = gi; w.gain_off = (unsigned)goff; w.dst_off = dstoff; w.ldsrc = ldsrc; w.col0 = col0; w.ncols = ncols; w.K = K; w.dstrow0 = dstrow0; w.mode = mode; };
    const size_t offgu[4] = {OFF_WGU00, OFF_WGU01, OFF_WGU10, OFF_WGU11}, offd[4] = {OFF_WD00, OFF_WD01, OFF_WD10, OFF_WD11};
    auto addgu = [&](int f) { add(3, (size_t)f * 1024 * 2816, 2, f * 1024, offgu[f], 2816, 0, 2816, 1024, 0, 1); add(4, (size_t)f * 1024 * 2816, 2, f * 1024, offgu[f], 2816, 0, 2816, 1024, 0, 2); };
    auto addd = [&](int f) { add(5, (size_t)f * 2816 * 1024, -1, 0, offd[f], 1024, 0, 1024, 2816, 0, 0); };
    addgu(0);
    addd(0); add(7, 0, 6, 0, OFF_WATTIN, 2304, 0, 2304, 1024, 0, 0); add(11, 0, -1, 0, OFF_WATTOUT, 1024, 0, 1024, 1024, 0, 0);
    addgu(1); addd(1); add(19, 0, 18, 0, OFF_WPG0, 1024, 0, 1024, 1024, 0, 0); add(20, 0, -1, 0, OFF_WPP0, 1024, 0, 1024, 256, 0, 0);
    addgu(2); addd(2);
    add(12, 0, 6, 1024, OFF_WQKVG, 6176, 0, 4096, 1024, 0, 0); add(12, 0, 6, 1024, OFF_WQKVG, 6176, 6144, 32, 1024, 4096, 0); add(12, 0, 6, 1024, OFF_WZ, 6176, 4096, 2048, 1024, 0, 0); add(17, 0, -1, 0, OFF_WGO, 1024, 0, 1024, 2048, 0, 0);
    addgu(3); addd(3); add(19, 1024 * 1024, 18, 1024, OFF_WPG1, 1024, 0, 1024, 1024, 0, 0); add(20, 256 * 1024, -1, 0, OFF_WPP1, 1024, 0, 1024, 256, 0, 0);
    (void)hipMemsetAsync((unsigned char*)d_ws + 246 * MIB, 0, XCD_BAR_WORDS * 4, stream);
    void* args[] = {&a};
    hipError_t e = hipLaunchCooperativeKernel((const void*)mega, dim3(grid), dim3(512), args, LDS_BYTES, stream);
    if (e != hipSuccess) fprintf(stderr, "cooperative launch failed: %s (grid %d)\n", hipGetErrorString(e), grid);
}
```

```cpp
#include <hip/hip_runtime.h>
#include <hip/hip_cooperative_groups.h>
#include <cstdio>
namespace cg = cooperative_groups;
__device__ __forceinline__ int tid_fresh() { int t = threadIdx.x; asm volatile("" : "+v"(t)); return t; }
namespace pg8 {
#define PG8_LAS __attribute__((address_space(3)))
typedef unsigned short bf16_t;
typedef short bf16x8 __attribute__((ext_vector_type(8)));
typedef float f32x4 __attribute__((ext_vector_type(4)));
typedef unsigned u32x4 __attribute__((ext_vector_type(4)));
constexpr int BM = 256, BK = 64, HALF = 128, HTB = HALF * BK * 2  , STAGE_BYTES = 8 * HTB, NXCD = 8, WGM = 8;

__host__ __device__ __forceinline__ int lds_byte(int r, int c) { const int st = (r >> 4) * 2 + (c >> 5), rr = r & 15, cc = c & 31, ob = rr * 64 + cc * 2; return st * 1024 + (ob ^ (((ob >> 9) & 1) << 5)); }
__host__ __device__ __forceinline__ void stage_rc(int b, int& R, int& C) { const int st = b / 1024, sb = b % 1024, swz = sb ^ (((sb >> 9) & 1) << 5); R = (st >> 1) * 16 + swz / 64; C = (st & 1) * 32 + (swz % 64) / 2; }
__host__ __device__ __forceinline__ int perm32(int rho) { const int n = rho >> 4, i = rho & 15; return 8 * (i >> 2) + 4 * n + (i & 3); }

struct Unit { int pm, pn; };
struct Gemm { const bf16_t* A; const bf16_t* Bt; int M, N, K; int atiled; int krot; };

struct StaticOrder {
    int nM, nN, nwg, G, c;
    __host__ __device__ void init(int M, int N, int G_, int c_) { nM = M / BM; nN = N / BM; nwg = nM * nN; G = G_; c = c_; }
    __host__ __device__ bool next(int i, Unit& u) const {
        const long L = (long)i * G + c; if (L >= nwg) return false;
        int wgid = (int)L; { const int q = nwg / NXCD, r = nwg % NXCD, xcd = wgid % NXCD, off = wgid / NXCD; wgid = (xcd < r ? xcd * (q + 1) : r * (q + 1) + (xcd - r) * q) + off; }
        const int nig = WGM * nN, gid = wgid / nig, fm = gid * WGM, gsz = (nM - fm) < WGM ? (nM - fm) : WGM;
        u.pm = fm + ((wgid % nig) % gsz); u.pn = (wgid % nig) / gsz; return true;
    }
    __device__ __forceinline__ void a_ready(const Unit&) const {}
    __device__ __forceinline__ void done(const Unit&) const {}
};
__device__ __forceinline__ unsigned cvt_pk_bf16(float lo, float hi) { unsigned r; asm volatile("v_cvt_pk_bf16_f32 %0, %1, %2" : "=v"(r) : "v"(lo), "v"(hi)); return r; }
template <class Epi, class Sched, bool STAMP = false>
__device__ __forceinline__ void gemm_phase(PG8_LAS unsigned char* lds, const Gemm g, const Sched& S, const Epi& E, unsigned long long* stamps) {
    const int tid = tid_fresh(), wid = __builtin_amdgcn_readfirstlane(tid >> 6), lane = tid & 63, wr = wid >> 2, wc = wid & 3, fr = lane & 15, fq = lane >> 4;
    const int K = g.K, nt = K / BK;
    int ts_lo = 0, ts_hi = 0, nts = 0; const unsigned long long rt_entry = STAMP ? (unsigned long long)wall_clock64() : 0ull;
#define PG8_STAMP() do { if (STAMP && wid == 0 && nts < 64) { const unsigned long long _c = (unsigned long long)clock64(); \
        ts_lo = (lane == nts) ? (int)(unsigned)_c : ts_lo; ts_hi = (lane == nts) ? (int)(unsigned)(_c >> 32) : ts_hi; ++nts; } } while (0)
    PG8_STAMP();
    unsigned voffA[2], voffB[2];
#pragma unroll
    for (int i = 0; i < 2; ++i) { int R, C; stage_rc(tid * 16 + i * 8192, R, C); const int Rb = Epi::PERM ? ((R & ~31) + perm32(R & 31)) : R;
        voffA[i] = (unsigned)(R * (g.atiled ? BK : K) + C) * 2u; voffB[i] = (unsigned)(Rb * K + C) * 2u; }
    const size_t kstep = (size_t)(BK * 2);
    const size_t hstep = (size_t)HALF * K * 2;
    const size_t tstep = 2 * hstep;
    const size_t kstepA = g.atiled ? (size_t)(BM * BK * 2) : kstep, hstepA = g.atiled ? (size_t)(HALF * BK * 2) : hstep;
    const unsigned ldsw = (unsigned)wid * 1024u;
    const int aoff = lds_byte(wr * 64 + fr, fq * 8), boff = lds_byte(wc * 32 + fr, fq * 8);
#define PG8_SA(b, h) (((b) * 2 + (h)) * HTB)
#define PG8_SB(b, h) ((4 + (b) * 2 + (h)) * HTB)
#define PG8_STAGE(bufoff, gbase, voff) do { _Pragma("unroll") for (int _i = 0; _i < 2; ++_i) \
        __builtin_amdgcn_global_load_lds((const unsigned*)((const char*)(gbase) + (voff)[_i]), (PG8_LAS unsigned*)(lds + (bufoff) + ldsw + _i * 8192), 16, 0, 0); } while (0)
#define PG8_LDA(dst, b, h) do { _Pragma("unroll") for (int m = 0; m < 4; ++m) _Pragma("unroll") for (int k = 0; k < 2; ++k) dst[m][k] = *(const PG8_LAS bf16x8*)(lds + PG8_SA(b, h) + aoff + m * 2048 + k * 1024); } while (0)
#define PG8_LDB(dst, b, h) do { _Pragma("unroll") for (int n = 0; n < 2; ++n) _Pragma("unroll") for (int k = 0; k < 2; ++k) dst[n][k] = *(const PG8_LAS bf16x8*)(lds + PG8_SB(b, h) + boff + n * 2048 + k * 1024); } while (0)
#define PG8_MMA(ai, bj, At, Bt) do { __builtin_amdgcn_s_setprio(1); _Pragma("unroll") for (int m = 0; m < 4; ++m) _Pragma("unroll") for (int n = 0; n < 2; ++n) _Pragma("unroll") for (int k = 0; k < 2; ++k) \
        acc[ai][bj][m][n] = __builtin_amdgcn_mfma_f32_16x16x32_bf16(Bt[n][k], At[m][k], acc[ai][bj][m][n], 0, 0, 0); __builtin_amdgcn_s_setprio(0); } while (0)
#define PG8_WAIT_V(n) asm volatile("s_waitcnt vmcnt(" #n ")" ::: "memory")
#define PG8_WAIT_L(n) asm volatile("s_waitcnt lgkmcnt(" #n ")" ::: "memory")
#define PG8_BAR __builtin_amdgcn_s_barrier()
#define PG8_SCHED __builtin_amdgcn_sched_barrier(0)
    Unit cur, nxt; int ui = 0;
    if (!S.next(0, cur)) return;
    f32x4 acc[2][2][4][2];
#pragma unroll
    for (int a = 0; a < 2; ++a)
#pragma unroll
        for (int b = 0; b < 2; ++b)
#pragma unroll
            for (int m = 0; m < 4; ++m)
#pragma unroll
                for (int n = 0; n < 2; ++n) acc[a][b][m][n] = (f32x4){0.f, 0.f, 0.f, 0.f};
    bf16x8 At[4][2], B0[2][2], B1[2][2];
    const char* cA = (const char*)g.A + (size_t)cur.pm * tstep; const char* cB = (const char*)g.Bt + (size_t)cur.pn * tstep;
    int rc = g.krot ? (2 * (cur.pm & 7)) % nt : 0;
    S.a_ready(cur);
    PG8_STAGE(PG8_SB(0, 0), cB + rc * kstep, voffB); PG8_STAGE(PG8_SA(0, 0), cA + rc * kstepA, voffA); PG8_STAGE(PG8_SB(0, 1), cB + hstep + rc * kstep, voffB); PG8_STAGE(PG8_SA(0, 1), cA + hstepA + rc * kstepA, voffA);
    if (wr == 1) PG8_BAR;
    PG8_WAIT_V(4); PG8_BAR;
    PG8_STAGE(PG8_SB(1, 0), cB + (rc + 1) * kstep, voffB); PG8_STAGE(PG8_SA(1, 0), cA + (rc + 1) * kstepA, voffA); PG8_STAGE(PG8_SB(1, 1), cB + hstep + (rc + 1) * kstep, voffB);
    PG8_WAIT_V(6); PG8_BAR;
    PG8_STAMP();
    for (;;) {
        const bool has_next = S.next(ui + 1, nxt);
        const char* nA = has_next ? (const char*)g.A + (size_t)nxt.pm * tstep : cA; const char* nB = has_next ? (const char*)g.Bt + (size_t)nxt.pn * tstep : cB;
        const int rn = has_next ? (g.krot ? (2 * (nxt.pm & 7)) % nt : 0) : rc;
        for (int t = 0; t < nt; t += 2) {
            const bool last = (t == nt - 2);
            int p0 = t + rc; if (p0 >= nt) p0 -= nt; int p2 = p0 + 2; if (p2 >= nt) p2 -= nt;
            const char* a1 = cA + (size_t)(p0 + 1) * kstepA;
            const char* a2 = last ? nA + (size_t)rn * kstepA : cA + (size_t)p2 * kstepA; const char* b2 = last ? nB + (size_t)rn * kstep : cB + (size_t)p2 * kstep;
            const char* a3 = a2 + kstepA; const char* b3 = b2 + kstep;
            if (last && has_next) S.a_ready(nxt);
            PG8_LDB(B0, 0, 0); PG8_SCHED; PG8_LDA(At, 0, 0); PG8_STAGE(PG8_SA(1, 1), a1 + hstepA, voffA);
            PG8_WAIT_L(8); PG8_BAR; PG8_WAIT_L(0); PG8_MMA(0, 0, At, B0); PG8_BAR; PG8_SCHED;
            PG8_LDB(B1, 0, 1); PG8_STAGE(PG8_SB(0, 0), b2, voffB);
            PG8_BAR; PG8_WAIT_L(0); PG8_MMA(0, 1, At, B1); PG8_BAR;
            PG8_LDA(At, 0, 1); PG8_STAGE(PG8_SA(0, 0), a2, voffA);
            PG8_BAR; PG8_WAIT_L(0); PG8_MMA(1, 0, At, B0); PG8_BAR; PG8_SCHED;
            PG8_STAGE(PG8_SB(0, 1), b2 + hstep, voffB);
            PG8_WAIT_V(6); PG8_BAR; PG8_MMA(1, 1, At, B1); PG8_BAR;
            PG8_LDB(B0, 1, 0); PG8_SCHED; PG8_LDA(At, 1, 0); PG8_STAGE(PG8_SA(0, 1), a2 + hstepA, voffA);
            PG8_WAIT_L(8); PG8_BAR; PG8_WAIT_L(0); PG8_MMA(0, 0, At, B0); PG8_BAR; PG8_SCHED;
            PG8_LDB(B1, 1, 1); PG8_STAGE(PG8_SB(1, 0), b3, voffB);
            PG8_BAR; PG8_WAIT_L(0); PG8_MMA(0, 1, At, B1); PG8_BAR;
            PG8_LDA(At, 1, 1); PG8_STAGE(PG8_SA(1, 0), a3, voffA);
            PG8_BAR; PG8_WAIT_L(0); PG8_MMA(1, 0, At, B0); PG8_BAR; PG8_SCHED;
            PG8_STAGE(PG8_SB(1, 1), b3 + hstep, voffB);
            PG8_WAIT_V(6); PG8_BAR; PG8_MMA(1, 1, At, B1); PG8_BAR;
        }
        PG8_STAMP();
        if constexpr (!Epi::AFTER_DRAIN) { E(acc, cur, wr, wc, fr, fq); S.done(cur); }
        PG8_STAMP();
        if (!has_next) break;
#pragma unroll
        for (int a = 0; a < 2; ++a)
#pragma unroll
            for (int b = 0; b < 2; ++b)
#pragma unroll
                for (int m = 0; m < 4; ++m)
#pragma unroll
                    for (int n = 0; n < 2; ++n) acc[a][b][m][n] = (f32x4){0.f, 0.f, 0.f, 0.f};
        cur = nxt; cA = nA; cB = nB; rc = rn; ++ui;
    }
    PG8_WAIT_V(0);
    if (wr == 0) PG8_BAR;
    PG8_BAR;
    if constexpr (Epi::AFTER_DRAIN) { E.fused(acc, cur, wr, wc, fr, fq, lds, wid, lane); S.done(cur); }
    PG8_STAMP();
    if (STAMP && wid == 0) { stamps[lane] = lane < nts ? (((unsigned long long)(unsigned)ts_hi << 32) | (unsigned)ts_lo) : 0ull;
        if (lane == 62) stamps[62] = rt_entry; if (lane == 63) stamps[63] = (unsigned long long)wall_clock64(); }
#undef PG8_STAMP
#undef PG8_SA
#undef PG8_SB
#undef PG8_STAGE
#undef PG8_LDA
#undef PG8_LDB
#undef PG8_MMA
#undef PG8_WAIT_V
#undef PG8_WAIT_L
#undef PG8_BAR
#undef PG8_SCHED
}
}

using pg8::bf16_t; using pg8::bf16x8; using pg8::f32x4; using pg8::u32x4; using pg8::Unit;
typedef unsigned u32x2 __attribute__((ext_vector_type(2)));
typedef __bf16 bf2_t __attribute__((ext_vector_type(2)));
#define LAS __attribute__((address_space(3)))

constexpr int MROWS = 16384;
#define VCU(lds) (*(LAS const int*)((lds) + 163788))
#define VB(lds) (*(LAS const int*)((lds) + 163776))
constexpr size_t MIB = 1048576;
constexpr size_t OFF_WZ = 0, OFF_WGO = 4 * MIB, OFF_WGU11 = 8 * MIB, OFF_WD11 = 19 * MIB, OFF_WPG1 = 24 * MIB + MIB / 2, OFF_WPP1 = 26 * MIB + MIB / 2,
    OFF_WQKVG = 27 * MIB, OFF_WE = 35 * MIB + MIB / 2,
    OFF_WGU00 = OFF_WE, OFF_WD00 = OFF_WGU00 + 11 * MIB, OFF_WGU01 = OFF_WD00 + 11 * MIB / 2, OFF_WD01 = OFF_WGU01 + 11 * MIB,
    OFF_WATTIN = OFF_WD01 + 11 * MIB / 2, OFF_WATTOUT = OFF_WATTIN + 9 * MIB / 2, OFF_WPG0 = OFF_WATTOUT + 2 * MIB, OFF_WPP0 = OFF_WPG0 + 2 * MIB,
    OFF_WGU10 = OFF_WPP0 + MIB / 2, OFF_WD10 = OFF_WGU10 + 11 * MIB,
    OFF_SB = 94 * MIB, OFF_BIG = 126 * MIB, OFF_SSQA = 235 * MIB + MIB / 2, OFF_SSQB = OFF_SSQA + MIB, OFF_PB = OFF_SSQB + MIB, OFF_SA = 263422976,
    WS_NEED = OFF_SA + 32 * MIB,
    OFF_QKV = OFF_WE, OFF_GATES = OFF_QKV + 128 * MIB, OFF_HALO = OFF_GATES + 2 * MIB, OFF_TINV = OFF_HALO + 6 * MIB, OFF_ATTN = OFF_TINV + 32 * MIB,
    OFF_GB = OFF_WQKVG, OFF_OB = OFF_TINV, OFF_H2 = OFF_WE, OFF_ACT11 = OFF_H2 + 32 * MIB, OFF_H3 = OFF_ACT11 + 88 * MIB, OFF_PP1 = OFF_WE;
static_assert(OFF_WD10 + 11 * MIB / 2 == OFF_SB, "weights map");
static_assert(OFF_ATTN + 32 * MIB == OFF_SSQA, "gdn map");
static_assert(OFF_PB + 8 * MIB <= OFF_SA && WS_NEED <= 296977568ull, "ws size");

struct WDesc { unsigned long long dst_off; unsigned src_off, gain_off; int src_idx, gain_idx, ldsrc, col0, ncols, K, dstrow0, mode; };
constexpr int NDESC = 22;
struct Args { const float* in[21]; float* out; unsigned char* ws; WDesc wd[NDESC]; };

typedef float f2v_t __attribute__((ext_vector_type(2)));
__device__ __forceinline__ unsigned pk2(float lo, float hi) { const f2v_t f = {lo, hi}; const bf2_t r = __builtin_convertvector(f, bf2_t); return __builtin_bit_cast(unsigned, r); }
__device__ __forceinline__ float bf_lo(unsigned u) { return __uint_as_float(u << 16); }
__device__ __forceinline__ float bf_hi(unsigned u) { return __uint_as_float(u & 0xffff0000u); }
__device__ __forceinline__ float bf2f(bf16_t b) { return __uint_as_float(((unsigned)b) << 16); }
__device__ __forceinline__ float sigm(float x) { return __builtin_amdgcn_rcpf(1.f + __expf(-x)); }
__device__ __forceinline__ float silu_(float x) { return x * __builtin_amdgcn_rcpf(1.f + __expf(-x)); }
__device__ __forceinline__ float wave_sum(float v) {
#pragma unroll
    for (int o = 1; o < 64; o <<= 1) v += __shfl_xor(v, o);
    return v;
}
__device__ __forceinline__ float row_rstd(const float* ssq, int row) {
    const f32x4* p = (const f32x4*)(ssq + (size_t)row * 16);
    const f32x4 a = p[0], b = p[1], c = p[2], d = p[3];
    const float s = (((a.x + a.y) + (a.z + a.w)) + ((b.x + b.y) + (b.z + b.w))) + (((c.x + c.y) + (c.z + c.w)) + ((d.x + d.y) + (d.z + d.w)));
    return rsqrtf(s * (1.f / 1024.f) + 1e-6f);
}
__device__ __forceinline__ float dot2bf(unsigned a, unsigned b, float c) {
    return __builtin_amdgcn_fdot2_f32_bf16(__builtin_bit_cast(bf2_t, a), __builtin_bit_cast(bf2_t, b), c, false);
}

constexpr int TABR_OFF = 131072, TABO_OFF = 131072 + 8192;
__device__ __forceinline__ int unit_ordinal(const pg8::StaticOrder& S, const Unit& u) {
    int r = 0;
    for (int i = 0; i < 8; ++i) { Unit t; if (S.next(i, t) && t.pm == u.pm && t.pn == u.pn) r = i; }
    return r;
}
struct EpiT {
    static constexpr bool PERM = true, AFTER_DRAIN = false;
    int mode;
    LAS const float* tabr; bf16_t* out; int ldo;
    bf16_t* halo; float* gates;
    const bf16_t* osrc; const float* ogain; LAS const float* tabo; pg8::StaticOrder S;
    __device__ __forceinline__ void operator()(const f32x4 (&acc)[2][2][4][2], const Unit& u, int wr, int wc, int fr_, int fq_) const {
        int fr = fr_, fq = fq_; asm volatile("" : "+v"(fr), "+v"(fq));
        const int ui = unit_ordinal(S, u);
        if (mode == 3) {
            const int cg = wc * 32 + 8 * fq;
            const f32x4 ga = *(const f32x4*)(ogain + cg), gb = *(const f32x4*)(ogain + cg + 4);
#pragma unroll
            for (int ai = 0; ai < 2; ++ai) {
                u32x4 o8[4][2];
#pragma unroll
                for (int m = 0; m < 4; ++m)
#pragma unroll
                    for (int bj = 0; bj < 2; ++bj) o8[m][bj] = *(const u32x4*)(osrc + (size_t)(u.pm * 256 + ai * 128 + wr * 64 + m * 16 + fr) * 4096 + 2048 + u.pn * 256 + bj * 128 + cg);
#pragma unroll
                for (int m = 0; m < 4; ++m) {
                    const int rl = ai * 128 + wr * 64 + m * 16 + fr, row = u.pm * 256 + rl;
                    const float rs = tabr[ui * 256 + rl];
#pragma unroll
                    for (int bj = 0; bj < 2; ++bj) {
                        const int c0 = u.pn * 256 + bj * 128 + cg;
                        const f32x4 v0 = acc[ai][bj][m][0] * rs, v1 = acc[ai][bj][m][1] * rs;
                        const float ro = tabo[ui * 512 + rl * 2 + bj];
                        const u32x4 o = o8[m][bj];
                        u32x4 w;
                        w.x = pk2(bf_lo(o.x) * ro * ga[0] * silu_(v0[0]), bf_hi(o.x) * ro * ga[1] * silu_(v0[1]));
                        w.y = pk2(bf_lo(o.y) * ro * ga[2] * silu_(v0[2]), bf_hi(o.y) * ro * ga[3] * silu_(v0[3]));
                        w.z = pk2(bf_lo(o.z) * ro * gb[0] * silu_(v1[0]), bf_hi(o.z) * ro * gb[1] * silu_(v1[1]));
                        w.w = pk2(bf_lo(o.w) * ro * gb[2] * silu_(v1[2]), bf_hi(o.w) * ro * gb[3] * silu_(v1[3]));
                        *(u32x4*)(out + (size_t)row * 2048 + c0) = w;
                    }
                }
            }
            return;
        }
#pragma unroll
        for (int ai = 0; ai < 2; ++ai)
#pragma unroll
            for (int m = 0; m < 4; ++m) {
                const int rl = ai * 128 + wr * 64 + m * 16 + fr, row = u.pm * 256 + rl;
                const float rs = tabr[ui * 256 + rl];
                if (mode == 0) {
                    const f32x4 g0 = acc[ai][0][m][0] * rs, g1 = acc[ai][0][m][1] * rs, u0 = acc[ai][1][m][0] * rs, u1 = acc[ai][1][m][1] * rs;
                    u32x4 w;
                    w.x = pk2(silu_(g0[0]) * u0[0], silu_(g0[1]) * u0[1]); w.y = pk2(silu_(g0[2]) * u0[2], silu_(g0[3]) * u0[3]);
                    w.z = pk2(silu_(g1[0]) * u1[0], silu_(g1[1]) * u1[1]); w.w = pk2(silu_(g1[2]) * u1[2], silu_(g1[3]) * u1[3]);
                    { const int f0 = u.pn * 128 + wc * 32 + 8 * fq;
                      *(u32x4*)(out + ((size_t)(u.pm * 44 + (f0 >> 6)) * 256 + rl) * 64 + (f0 & 63)) = w; }
                } else {
#pragma unroll
                    for (int bj = 0; bj < 2; ++bj) {
                        const int c0 = u.pn * 256 + bj * 128 + wc * 32 + 8 * fq;
                        const f32x4 v0 = acc[ai][bj][m][0] * rs, v1 = acc[ai][bj][m][1] * rs;
                        u32x4 w; w.x = pk2(v0[0], v0[1]); w.y = pk2(v0[2], v0[3]); w.z = pk2(v1[0], v1[1]); w.w = pk2(v1[2], v1[3]);
                        if (mode == 1) { *(u32x4*)(out + (size_t)row * ldo + c0) = w; }
                        else if (c0 < 4096) {
                            *(u32x4*)(out + (size_t)row * 4096 + c0) = w;
                            const int t = row & 4095;
                            if ((t & 63) >= 61) *(u32x4*)(halo + ((size_t)((row >> 12) * 64 + (t >> 6)) * 3 + ((t & 63) - 61)) * 4096 + c0) = w;
                        } else if (c0 < 4128) {
                            float* gp = gates + (size_t)row * 32 + (c0 - 4096);
                            *(f32x4*)gp = v0; *(f32x4*)(gp + 4) = v1;
                        }
                    }
                }
            }
    }
};
__device__ __forceinline__ float lo_scale(float hif) { return __uint_as_float(__float_as_uint(hif) & 0x7f800000u) * 3.0517578125e-5f; }
struct EpiF {
    static constexpr bool PERM = false, AFTER_DRAIN = false;
    int mode;
    const float* xin; const bf16_t* hbin; const signed char* loin;
    float* fout; bf16_t* hb; signed char* loout;
    float* ssqo; float scale; LAS const float* tabr; bf16_t* pp; pg8::StaticOrder S;
    __device__ __forceinline__ void operator()(const f32x4 (&acc)[2][2][4][2], const Unit& u, int wr, int wc, int fr_, int fq_) const {
        int fr = fr_, fq = fq_; asm volatile("" : "+v"(fr), "+v"(fq));
        const int ui = mode == 2 ? unit_ordinal(S, u) : 0;
        const size_t cb = (size_t)u.pn * 256 + wc * 32 + 4 * fq;
#pragma unroll
        for (int ai = 0; ai < 2; ++ai)
#pragma unroll
            for (int mp = 0; mp < 2; ++mp) {
                if (mode == 1) {
#pragma unroll
                    for (int m2 = 0; m2 < 2; ++m2)
#pragma unroll
                        for (int bj = 0; bj < 2; ++bj)
#pragma unroll
                            for (int n = 0; n < 2; ++n) { const f32x4 v = acc[ai][bj][2 * mp + m2][n]; u32x2 w; w.x = pk2(v[0], v[1]); w.y = pk2(v[2], v[3]);
                                *(u32x2*)(pp + (size_t)(u.pm * 256 + ai * 128 + wr * 64 + (2 * mp + m2) * 16 + fr) * 1024 + cb + bj * 128 + n * 16) = w; }
                    continue;
                }
                f32x4 hv[2][2][2]; u32x2 qv[2][2][2];
                if (xin) {
#pragma unroll
                    for (int m2 = 0; m2 < 2; ++m2)
#pragma unroll
                        for (int bj = 0; bj < 2; ++bj)
#pragma unroll
                            for (int n = 0; n < 2; ++n) hv[m2][bj][n] = *(const f32x4*)(xin + (size_t)(u.pm * 256 + ai * 128 + wr * 64 + (2 * mp + m2) * 16 + fr) * 1024 + cb + bj * 128 + n * 16);
                } else {
                    u32x2 hi2[2][2][2]; unsigned lo4[2][2][2];
#pragma unroll
                    for (int m2 = 0; m2 < 2; ++m2)
#pragma unroll
                        for (int bj = 0; bj < 2; ++bj)
#pragma unroll
                            for (int n = 0; n < 2; ++n) { const size_t idx = (size_t)(u.pm * 256 + ai * 128 + wr * 64 + (2 * mp + m2) * 16 + fr) * 1024 + cb + bj * 128 + n * 16;
                                hi2[m2][bj][n] = *(const u32x2*)(hbin + idx); lo4[m2][bj][n] = *(const unsigned*)(loin + idx);
                                if (mode == 2) qv[m2][bj][n] = *(const u32x2*)(pp + idx); }
#pragma unroll
                    for (int m2 = 0; m2 < 2; ++m2)
#pragma unroll
                        for (int bj = 0; bj < 2; ++bj)
#pragma unroll
                            for (int n = 0; n < 2; ++n) { const u32x2 hh = hi2[m2][bj][n]; const unsigned ll = lo4[m2][bj][n];
                                const float h0 = bf_lo(hh.x), h1 = bf_hi(hh.x), h2 = bf_lo(hh.y), h3 = bf_hi(hh.y);
                                f32x4 r;
                                r[0] = h0 + (float)(int)(signed char)(ll & 0xffu) * lo_scale(h0); r[1] = h1 + (float)(int)(signed char)((ll >> 8) & 0xffu) * lo_scale(h1);
                                r[2] = h2 + (float)(int)(signed char)((ll >> 16) & 0xffu) * lo_scale(h2); r[3] = h3 + (float)(int)(signed char)(ll >> 24) * lo_scale(h3);
                                hv[m2][bj][n] = r; }
                }
                if (xin && mode == 2) {
#pragma unroll
                    for (int m2 = 0; m2 < 2; ++m2)
#pragma unroll
                        for (int bj = 0; bj < 2; ++bj)
#pragma unroll
                            for (int n = 0; n < 2; ++n) qv[m2][bj][n] = *(const u32x2*)(pp + (size_t)(u.pm * 256 + ai * 128 + wr * 64 + (2 * mp + m2) * 16 + fr) * 1024 + cb + bj * 128 + n * 16);
                }
#pragma unroll
                for (int m2 = 0; m2 < 2; ++m2) {
                    const int m = 2 * mp + m2, rl = ai * 128 + wr * 64 + m * 16 + fr, row = u.pm * 256 + rl;
                    const float rs = mode == 2 ? tabr[ui * 256 + rl] : 0.f;
                    float sq = 0.f;
#pragma unroll
                    for (int bj = 0; bj < 2; ++bj)
#pragma unroll
                        for (int n = 0; n < 2; ++n) {
                            const size_t idx = (size_t)row * 1024 + cb + bj * 128 + n * 16;
                            const f32x4 v = acc[ai][bj][m][n];
                            f32x4 h = hv[m2][bj][n];
                            if (mode == 0) h = h + v * scale;
                            else { const f32x4 q = {bf_lo(qv[m2][bj][n].x), bf_hi(qv[m2][bj][n].x), bf_lo(qv[m2][bj][n].y), bf_hi(qv[m2][bj][n].y)};
                                h[0] += sigm(v[0] * rs) * q[0]; h[1] += sigm(v[1] * rs) * q[1]; h[2] += sigm(v[2] * rs) * q[2]; h[3] += sigm(v[3] * rs) * q[3]; }
                            if (fout) *(f32x4*)(fout + idx) = h;
                            else {
                                u32x2 w; w.x = pk2(h[0], h[1]); w.y = pk2(h[2], h[3]); *(u32x2*)(hb + idx) = w;
                                const float g0 = bf_lo(w.x), g1 = bf_hi(w.x), g2 = bf_lo(w.y), g3 = bf_hi(w.y);
                                const float q0 = __builtin_amdgcn_fmed3f(rintf((h[0] - g0) * __uint_as_float(0x86800000u - (__float_as_uint(g0) & 0x7f800000u))), -128.f, 127.f);
                                const float q1 = __builtin_amdgcn_fmed3f(rintf((h[1] - g1) * __uint_as_float(0x86800000u - (__float_as_uint(g1) & 0x7f800000u))), -128.f, 127.f);
                                const float q2 = __builtin_amdgcn_fmed3f(rintf((h[2] - g2) * __uint_as_float(0x86800000u - (__float_as_uint(g2) & 0x7f800000u))), -128.f, 127.f);
                                const float q3 = __builtin_amdgcn_fmed3f(rintf((h[3] - g3) * __uint_as_float(0x86800000u - (__float_as_uint(g3) & 0x7f800000u))), -128.f, 127.f);
                                *(unsigned*)(loout + idx) = ((unsigned)(int)q0 & 0xffu) | (((unsigned)(int)q1 & 0xffu) << 8) | (((unsigned)(int)q2 & 0xffu) << 16) | (((unsigned)(int)q3 & 0xffu) << 24);
                            }
                            sq += (h[0] * h[0] + h[1] * h[1]) + (h[2] * h[2] + h[3] * h[3]);
                        }
                    if (ssqo) { sq += __shfl_xor(sq, 16); sq += __shfl_xor(sq, 32); if (fq == 0) ssqo[(size_t)row * 16 + u.pn * 4 + wc] = sq; }
                }
            }
    }
};
__device__ __forceinline__ void fill_rstd_tab(LAS unsigned char* lds, const float* ssq, int N) {
    const int tid = tid_fresh(), rl = tid & 255, hi = tid >> 8;
    LAS float* tab = (LAS float*)(lds + TABR_OFF);
    pg8::StaticOrder S; S.init(MROWS, N, gridDim.x, VB(lds));
    f32x4 v[4][4]; bool ok[4];
#pragma unroll
    for (int ps = 0; ps < 4; ++ps) { Unit u; ok[ps] = S.next(2 * ps + hi, u);
        if (ok[ps]) { const f32x4* p = (const f32x4*)(ssq + (size_t)(u.pm * 256 + rl) * 16); v[ps][0] = p[0]; v[ps][1] = p[1]; v[ps][2] = p[2]; v[ps][3] = p[3]; } }
#pragma unroll
    for (int ps = 0; ps < 4; ++ps) if (ok[ps]) {
        const f32x4 a = v[ps][0], b = v[ps][1], c = v[ps][2], d = v[ps][3];
        const float s = (((a.x + a.y) + (a.z + a.w)) + ((b.x + b.y) + (b.z + b.w))) + (((c.x + c.y) + (c.z + c.w)) + ((d.x + d.y) + (d.z + d.w)));
        tab[(2 * ps + hi) * 256 + rl] = rsqrtf(s * (1.f / 1024.f) + 1e-6f); }
    __syncthreads();
}
template <class Epi> __device__ __forceinline__ void run_gemm(LAS unsigned char* lds, const bf16_t* A, const bf16_t* Bt, int N, int K, const Epi& E, int atiled = 0, int krot = 0) {
    pg8::StaticOrder S; S.init(MROWS, N, gridDim.x, VB(lds));
    const pg8::Gemm g{A, Bt, MROWS, N, K, atiled, krot};
    pg8::gemm_phase<Epi, pg8::StaticOrder, false>(lds, g, S, E, nullptr);
}
__device__ __forceinline__ void gemm_gu(LAS unsigned char* lds, const bf16_t* A, const float* ssq, const bf16_t* W, bf16_t* act) {
    fill_rstd_tab(lds, ssq, 5632);
    EpiT e{}; e.mode = 0; e.tabr = (LAS const float*)(lds + TABR_OFF); e.out = act; e.S.init(MROWS, 5632, gridDim.x, VB(lds)); run_gemm(lds, A, W, 5632, 1024, e);
}
struct HRef { const float* x; const bf16_t* hi; const signed char* lo; };
struct HDst { float* f; bf16_t* hi; signed char* lo; float* ssq; };
__device__ __forceinline__ void gemm_res(LAS unsigned char* lds, const bf16_t* A, const bf16_t* W, int K, HRef in, HDst out, float scale) {
    EpiF e{}; e.mode = 0; e.xin = in.x; e.hbin = in.hi; e.loin = in.lo; e.fout = out.f; e.hb = out.hi; e.loout = out.lo; e.ssqo = out.ssq; e.scale = scale;
    run_gemm(lds, A, W, 1024, K, e, K == 2816 ? 1 : 0, 0);
}
__device__ __forceinline__ void ple_phase(LAS unsigned char* lds, const bf16_t* pb, const bf16_t* Wpp, bf16_t* pp, const bf16_t* A, const float* ssqi, const bf16_t* Wpg, HRef in, HDst out, bool pp_ready = false) {
    fill_rstd_tab(lds, ssqi, 1024);
    pg8::StaticOrder S; S.init(MROWS, 1024, gridDim.x, VB(lds));
    if (!pp_ready) {
        run_gemm(lds, pb, Wpp, 1024, 256, EpiF{1, nullptr, nullptr, nullptr, nullptr, nullptr, nullptr, nullptr, 0.f, nullptr, pp, S});
        __threadfence(); __syncthreads(); __builtin_amdgcn_fence(__ATOMIC_ACQUIRE, "agent"); }
    run_gemm(lds, A, Wpg, 1024, 1024, EpiF{2, in.x, in.hi, in.lo, out.f, out.hi, out.lo, out.ssq, 0.f, (LAS const float*)(lds + TABR_OFF), pp, S});
}

__device__ __forceinline__ void cvt_rows_bf16(const float* src, bf16_t* dst, int ncol4  , int lane, int gw, int NGW) {
    for (int row = gw; row < MROWS; row += NGW) {
        const f32x4 v = *(const f32x4*)(src + (size_t)row * 256 + 4 * lane);
        u32x2 w; w.x = pk2(v[0], v[1]); w.y = pk2(v[2], v[3]);
        *(u32x2*)(dst + (size_t)row * 256 + 4 * lane) = w;
    }
}
__device__ __forceinline__ void convert_descs(const Args& a, int d_lo, int d_hi, int rank, int n) {
    const int lane = tid_fresh() & 63, wave = tid_fresh() >> 6;
    int total = 0;
    for (int d = d_lo; d < d_hi; ++d) total += (a.wd[d].K >> 6) * (a.wd[d].ncols >> 5);
    const int kc = lane & 7, ng = lane >> 3;
    for (int it = rank * 8 + wave; it < total; it += n * 8) {
        int r = it, d = d_lo;
        for (;;) { const int c = (a.wd[d].K >> 6) * (a.wd[d].ncols >> 5); if (r < c) break; r -= c; ++d; }
        const float* src = a.in[a.wd[d].src_idx] + a.wd[d].src_off; const float* gain = a.wd[d].gain_idx >= 0 ? a.in[a.wd[d].gain_idx] + a.wd[d].gain_off : nullptr; bf16_t* dst = (bf16_t*)(a.ws + a.wd[d].dst_off);
        const int ldsrc = a.wd[d].ldsrc, col0 = a.wd[d].col0, K = a.wd[d].K, dstrow0 = a.wd[d].dstrow0, mode = a.wd[d].mode;
        const int nblk = a.wd[d].ncols >> 5, kb = r / nblk, nb = r % nblk, k0 = 64 * kb + 8 * kc, n0 = 32 * nb + 4 * ng;
        f32x4 v[8];
#pragma unroll
        for (int i = 0; i < 8; ++i) v[i] = *(const f32x4*)(src + (size_t)(k0 + i) * ldsrc + col0 + n0);
        if (gain) { const f32x4 g0 = *(const f32x4*)(gain + k0), g1 = *(const f32x4*)(gain + k0 + 4);
#pragma unroll
            for (int i = 0; i < 4; ++i) { v[i] = v[i] * g0[i]; v[4 + i] = v[4 + i] * g1[i]; } }
#pragma unroll
        for (int j = 0; j < 4; ++j) { const int f = n0 + j;
            const int drow = mode == 0 ? dstrow0 + f : (256 * (f >> 7) + (f & 127) + (mode == 2 ? 128 : 0));
            u32x4 o; o.x = pk2(v[0][j], v[1][j]); o.y = pk2(v[2][j], v[3][j]); o.z = pk2(v[4][j], v[5][j]); o.w = pk2(v[6][j], v[7][j]);
            *(u32x4*)(dst + (size_t)drow * K + k0) = o; }
    }
}
__device__ __forceinline__ bool slack_pp(LAS unsigned char* lds, int N, const bf16_t* pb, const bf16_t* Wpp, bf16_t* pp) {
    const int G = (int)gridDim.x, nwg = 64 * (N >> 8), busy_last = nwg - ((nwg + G - 1) / G - 1) * G, c = VB(lds);
    if (busy_last >= G) return false;
    if (c >= busy_last) { pg8::StaticOrder S; S.init(MROWS, 1024, G - busy_last, c - busy_last); const pg8::Gemm g{pb, Wpp, MROWS, 1024, 256, 0, 0};
        const EpiF e{1, nullptr, nullptr, nullptr, nullptr, nullptr, nullptr, nullptr, 0.f, nullptr, pp, S}; pg8::gemm_phase<EpiF, pg8::StaticOrder, false>(lds, g, S, e, nullptr); }
    return true;
}
__device__ __forceinline__ void slack_convert(const Args& a, LAS unsigned char* lds, int N, int d_lo, int d_hi) {
    const int G = (int)gridDim.x, nwg = 64 * (N >> 8), busy_last = nwg - ((nwg + G - 1) / G - 1) * G, c = VB(lds);
    if (busy_last >= G) convert_descs(a, d_lo, d_hi, c, G);
    else if (c >= busy_last) convert_descs(a, d_lo, d_hi, c - busy_last, G - busy_last);
}
__device__ __forceinline__ void p0_phase(const Args& a, LAS unsigned char* lds) {
    const int lane = tid_fresh() & 63, wave = tid_fresh() >> 6;
    const int gw = blockIdx.x * 8 + wave, NGW = gridDim.x * 8;
    convert_descs(a, 0, 2, blockIdx.x, gridDim.x);
    const float* x = a.in[0]; bf16_t* xb = (bf16_t*)(a.ws + OFF_SA); float* ssq = (float*)(a.ws + OFF_SSQA);
    for (int row = gw; row < MROWS; row += NGW) {
        float s = 0.f;
#pragma unroll
        for (int j = 0; j < 4; ++j) { const f32x4 v = *(const f32x4*)(x + (size_t)row * 1024 + 256 * j + 4 * lane);
            s += (v[0] * v[0] + v[1] * v[1]) + (v[2] * v[2] + v[3] * v[3]);
            u32x2 w; w.x = pk2(v[0], v[1]); w.y = pk2(v[2], v[3]); *(u32x2*)(xb + (size_t)row * 1024 + 256 * j + 4 * lane) = w; }
        s = wave_sum(s);
        if (lane < 16) ssq[(size_t)row * 16 + lane] = lane == 0 ? s : 0.f;
    }
    cvt_rows_bf16(a.in[1], (bf16_t*)(a.ws + OFF_PB), 64, lane, gw, NGW);
}
#define XB_TMO      128
#define XB_XCNT(j)  (256  + 64 * (j))
#define XB_XSUB(j)  (1280 + 64 * (j))
#define XB_XGEN(j)  (2304 + 64 * (j))
#define XB_TOP      3328
#define XB_TOPGEN   3392
#define XCD_BAR_WORDS 3456
#define XB_SPIN_CAP (1u << 18)
__device__ __forceinline__ unsigned xb_ld(unsigned* p)              { return __hip_atomic_load(p, __ATOMIC_RELAXED, __HIP_MEMORY_SCOPE_AGENT); }
__device__ __forceinline__ unsigned xb_add(unsigned* p, unsigned v) { return __hip_atomic_fetch_add(p, v, __ATOMIC_RELAXED, __HIP_MEMORY_SCOPE_AGENT); }
__device__ __forceinline__ unsigned xb_xcc_id() { return (unsigned)__builtin_amdgcn_s_getreg((3 << 11) | 20) & 0xFu; }
#define XB_SPIN(cond, bar) do { unsigned _sp = 0; while (cond) { __builtin_amdgcn_s_sleep(1); \
    if ((++_sp & 255u) == 0u) { if (xb_ld(&(bar)[XB_TMO])) break; if (_sp > XB_SPIN_CAP) { atomicAdd(&(bar)[XB_TMO], 1u); break; } } } } while (0)

struct XcdBarrier {
    unsigned* bar; unsigned x;
    volatile LAS unsigned* st;
};

__device__ __forceinline__ XcdBarrier xcd_barrier_post(unsigned* bar, volatile LAS unsigned* st) {
    XcdBarrier b; b.bar = bar; b.x = xb_xcc_id(); b.st = st;
    if (tid_fresh() == 0) (void)xb_add(&bar[XB_XCNT(b.x)], 1u);
    return b;
}
__device__ __forceinline__ void xcd_barrier_complete(unsigned* bar, unsigned x, unsigned& nloc, unsigned& nx) {
    const unsigned G = gridDim.x * gridDim.y * gridDim.z;
    unsigned sum, cnt, mine, sp = 0u;
    for (;;) {
        sum = 0u; cnt = 0u; mine = 0u;
#pragma unroll
        for (unsigned j = 0; j < 16; ++j) { const unsigned c = xb_ld(&bar[XB_XCNT(j)]); sum += c; cnt += (c > 0u) ? 1u : 0u; mine = (j == x) ? c : mine; }
        if (sum == G) break;
        __builtin_amdgcn_s_sleep(1);
        if ((++sp & 255u) == 0u) { if (xb_ld(&bar[XB_TMO])) break; if (sp > XB_SPIN_CAP) { atomicAdd(&bar[XB_TMO], 1u); break; } }
    }
    nloc = mine > 0u ? mine : 1u; nx = cnt > 0u ? cnt : 1u;
}

__device__ __forceinline__ void xcd_barrier(const XcdBarrier& b) {
    asm volatile("s_waitcnt vmcnt(0)" ::: "memory");
    __syncthreads();
    if (tid_fresh() == 0) {
        unsigned* bar = b.bar;
        __builtin_amdgcn_s_waitcnt(0);
        unsigned nloc = b.st[0], nx = b.st[1];
        if (nloc == 0u) { xcd_barrier_complete(bar, b.x, nloc, nx); b.st[0] = nloc; b.st[1] = nx; }
        const unsigned old = xb_add(&bar[XB_XSUB(b.x)], 1u);
        const unsigned gen = old / nloc;
        if (old + 1u == (gen + 1u) * nloc) {
            __builtin_amdgcn_fence(__ATOMIC_RELEASE, "agent");
            asm volatile("s_waitcnt vmcnt(0)" ::: "memory");
            const unsigned og = xb_add(&bar[XB_TOP], 1u);
            const unsigned tg = og / nx;
            if (og + 1u == (tg + 1u) * nx) xb_add(&bar[XB_TOPGEN], 1u);
            else XB_SPIN(xb_ld(&bar[XB_TOPGEN]) == tg, bar);
            __builtin_amdgcn_fence(__ATOMIC_ACQUIRE, "agent");
            xb_add(&bar[XB_XGEN(b.x)], 1u);
            asm volatile("s_waitcnt vmcnt(0)" ::: "memory");
        } else {
            XB_SPIN(xb_ld(&bar[XB_XGEN(b.x)]) == gen, bar);
            __builtin_amdgcn_fence(__ATOMIC_ACQUIRE, "agent");
            asm volatile("s_waitcnt vmcnt(0)" ::: "memory");
        }
    }
    __syncthreads();
}

__device__ __forceinline__ void stage_k(const bf16_t* src, LAS unsigned char* Kt, int lane) {
#pragma unroll
    for (int i = 0; i < 8; ++i) { const int r = (lane >> 3) + 8 * i;
        const u32x4 v = *(const u32x4*)(src + (size_t)r * 2304 + (lane & 7) * 8);
        *(LAS u32x4*)(Kt + r * 144 + (lane & 7) * 16) = v; }
}
__device__ __forceinline__ void stage_k_norm(const bf16_t* src, const float* kg, LAS unsigned char* Kt, int lane) {
    const f32x4 g0 = *(const f32x4*)(kg + (lane & 7) * 8), g1 = *(const f32x4*)(kg + (lane & 7) * 8 + 4);
#pragma unroll
    for (int i = 0; i < 8; ++i) { const int r = (lane >> 3) + 8 * i;
        const u32x4 v = *(const u32x4*)(src + (size_t)r * 2304 + (lane & 7) * 8);
        float f[8] = {bf_lo(v.x), bf_hi(v.x), bf_lo(v.y), bf_hi(v.y), bf_lo(v.z), bf_hi(v.z), bf_lo(v.w), bf_hi(v.w)};
        float s = 0.f;
#pragma unroll
        for (int e = 0; e < 8; ++e) s += f[e] * f[e];
        s += __shfl_xor(s, 1); s += __shfl_xor(s, 2); s += __shfl_xor(s, 4);
        const float inv = rsqrtf(s * (1.f / 64.f) + 1e-6f);
        u32x4 w; w.x = pk2(f[0] * inv * g0[0], f[1] * inv * g0[1]); w.y = pk2(f[2] * inv * g0[2], f[3] * inv * g0[3]);
        w.z = pk2(f[4] * inv * g1[0], f[5] * inv * g1[1]); w.w = pk2(f[6] * inv * g1[2], f[7] * inv * g1[3]);
        *(LAS u32x4*)(Kt + r * 144 + (lane & 7) * 16) = w; }
}
__device__ __forceinline__ void stage_vt(const bf16_t* src, LAS unsigned char* Vt, int lane) {
#pragma unroll
    for (int c = 0; c < 8; ++c) {
        const u32x4 v = *(const u32x4*)(src + (size_t)lane * 2304 + c * 8);
        LAS unsigned short* p = (LAS unsigned short*)(Vt + (8 * c) * 144 + lane * 2);
        p[0 * 72] = (unsigned short)(v.x & 0xffffu); p[1 * 72] = (unsigned short)(v.x >> 16);
        p[2 * 72] = (unsigned short)(v.y & 0xffffu); p[3 * 72] = (unsigned short)(v.y >> 16);
        p[4 * 72] = (unsigned short)(v.z & 0xffffu); p[5 * 72] = (unsigned short)(v.z >> 16);
        p[6 * 72] = (unsigned short)(v.w & 0xffffu); p[7 * 72] = (unsigned short)(v.w >> 16);
    }
}
typedef short s16x4 __attribute__((ext_vector_type(4)));
__device__ __forceinline__ s16x4 lds_tr4(LAS const unsigned char* p) { return __builtin_amdgcn_ds_read_tr16_b64_v4i16((LAS s16x4*)p); }
__device__ __forceinline__ void tile_fetch(u32x4 (&r)[8], const bf16_t* src, int lane) {
#pragma unroll
    for (int i = 0; i < 8; ++i) r[i] = *(const u32x4*)(src + (size_t)((lane >> 3) + 8 * i) * 2304 + (lane & 7) * 8);
}
__device__ __forceinline__ void tile_park(const u32x4 (&r)[8], LAS unsigned char* T, int lane) {
#pragma unroll
    for (int i = 0; i < 8; ++i) *(LAS u32x4*)(T + ((lane >> 3) + 8 * i) * 144 + (lane & 7) * 16) = r[i];
}
template <int I0, int N> __device__ __forceinline__ void tile_fetch_part(u32x4 (&r)[N], const bf16_t* src, int lane) {
#pragma unroll
    for (int i = 0; i < N; ++i) r[i] = *(const u32x4*)(src + (size_t)((lane >> 3) + 8 * (I0 + i)) * 2304 + (lane & 7) * 8);
}
template <int I0, int N> __device__ __forceinline__ void tile_park_part(const u32x4 (&r)[N], LAS unsigned char* T, int lane) {
#pragma unroll
    for (int i = 0; i < N; ++i) *(LAS u32x4*)(T + ((lane >> 3) + 8 * (I0 + i)) * 144 + (lane & 7) * 16) = r[i];
}
__device__ __forceinline__ void tile_park_norm(const u32x4 (&r)[8], const float* kg, LAS unsigned char* T, int lane) {
    const f32x4 g0 = *(const f32x4*)(kg + (lane & 7) * 8), g1 = *(const f32x4*)(kg + (lane & 7) * 8 + 4);
#pragma unroll
    for (int i = 0; i < 8; ++i) { const u32x4 v = r[i];
        float f[8] = {bf_lo(v.x), bf_hi(v.x), bf_lo(v.y), bf_hi(v.y), bf_lo(v.z), bf_hi(v.z), bf_lo(v.w), bf_hi(v.w)};
        float s = 0.f;
#pragma unroll
        for (int e = 0; e < 8; ++e) s += f[e] * f[e];
        s += __shfl_xor(s, 1); s += __shfl_xor(s, 2); s += __shfl_xor(s, 4);
        const float inv = rsqrtf(s * (1.f / 64.f) + 1e-6f);
        u32x4 w; w.x = pk2(f[0] * inv * g0[0], f[1] * inv * g0[1]); w.y = pk2(f[2] * inv * g0[2], f[3] * inv * g0[3]);
        w.z = pk2(f[4] * inv * g1[0], f[5] * inv * g1[1]); w.w = pk2(f[6] * inv * g1[2], f[7] * inv * g1[3]);
        *(LAS u32x4*)(T + ((lane >> 3) + 8 * i) * 144 + (lane & 7) * 16) = w; }
}
__device__ __forceinline__ void wave_lds_fence() { asm volatile("s_waitcnt lgkmcnt(0)" ::: "memory"); }
__device__ __forceinline__ f32x4 amfma(bf16x8 x, bf16x8 y, f32x4 c) { return __builtin_amdgcn_mfma_f32_16x16x32_bf16(x, y, c, 0, 0, 0); }
__device__ __forceinline__ bf16x8 mk8(unsigned a, unsigned b, unsigned c, unsigned d) { const u32x4 t = {a, b, c, d}; return __builtin_bit_cast(bf16x8, t); }

template <int KIND, int NQS>
__device__ __forceinline__ void att_item(const bf16_t* proj, bf16_t* oatt, const float* qg, const float* kg, const float* sinks, LAS unsigned char* wl, int b, int h, int qbi, int lane) {
    const int t0 = qbi * (16 * NQS);
    LAS unsigned char* Kt = wl; LAS unsigned char* Vt = wl + 9216;
    const int l15 = lane & 15, l4 = lane >> 4;
    const int kvh = KIND ? (h >> 2) : h;
    const int qcol = KIND ? 1536 + h * 64 : h * 64, kcol = KIND ? 2048 + kvh * 64 : 512 + h * 64, vcol = KIND ? 2176 + kvh * 64 : 1024 + h * 64, ocol = KIND ? 512 + h * 64 : h * 64;
    const float slope = exp2f(-(float)(h + 1));
    const size_t rowb = (size_t)b * 4096 + t0;
    bf16x8 qf[NQS][2];
#pragma unroll
    for (int qs = 0; qs < NQS; ++qs) {
        const u32x4 r0 = *(const u32x4*)(proj + (rowb + 16 * qs + l15) * 2304 + qcol + 8 * l4), r1 = *(const u32x4*)(proj + (rowb + 16 * qs + l15) * 2304 + qcol + 32 + 8 * l4);
        if (KIND == 0) { qf[qs][0] = __builtin_bit_cast(bf16x8, r0); qf[qs][1] = __builtin_bit_cast(bf16x8, r1); }
        else {
            float f[16] = {bf_lo(r0.x), bf_hi(r0.x), bf_lo(r0.y), bf_hi(r0.y), bf_lo(r0.z), bf_hi(r0.z), bf_lo(r0.w), bf_hi(r0.w),
                           bf_lo(r1.x), bf_hi(r1.x), bf_lo(r1.y), bf_hi(r1.y), bf_lo(r1.z), bf_hi(r1.z), bf_lo(r1.w), bf_hi(r1.w)};
            float ss = 0.f;
#pragma unroll
            for (int e = 0; e < 16; ++e) ss += f[e] * f[e];
            ss += __shfl_xor(ss, 16); ss += __shfl_xor(ss, 32);
            const float inv = rsqrtf(ss * (1.f / 64.f) + 1e-6f) * 0.125f;
            const f32x4 g0 = *(const f32x4*)(qg + 8 * l4), g1 = *(const f32x4*)(qg + 8 * l4 + 4), g2 = *(const f32x4*)(qg + 32 + 8 * l4), g3 = *(const f32x4*)(qg + 36 + 8 * l4);
            qf[qs][0] = mk8(pk2(f[0] * inv * g0[0], f[1] * inv * g0[1]), pk2(f[2] * inv * g0[2], f[3] * inv * g0[3]), pk2(f[4] * inv * g1[0], f[5] * inv * g1[1]), pk2(f[6] * inv * g1[2], f[7] * inv * g1[3]));
            qf[qs][1] = mk8(pk2(f[8] * inv * g2[0], f[9] * inv * g2[1]), pk2(f[10] * inv * g2[2], f[11] * inv * g2[3]), pk2(f[12] * inv * g3[0], f[13] * inv * g3[1]), pk2(f[14] * inv * g3[2], f[15] * inv * g3[3]));
        }
    }
    f32x4 O[NQS][4];
#pragma unroll
    for (int qs = 0; qs < NQS; ++qs)
#pragma unroll
        for (int dt = 0; dt < 4; ++dt) O[qs][dt] = (f32x4){0.f, 0.f, 0.f, 0.f};
    float st0[NQS], st1[NQS];
#pragma unroll
    for (int qs = 0; qs < NQS; ++qs) { st0[qs] = KIND ? sinks[h] : 0.f; st1[qs] = (KIND && l4 == 0) ? 1.f : 0.f; }
    const int kb_hi = (t0 + 16 * NQS - 1) >> 6, kb_lo = t0 >= 127 ? ((t0 - 127) >> 6) : 0;
    const int kb_first = KIND ? kb_lo : kb_hi, kb_last = KIND ? kb_hi : 0, kb_step = KIND ? 1 : -1;
    u32x4 kr[8], vlo[4];
    { const bf16_t* kbase = proj + ((size_t)b * 4096 + kb_first * 64) * 2304; tile_fetch(kr, kbase + kcol, lane); tile_fetch_part<0, 4>(vlo, kbase + vcol, lane); }
    for (int kb = kb_first; KIND ? (kb <= kb_last) : (kb >= kb_last); kb += kb_step) {
        wave_lds_fence();
        { u32x4 vhi[4]; tile_fetch_part<4, 4>(vhi, proj + ((size_t)b * 4096 + kb * 64) * 2304 + vcol, lane);
          if (KIND) tile_park_norm(kr, kg, Kt, lane); else tile_park(kr, Kt, lane);
          tile_park_part<0, 4>(vlo, Vt, lane); tile_park_part<4, 4>(vhi, Vt, lane); }
        { const int kn = kb + kb_step;
          if (KIND ? (kn <= kb_last) : (kn >= kb_last)) { const bf16_t* kbase = proj + ((size_t)b * 4096 + kn * 64) * 2304; tile_fetch(kr, kbase + kcol, lane); tile_fetch_part<0, 4>(vlo, kbase + vcol, lane); } }
        wave_lds_fence();
#pragma unroll
        for (int qs = 0; qs < NQS; ++qs) {
            f32x4 S[4];
#pragma unroll
            for (int kt = 0; kt < 4; ++kt) { const bf16x8 k0 = *(LAS const bf16x8*)(Kt + (16 * kt + l15) * 144 + (8 * l4) * 2), k1 = *(LAS const bf16x8*)(Kt + (16 * kt + l15) * 144 + (32 + 8 * l4) * 2);
                S[kt] = amfma(k0, qf[qs][0], (f32x4){0.f, 0.f, 0.f, 0.f}); S[kt] = amfma(k1, qf[qs][1], S[kt]); }
            const int t = t0 + 16 * qs + l15, key0 = kb * 64 + 4 * l4;
            float w[4][4];
            if (KIND == 0) {
                float sp[4][4], q4[4], hi[4], tot[4];
#pragma unroll
                for (int kt = 0; kt < 4; ++kt) { q4[kt] = 0.f;
#pragma unroll
                    for (int r = 0; r < 4; ++r) { const float z = S[kt][r] * 0.125f; S[kt][r] = z;
                        const float v = fmaxf(z, 0.f) + __logf(1.f + __expf(-fabsf(z)));
                        sp[kt][r] = (key0 + 16 * kt + r < t) ? v : 0.f; q4[kt] += sp[kt][r]; } }
#pragma unroll
                for (int kt = 0; kt < 4; ++kt) {
                    const float a1 = __shfl(q4[kt], (lane + 16) & 63), a2 = __shfl(q4[kt], (lane + 32) & 63), a3 = __shfl(q4[kt], (lane + 48) & 63);
                    hi[kt] = (l4 < 3 ? a1 : 0.f) + (l4 < 2 ? a2 : 0.f) + (l4 < 1 ? a3 : 0.f);
                    tot[kt] = __shfl(hi[kt] + q4[kt], l15); }
                float above = st0[qs];
#pragma unroll
                for (int kt = 3; kt >= 0; --kt) { float run = above + hi[kt];
#pragma unroll
                    for (int r = 3; r >= 0; --r) { w[kt][r] = (key0 + 16 * kt + r < t) ? __expf(S[kt][r] - sp[kt][r] - run) : 0.f; run += sp[kt][r]; }
                    above += tot[kt]; }
                st0[qs] = above;
            } else {
                float mx = st0[qs];
#pragma unroll
                for (int kt = 0; kt < 4; ++kt)
#pragma unroll
                    for (int r = 0; r < 4; ++r) { const int dist = t - (key0 + 16 * kt + r); const bool valid = dist >= 0 && dist < 128;
                        const float sc = valid ? S[kt][r] - slope * (float)dist : -1e30f; S[kt][r] = sc; mx = fmaxf(mx, sc); }
                mx = fmaxf(mx, __shfl_xor(mx, 16)); mx = fmaxf(mx, __shfl_xor(mx, 32));
                const float corr = __expf(st0[qs] - mx); st0[qs] = mx;
                float ls = 0.f;
#pragma unroll
                for (int kt = 0; kt < 4; ++kt)
#pragma unroll
                    for (int r = 0; r < 4; ++r) { w[kt][r] = S[kt][r] > -1e29f ? __expf(S[kt][r] - mx) : 0.f; ls += w[kt][r]; }
                st1[qs] = st1[qs] * corr + ls;
#pragma unroll
                for (int dt = 0; dt < 4; ++dt) O[qs][dt] = O[qs][dt] * corr;
            }
            const bf16x8 pf0 = mk8(pk2(w[0][0], w[0][1]), pk2(w[0][2], w[0][3]), pk2(w[1][0], w[1][1]), pk2(w[1][2], w[1][3]));
            const bf16x8 pf1 = mk8(pk2(w[2][0], w[2][1]), pk2(w[2][2], w[2][3]), pk2(w[3][0], w[3][1]), pk2(w[3][2], w[3][3]));
            {
                LAS const unsigned char* vb = Vt + (4 * l4 + (l15 >> 2)) * 144 + 8 * (l15 & 3);
#pragma unroll
                for (int dt = 0; dt < 4; ++dt) {
                    const s16x4 a0 = lds_tr4(vb + 32 * dt), b0 = lds_tr4(vb + 16 * 144 + 32 * dt), a1 = lds_tr4(vb + 32 * 144 + 32 * dt), b1 = lds_tr4(vb + 48 * 144 + 32 * dt);
                    const bf16x8 v0 = {a0[0], a0[1], a0[2], a0[3], b0[0], b0[1], b0[2], b0[3]}, v1 = {a1[0], a1[1], a1[2], a1[3], b1[0], b1[1], b1[2], b1[3]};
                    O[qs][dt] = amfma(v0, pf0, O[qs][dt]);
                    O[qs][dt] = amfma(v1, pf1, O[qs][dt]);
                }
            }
        }
        if (KIND == 0) { float rmin = st0[0];
#pragma unroll
            for (int qs = 1; qs < NQS; ++qs) rmin = fminf(rmin, st0[qs]);
            if (__all(rmin > 104.f)) break; }
    }
#pragma unroll
    for (int qs = 0; qs < NQS; ++qs) {
        float sc = 1.f;
        if (KIND) { float l = st1[qs]; l += __shfl_xor(l, 16); l += __shfl_xor(l, 32); sc = 1.f / l; }
#pragma unroll
        for (int dt = 0; dt < 4; ++dt) { u32x2 o; o.x = pk2(O[qs][dt][0] * sc, O[qs][dt][1] * sc); o.y = pk2(O[qs][dt][2] * sc, O[qs][dt][3] * sc);
            *(u32x2*)(oatt + (rowb + 16 * qs + l15) * 1024 + ocol + 16 * dt + 4 * l4) = o; }
    }
}
__device__ __forceinline__ void att_phase(const Args& a, LAS unsigned char* lds, const bf16_t* proj, bf16_t* oatt) {
    const int lane = tid_fresh() & 63, wave = tid_fresh() >> 6;
    LAS unsigned char* wl = lds + wave * 18432;
    const int NGW = gridDim.x * 8;
    for (int it = blockIdx.x * 8 + wave; it < 8192; it += NGW) {
        const int kind = it >> 12, r = it & 4095;
        const int qbi = 127 - (r & 127), h = (r >> 7) & 7, b = r >> 10;
        if (kind == 0) att_item<0, 2>(proj, oatt, a.in[8], a.in[9], a.in[10], wl, b, h, qbi, lane);
        else att_item<1, 2>(proj, oatt, a.in[8], a.in[9], a.in[10], wl, b, h, qbi, lane);
    }
}
__device__ __forceinline__ f32x4 mfma16(bf16x8 x, bf16x8 y, f32x4 c) { return __builtin_amdgcn_mfma_f32_16x16x32_bf16(x, y, c, 0, 0, 0); }
__device__ __forceinline__ bf16_t f2bf(float x) { return (bf16_t)(pk2(x, 0.f) & 0xffffu); }

__device__ __forceinline__ void gdn_prep_phase(const Args& a, LAS unsigned char* lds, const bool dry = false) {
    const int tid = tid_fresh(), lane = tid & 63, wave = tid >> 6;
    unsigned char* ws = a.ws;
    bf16_t* QKV = (bf16_t*)(ws + OFF_QKV); const bf16_t* halo = (const bf16_t*)(ws + OFF_HALO); const float* gates = (const float*)(ws + OFF_GATES);
    float* gb = (float*)(ws + OFF_GB); bf16_t* Tinv = (bf16_t*)(ws + OFF_TINV); bf16_t* attn = (bf16_t*)(ws + OFF_ATTN);
    const float* convw = a.in[13]; const float* a_log = a.in[14]; const float* dtb = a.in[15];
    constexpr int CSP = 1040;
    LAS unsigned char* cs = lds;
    LAS float* kkf = (LAS float*)(lds + 69888);
    LAS float* qkf = (LAS float*)(lds + 69888 + 17408);
    LAS float* Lm = (LAS float*)(lds + 104704);
    LAS float* betas = (LAS float*)(lds + 137472);
    LAS float* gcs = betas + 128;
    auto fetch_raw = [&](int item, u32x4 (&raw)[9]) {
        const int n = item & 63, hk = (item >> 6) & 7, b = item >> 9;
        const size_t row0 = (size_t)b * 4096 + 64 * n;
#pragma unroll
        for (int i = 0; i < 9; ++i) { const int v = tid + 512 * i; raw[i] = (u32x4){0u, 0u, 0u, 0u};
            if (v < 67 * 64) { const int r = v >> 6, ch = 8 * (v & 63);
                const int gcol = ch < 128 ? hk * 128 + ch : (ch < 256 ? 1024 + hk * 128 + (ch - 128) : 2048 + hk * 256 + (ch - 256));
                if (r >= 3) raw[i] = *(const u32x4*)(QKV + (row0 + r - 3) * 4096 + gcol);
                else if (n > 0) raw[i] = *(const u32x4*)(halo + ((size_t)(b * 64 + n - 1) * 3 + r) * 4096 + gcol); } }
    };
    u32x4 raw[9];
    if ((int)blockIdx.x < 2048) fetch_raw(blockIdx.x, raw);
    for (int item = blockIdx.x; item < 2048; item += gridDim.x) {
        const int n = item & 63, hk = (item >> 6) & 7, b = item >> 9;
        const size_t row0 = (size_t)b * 4096 + 64 * n;
        __syncthreads();
#pragma unroll
        for (int i = 0; i < 9; ++i) { const int v = tid + 512 * i; if (v < 67 * 64) *(LAS u32x4*)(cs + (v >> 6) * CSP + 16 * (v & 63)) = raw[i]; }
        if (item + (int)gridDim.x < 2048) fetch_raw(item + gridDim.x, raw);
        __syncthreads();
        {
            const int ch = tid;
            const int gcol = ch < 128 ? hk * 128 + ch : (ch < 256 ? 1024 + hk * 128 + (ch - 128) : 2048 + hk * 256 + (ch - 256));
            const float w0 = convw[gcol], w1 = convw[4096 + gcol], w2 = convw[8192 + gcol], w3 = convw[12288 + gcol];
            LAS bf16_t* col = (LAS bf16_t*)(cs + ch * 2);
            float x0 = bf2f(col[0]), x1 = bf2f(col[520]), x2 = bf2f(col[1040]);
#pragma unroll 8
            for (int t = 0; t < 64; ++t) { const float x3 = bf2f(col[(t + 3) * 520]);
                const float y = (w0 * x0 + w1 * x1) + (w2 * x2 + w3 * x3);
                col[(t + 3) * 520] = f2bf(silu_(y)); x0 = x1; x1 = x2; x2 = x3; }
        }
        __syncthreads();
        {
            const int pair = tid >> 2, t = pair >> 1, part = pair & 1, qd = tid & 3;
            LAS u32x4* p = (LAS u32x4*)(cs + (t + 3) * CSP + part * 256 + qd * 64);
            u32x4 u[4]; float ss = 0.f;
#pragma unroll
            for (int i = 0; i < 4; ++i) { u[i] = p[i];
                ss += (bf_lo(u[i].x) * bf_lo(u[i].x) + bf_hi(u[i].x) * bf_hi(u[i].x)) + (bf_lo(u[i].y) * bf_lo(u[i].y) + bf_hi(u[i].y) * bf_hi(u[i].y))
                    + (bf_lo(u[i].z) * bf_lo(u[i].z) + bf_hi(u[i].z) * bf_hi(u[i].z)) + (bf_lo(u[i].w) * bf_lo(u[i].w) + bf_hi(u[i].w) * bf_hi(u[i].w)); }
            ss += __shfl_xor(ss, 1); ss += __shfl_xor(ss, 2);
            const float inv = rsqrtf(ss + 1e-6f) * (part == 0 ? 0.08838834764831845f : 1.f);
            bf16_t* gp = QKV + (row0 + t) * 4096 + part * 1024 + hk * 128 + qd * 32;
#pragma unroll
            for (int i = 0; i < 4; ++i) { u32x4 w;
                w.x = pk2(bf_lo(u[i].x) * inv, bf_hi(u[i].x) * inv); w.y = pk2(bf_lo(u[i].y) * inv, bf_hi(u[i].y) * inv);
                w.z = pk2(bf_lo(u[i].z) * inv, bf_hi(u[i].z) * inv); w.w = pk2(bf_lo(u[i].w) * inv, bf_hi(u[i].w) * inv);
                p[i] = w; if (!dry) *(u32x4*)(gp + 8 * i) = w; }
        }
        for (int v = tid; v < 2048; v += 512) { const int t = v >> 5, c8 = v & 31;
            if (!dry) *(u32x4*)(QKV + (row0 + t) * 4096 + 2048 + hk * 256 + 8 * c8) = *(LAS const u32x4*)(cs + (t + 3) * CSP + 512 + 16 * c8); }
        if (tid < 128) {
            const int hvl = tid >> 6, hv = 2 * hk + hvl; const size_t row = row0 + lane;
            const float bl = gates[row * 32 + hv], av = gates[row * 32 + 16 + hv];
            const float beta = sigm(bl); const float xx = av + dtb[hv];
            const float ex = __expf(-fabsf(xx));
            const float sp = fmaxf(xx, 0.f) + (ex < 1e-4f ? ex * (1.f - 0.5f * ex) : __logf(1.f + ex));
            float g = -__expf(a_log[hv]) * sp;
#pragma unroll
            for (int o = 1; o < 64; o <<= 1) { const float y = __shfl_up(g, o); if (lane >= o) g += y; }
            betas[hvl * 64 + lane] = beta; gcs[hvl * 64 + lane] = g;
            float2 bg; bg.x = beta; bg.y = g; if (!dry) *(float2*)(gb + (row * 16 + hv) * 2) = bg;
        }
        __syncthreads();
        {
            const int ct = wave & 3, which = wave >> 2, l15 = lane & 15, l4 = lane >> 4;
            LAS float* dstm = which ? qkf : kkf;
            bf16x8 ya[4];
#pragma unroll
            for (int ks = 0; ks < 4; ++ks) ya[ks] = *(LAS const bf16x8*)(cs + (3 + 16 * ct + l15) * CSP + (which ? 0 : 256) + (32 * ks + 8 * l4) * 2);
#pragma unroll
            for (int st = 0; st < 4; ++st) { f32x4 acc = {0.f, 0.f, 0.f, 0.f};
#pragma unroll
                for (int ks = 0; ks < 4; ++ks) { const bf16x8 xs = *(LAS const bf16x8*)(cs + (3 + 16 * st + l15) * CSP + 256 + (32 * ks + 8 * l4) * 2); acc = mfma16(xs, ya[ks], acc); }
                *(LAS f32x4*)(dstm + (16 * ct + l15) * 68 + 16 * st + 4 * l4) = acc; }
        }
        __syncthreads();
        {
            const int hvl = tid >> 8, c = (tid >> 2) & 63, s0 = 16 * (tid & 3), hv = 2 * hk + hvl;
            const float gcc = gcs[hvl * 64 + c], bc = betas[hvl * 64 + c];
            unsigned aw[8];
#pragma unroll
            for (int i = 0; i < 16; i += 2) {
                float lv[2], av[2];
#pragma unroll
                for (int e = 0; e < 2; ++e) { const int s_ = s0 + i + e; const float dec = c >= s_ ? __expf(gcc - gcs[hvl * 64 + s_]) : 0.f;
                    lv[e] = c > s_ ? bc * kkf[c * 68 + s_] * dec : 0.f; av[e] = qkf[c * 68 + s_] * dec; }
                Lm[hvl * 4096 + c * 64 + s0 + i] = lv[0]; Lm[hvl * 4096 + c * 64 + s0 + i + 1] = lv[1];
                aw[i >> 1] = pk2(av[0], av[1]); }
            if (!dry) { bf16_t* ap = attn + ((size_t)((b * 16 + hv) * 64 + n)) * 4096 + c * 64 + s0;
                u32x4 w0 = {aw[0], aw[1], aw[2], aw[3]}, w1 = {aw[4], aw[5], aw[6], aw[7]}; *(u32x4*)ap = w0; *(u32x4*)(ap + 8) = w1; }
        }
        __syncthreads();
        LAS float* X = kkf;
        LAS float* Mb = (LAS float*)cs;
        if (tid < 128) {
            const int hvl = tid >> 6, half = lane >> 5, jj = lane & 31, base = 32 * half;
            LAS const float* Lh = Lm + hvl * 4096 + base * 64 + base;
            LAS float* Xh = X + hvl * 4096;
            float x[32];
#pragma unroll
            for (int c = 0; c < 32; ++c) x[c] = 0.f;
#pragma unroll
            for (int c = 0; c < 32; ++c) { float a0 = (c == jj) ? 1.f : 0.f, a1 = 0.f, a2 = 0.f, a3 = 0.f;
#pragma unroll
                for (int s4 = 0; s4 < (c + 3) / 4; ++s4) { const f32x4 Lv = *(LAS const f32x4*)(Lh + c * 64 + 4 * s4);
                    a0 -= Lv[0] * x[4 * s4]; a1 -= Lv[1] * x[4 * s4 + 1]; a2 -= Lv[2] * x[4 * s4 + 2]; a3 -= Lv[3] * x[4 * s4 + 3]; }
                x[c] = (a0 + a1) + (a2 + a3);
                Xh[(base + c) * 64 + base + jj] = x[c];
                if (half == 0) Xh[c * 64 + 32 + jj] = 0.f; }
        }
        __syncthreads();
        {
            const int hvl = tid >> 8, r = (tid >> 3) & 31, q0 = 4 * (tid & 7);
            LAS const float* Lh = Lm + hvl * 4096; LAS float* Xh = X + hvl * 4096;
            f32x4 m = {0.f, 0.f, 0.f, 0.f};
#pragma unroll 8
            for (int t = 0; t < 32; ++t) m = m + *(LAS const f32x4*)(Xh + t * 64 + q0) * Lh[(32 + r) * 64 + t];
            *(LAS f32x4*)(Mb + hvl * 1024 + r * 32 + q0) = m;
            __syncthreads();
            f32x4 e = {0.f, 0.f, 0.f, 0.f};
#pragma unroll 8
            for (int t = 0; t < 32; ++t) e = e - *(LAS const f32x4*)(Mb + hvl * 1024 + t * 32 + q0) * Xh[(32 + r) * 64 + 32 + t];
            *(LAS f32x4*)(Xh + (32 + r) * 64 + q0) = e;
        }
        __syncthreads();
        if (!dry) {
            const int hvl = tid >> 8, c = (tid >> 2) & 63, s0 = 16 * (tid & 3), hv = 2 * hk + hvl;
            LAS const float* xr = X + hvl * 4096 + c * 64 + s0;
            const f32x4 a0 = *(LAS const f32x4*)xr, a1 = *(LAS const f32x4*)(xr + 4), a2 = *(LAS const f32x4*)(xr + 8), a3 = *(LAS const f32x4*)(xr + 12);
            bf16_t* tp = Tinv + ((size_t)((b * 16 + hv) * 64 + n)) * 4096 + c * 64 + s0;
            u32x4 w0 = {pk2(a0[0], a0[1]), pk2(a0[2], a0[3]), pk2(a1[0], a1[1]), pk2(a1[2], a1[3])}, w1 = {pk2(a2[0], a2[1]), pk2(a2[2], a2[3]), pk2(a3[0], a3[1]), pk2(a3[2], a3[3])};
            *(u32x4*)tp = w0; *(u32x4*)(tp + 8) = w1;
        }
    }
}

constexpr int SC_KT = 0, SC_QT = 17408, SC_TT = 34816, SC_AT = 44032, SC_VT = 53248, SC_GB = 58368, SC_STRIDE = 58880, SC_BASE = 22528;
struct ScanStage { u32x4 k[2], q[2], t, a, v; f2v_t g; };
__device__ __forceinline__ void scan_fetch(ScanStage& o, const bf16_t* QKV, const float* gb, const bf16_t* Tinv, const bf16_t* attn, int b, int hv, int hk, int j, int n, int tid) {
    const size_t row0 = (size_t)b * 4096 + 64 * n;
    const size_t itm = (size_t)((b * 16 + hv) * 64 + n) * 4096;
#pragma unroll
    for (int i = 0; i < 2; ++i) { const int idx = tid + 512 * i, row = idx >> 4, c16 = idx & 15;
        o.q[i] = *(const u32x4*)(QKV + (row0 + row) * 4096 + hk * 128 + 8 * c16);
        o.k[i] = *(const u32x4*)(QKV + (row0 + row) * 4096 + 1024 + hk * 128 + 8 * c16); }
    o.t = *(const u32x4*)(Tinv + itm + (tid >> 3) * 64 + 8 * (tid & 7));
    o.a = *(const u32x4*)(attn + itm + (tid >> 3) * 64 + 8 * (tid & 7));
    if (tid < 256) o.v = *(const u32x4*)(QKV + (row0 + (tid >> 2)) * 4096 + 2048 + hv * 128 + 32 * j + 8 * (tid & 3));
    else if (tid < 320) o.g = *(const f2v_t*)(gb + ((row0 + (tid - 256)) * 16 + hv) * 2);
}
__device__ __forceinline__ void scan_park(const ScanStage& o, LAS unsigned char* img, int tid) {
#pragma unroll
    for (int i = 0; i < 2; ++i) { const int idx = tid + 512 * i, row = idx >> 4, c16 = idx & 15;
        *(LAS u32x4*)(img + SC_QT + row * 272 + c16 * 16) = o.q[i]; *(LAS u32x4*)(img + SC_KT + row * 272 + c16 * 16) = o.k[i]; }
    *(LAS u32x4*)(img + SC_TT + (tid >> 3) * 144 + (tid & 7) * 16) = o.t;
    *(LAS u32x4*)(img + SC_AT + (tid >> 3) * 144 + (tid & 7) * 16) = o.a;
    if (tid < 256) *(LAS u32x4*)(img + SC_VT + (tid >> 2) * 80 + (tid & 3) * 16) = o.v;
    else if (tid < 320) *(LAS f2v_t*)(img + SC_GB + (tid - 256) * 8) = o.g;
}
__device__ __forceinline__ void gdn_scan_phase(const Args& a, LAS unsigned char* lds, const bool dry = false) {
    const int tid = tid_fresh(), lane = tid & 63, wave = tid >> 6, l15 = lane & 15, l4 = lane >> 4, ct = wave >> 1, dt = wave & 1;
    unsigned char* ws = a.ws;
    bf16_t* QKV = (bf16_t*)(ws + OFF_QKV); const float* gb = (const float*)(ws + OFF_GB);
    const bf16_t* Tinv = (const bf16_t*)(ws + OFF_TINV); const bf16_t* attn = (const bf16_t*)(ws + OFF_ATTN);
    LAS unsigned char* Sb = lds; LAS unsigned char* RT = lds + 8704; LAS unsigned char* vnT = lds + 13312; LAS unsigned char* vnsT = lds + 17920;
    for (int item = VCU(lds); item < 256; item += gridDim.x) {
        const int j = item & 3, hv = (item >> 2) & 15, b = item >> 6, hk = hv >> 1;
        __syncthreads();
        for (int i = tid; i < 8704 / 4; i += 512) ((LAS unsigned*)Sb)[i] = 0u;
        f32x4 S0 = {0.f, 0.f, 0.f, 0.f}, S1 = {0.f, 0.f, 0.f, 0.f};
        { ScanStage s0; scan_fetch(s0, QKV, gb, Tinv, attn, b, hv, hk, j, 0, tid); scan_park(s0, lds + SC_BASE, tid); }
        __syncthreads();
        for (int n = 0; n < 64; ++n) {
            LAS const unsigned char* img = lds + SC_BASE + (n & 1) * SC_STRIDE;
            ScanStage nx; scan_fetch(nx, QKV, gb, Tinv, attn, b, hv, hk, j, n < 63 ? n + 1 : 63, tid);
            bf16_t* vcol = QKV + ((size_t)b * 4096 + 64 * n + 16 * ct + 4 * l4) * 4096 + 2048 + hv * 128 + 32 * j + 16 * dt + l15;
            float vv[4], be[4], gcr[4];
#pragma unroll
            for (int r = 0; r < 4; ++r) { vv[r] = bf2f(*(LAS const bf16_t*)(img + SC_VT + (16 * ct + 4 * l4 + r) * 80 + (16 * dt + l15) * 2));
                const f2v_t bg = *(LAS const f2v_t*)(img + SC_GB + (16 * ct + 4 * l4 + r) * 8); be[r] = bg.x; gcr[r] = bg.y; }
            const float gcl = *(LAS const float*)(img + SC_GB + 63 * 8 + 4);
            f32x4 KS = {0.f, 0.f, 0.f, 0.f}, QS = {0.f, 0.f, 0.f, 0.f};
#pragma unroll
            for (int ks = 0; ks < 4; ++ks) { const bf16x8 sf = *(LAS const bf16x8*)(Sb + (16 * dt + l15) * 272 + (32 * ks + 8 * l4) * 2);
                const bf16x8 kf = *(LAS const bf16x8*)(img + SC_KT + (16 * ct + l15) * 272 + (32 * ks + 8 * l4) * 2), qf = *(LAS const bf16x8*)(img + SC_QT + (16 * ct + l15) * 272 + (32 * ks + 8 * l4) * 2);
                KS = mfma16(kf, sf, KS); QS = mfma16(qf, sf, QS); }
            float Oacc[4], Rr[4];
#pragma unroll
            for (int r = 0; r < 4; ++r) { const float eg = __expf(gcr[r]); Rr[r] = be[r] * (vv[r] - eg * KS[r]); Oacc[r] = eg * QS[r]; }
            { u32x2 w; w.x = pk2(Rr[0], Rr[1]); w.y = pk2(Rr[2], Rr[3]); *(LAS u32x2*)(RT + (16 * dt + l15) * 144 + (16 * ct + 4 * l4) * 2) = w; }
            __syncthreads();
            f32x4 VN = {0.f, 0.f, 0.f, 0.f};
#pragma unroll
            for (int k2 = 0; k2 < 2; ++k2) { const bf16x8 rf = *(LAS const bf16x8*)(RT + (16 * dt + l15) * 144 + (32 * k2 + 8 * l4) * 2);
                const bf16x8 tf = *(LAS const bf16x8*)(img + SC_TT + (16 * ct + l15) * 144 + (32 * k2 + 8 * l4) * 2); VN = mfma16(tf, rf, VN); }
            { u32x2 w; w.x = pk2(VN[0], VN[1]); w.y = pk2(VN[2], VN[3]); *(LAS u32x2*)(vnT + (16 * dt + l15) * 144 + (16 * ct + 4 * l4) * 2) = w;
              u32x2 x; x.x = pk2(VN[0] * __expf(gcl - gcr[0]), VN[1] * __expf(gcl - gcr[1])); x.y = pk2(VN[2] * __expf(gcl - gcr[2]), VN[3] * __expf(gcl - gcr[3]));
              *(LAS u32x2*)(vnsT + (16 * dt + l15) * 144 + (16 * ct + 4 * l4) * 2) = x; }
            __syncthreads();
            f32x4 O = {Oacc[0], Oacc[1], Oacc[2], Oacc[3]};
#pragma unroll
            for (int k2 = 0; k2 < 2; ++k2) { const bf16x8 vf = *(LAS const bf16x8*)(vnT + (16 * dt + l15) * 144 + (32 * k2 + 8 * l4) * 2);
                const bf16x8 af = *(LAS const bf16x8*)(img + SC_AT + (16 * ct + l15) * 144 + (32 * k2 + 8 * l4) * 2); O = mfma16(af, vf, O); }
#pragma unroll
            for (int r = 0; r < 4; ++r) { if (!dry) vcol[(size_t)r * 4096] = f2bf(O[r]); }
            const float dec = __expf(gcl);
            S0 = S0 * dec; S1 = S1 * dec;
#pragma unroll
            for (int k2 = 0; k2 < 2; ++k2) {
                LAS const unsigned char* kb_ = img + SC_KT + (32 * k2 + 8 * l4 + (l15 >> 2)) * 272 + 32 * wave + 8 * (l15 & 3);
                const s16x4 ka = lds_tr4(kb_), kc = lds_tr4(kb_ + 4 * 272);
                const bf16x8 ktf = {ka[0], ka[1], ka[2], ka[3], kc[0], kc[1], kc[2], kc[3]};
                const bf16x8 v0 = *(LAS const bf16x8*)(vnsT + l15 * 144 + (32 * k2 + 8 * l4) * 2), v1 = *(LAS const bf16x8*)(vnsT + (16 + l15) * 144 + (32 * k2 + 8 * l4) * 2);
                S0 = mfma16(ktf, v0, S0); S1 = mfma16(ktf, v1, S1); }
            { u32x2 w; w.x = pk2(S0[0], S0[1]); w.y = pk2(S0[2], S0[3]); *(LAS u32x2*)(Sb + l15 * 272 + (16 * wave + 4 * l4) * 2) = w;
              u32x2 x; x.x = pk2(S1[0], S1[1]); x.y = pk2(S1[2], S1[3]); *(LAS u32x2*)(Sb + (16 + l15) * 272 + (16 * wave + 4 * l4) * 2) = x; }
            scan_park(nx, lds + SC_BASE + ((n + 1) & 1) * SC_STRIDE, tid);
            __syncthreads();
        }
    }
}

__device__ __forceinline__ void gdn_z_phase(const Args& a, LAS unsigned char* lds) {
    const int tid = tid_fresh();
    unsigned char* ws = a.ws;
    const bf16_t* QKV = (const bf16_t*)(ws + OFF_QKV);
    LAS float* tab = (LAS float*)(lds + TABO_OFF);
    pg8::StaticOrder S; S.init(MROWS, 2048, gridDim.x, VB(lds));
    Unit u;
    for (int i = 0; i < 8 && S.next(i, u); ++i) {
        const int rl = tid >> 1, bj = tid & 1;
        const bf16_t* op = QKV + (size_t)(u.pm * 256 + rl) * 4096 + 2048 + (2 * u.pn + bj) * 128;
        float ss = 0.f;
#pragma unroll
        for (int c = 0; c < 16; ++c) { const u32x4 v = *(const u32x4*)(op + 8 * c);
            ss += (bf_lo(v.x) * bf_lo(v.x) + bf_hi(v.x) * bf_hi(v.x)) + (bf_lo(v.y) * bf_lo(v.y) + bf_hi(v.y) * bf_hi(v.y)) + (bf_lo(v.z) * bf_lo(v.z) + bf_hi(v.z) * bf_hi(v.z)) + (bf_lo(v.w) * bf_lo(v.w) + bf_hi(v.w) * bf_hi(v.w)); }
        tab[i * 512 + rl * 2 + bj] = rsqrtf(ss * (1.f / 128.f) + 1e-6f);
    }
    fill_rstd_tab(lds, (const float*)(ws + OFF_SSQA), 2048);
    EpiT e{}; e.mode = 3; e.tabr = (LAS const float*)(lds + TABR_OFF); e.out = (bf16_t*)(ws + OFF_OB); e.osrc = QKV; e.ogain = a.in[16]; e.tabo = tab; e.S.init(MROWS, 2048, gridDim.x, VB(lds));
    run_gemm(lds, (const bf16_t*)(ws + OFF_SA), (const bf16_t*)(ws + OFF_WZ), 2048, 1024, e);
}
extern __shared__ __attribute__((aligned(16))) unsigned char dyn_lds[];
constexpr int LDS_BYTES = 160 * 1024;
__global__ void __launch_bounds__(512, 2) mega(Args a) {
    cg::grid_group grid = cg::this_grid();
    LAS unsigned char* lds = (LAS unsigned char*)dyn_lds;
    unsigned char* ws = a.ws;
#define WB(off) ((bf16_t*)(ws + (off)))
#define WF(off) ((float*)(ws + (off)))
    float* out = a.out;
    signed char* LO = (signed char*)a.out;
    signed char* LO2 = (signed char*)(ws + 187 * MIB + MIB / 2);
    unsigned* bar = (unsigned*)(ws + 246 * MIB);
    XcdBarrier xb; xb.bar = bar; xb.x = xb_xcc_id(); xb.st = (volatile LAS unsigned*)(lds + 163792);
    if (tid_fresh() == 0) {
        const unsigned rank = xb_add(&bar[XB_XCNT(xb.x)], 1u);
        *(LAS int*)(lds + 163780) = (int)xb.x; *(LAS int*)(lds + 163784) = (int)rank; xb.st[0] = 0u; xb.st[1] = 0u; }
    __syncthreads();
    p0_phase(a, lds);
    if (ws == nullptr) grid.sync();
    xcd_barrier(xb);
    if (tid_fresh() == 0) {
        const int xcc = *(LAS const int*)(lds + 163780), rank = *(LAS const int*)(lds + 163784), G = (int)gridDim.x;
        int pre = 0; for (int x = 0; x < 8; ++x) { const unsigned cx = xb_ld(&bar[XB_XCNT(x)]); if (x < xcc) pre += (int)cx; }
        const int vcu = pre + rank;
        *(LAS int*)(lds + 163776) = (G % 8 == 0) ? (vcu % (G / 8)) * 8 + vcu / (G / 8) : vcu; *(LAS int*)(lds + 163788) = vcu; }
    __syncthreads();
    gemm_gu(lds, WB(OFF_SA), WF(OFF_SSQA), WB(OFF_WGU00), WB(OFF_BIG));
    slack_convert(a, lds, 5632, 2, 5);
    xcd_barrier(xb);
    gemm_res(lds, WB(OFF_BIG), WB(OFF_WD00), 2816, HRef{a.in[0], nullptr, nullptr}, HDst{nullptr, WB(OFF_SB), LO, WF(OFF_SSQB)}, 0.5f);
    xcd_barrier(xb);
    fill_rstd_tab(lds, WF(OFF_SSQB), 2304);
    { EpiT e{}; e.mode = 1; e.tabr = (LAS const float*)(lds + TABR_OFF); e.out = WB(OFF_BIG); e.ldo = 2304; e.S.init(MROWS, 2304, gridDim.x, VB(lds)); run_gemm(lds, WB(OFF_SB), WB(OFF_WATTIN), 2304, 1024, e); }
    slack_convert(a, lds, 2304, 5, 10);
    xcd_barrier(xb);
    att_phase(a, lds, WB(OFF_BIG), WB(OFF_SA));
    xcd_barrier(xb);
    gemm_res(lds, WB(OFF_SA), WB(OFF_WATTOUT), 1024, HRef{nullptr, WB(OFF_SB), LO}, HDst{nullptr, WB(OFF_SB), LO, WF(OFF_SSQB)}, 1.0f);
    xcd_barrier(xb);
    gemm_gu(lds, WB(OFF_SB), WF(OFF_SSQB), WB(OFF_WGU01), WB(OFF_BIG));
    slack_convert(a, lds, 5632, 10, 13);
    xcd_barrier(xb);
    gemm_res(lds, WB(OFF_BIG), WB(OFF_WD01), 2816, HRef{nullptr, WB(OFF_SB), LO}, HDst{nullptr, WB(OFF_SA), LO, WF(OFF_SSQA)}, 0.5f);
    xcd_barrier(xb);
    ple_phase(lds, WB(OFF_PB), WB(OFF_WPP0), WB(OFF_BIG), WB(OFF_SA), WF(OFF_SSQA), WB(OFF_WPG0), HRef{nullptr, WB(OFF_SA), LO}, HDst{nullptr, WB(OFF_SB), LO, WF(OFF_SSQB)});
    xcd_barrier(xb);
    cvt_rows_bf16(a.in[1] + (size_t)MROWS * 256, WB(OFF_PB), 64, tid_fresh() & 63, blockIdx.x * 8 + (tid_fresh() >> 6), gridDim.x * 8);
    gemm_gu(lds, WB(OFF_SB), WF(OFF_SSQB), WB(OFF_WGU10), WB(OFF_BIG));
    slack_convert(a, lds, 5632, 13, 17);
    xcd_barrier(xb);
    gemm_res(lds, WB(OFF_BIG), WB(OFF_WD10), 2816, HRef{nullptr, WB(OFF_SB), LO}, HDst{nullptr, WB(OFF_SA), LO, WF(OFF_SSQA)}, 0.5f);
    xcd_barrier(xb);
    fill_rstd_tab(lds, WF(OFF_SSQA), 4352);
    { EpiT e{}; e.mode = 2; e.tabr = (LAS const float*)(lds + TABR_OFF); e.out = WB(OFF_QKV); e.halo = WB(OFF_HALO); e.gates = WF(OFF_GATES); e.S.init(MROWS, 4352, gridDim.x, VB(lds)); run_gemm(lds, WB(OFF_SA), WB(OFF_WQKVG), 4352, 1024, e); }
    slack_convert(a, lds, 4352, 17, 22);
    xcd_barrier(xb);
    gdn_prep_phase(a, lds);
    xcd_barrier(xb);
    gdn_scan_phase(a, lds);
    xcd_barrier(xb);
    gdn_z_phase(a, lds);
    xcd_barrier(xb);
    gemm_res(lds, WB(OFF_OB), WB(OFF_WGO), 2048, HRef{nullptr, WB(OFF_SA), LO}, HDst{nullptr, WB(OFF_H2), LO, WF(OFF_SSQB)}, 1.0f);
    xcd_barrier(xb);
    gemm_gu(lds, WB(OFF_H2), WF(OFF_SSQB), WB(OFF_WGU11), WB(OFF_ACT11));
    const bool pp1_ready = slack_pp(lds, 5632, WB(OFF_PB), WB(OFF_WPP1), WB(203 * MIB + MIB / 2));
    xcd_barrier(xb);
    gemm_res(lds, WB(OFF_ACT11), WB(OFF_WD11), 2816, HRef{nullptr, WB(OFF_H2), LO}, HDst{nullptr, WB(OFF_H3), LO2, WF(OFF_SSQA)}, 0.5f);
    xcd_barrier(xb);
    ple_phase(lds, WB(OFF_PB), WB(OFF_WPP1), WB(203 * MIB + MIB / 2), WB(OFF_H3), WF(OFF_SSQA), WB(OFF_WPG1), HRef{nullptr, WB(OFF_H3), LO2}, HDst{out, nullptr, nullptr, nullptr}, pp1_ready);
#undef WB
#undef WF
}

extern "C" void kernel_launch(void* const* d_in, const int* in_sizes, int n_in, void* d_out, int out_size, void* d_ws, size_t ws_size, hipStream_t stream) {
    static int grid = 0;
    if (!grid) {
        int dev = 0, cus = 0, per = 0;
        (void)hipGetDevice(&dev); (void)hipDeviceGetAttribute(&cus, hipDeviceAttributeMultiprocessorCount, dev);
        (void)hipFuncSetAttribute((const void*)mega, hipFuncAttributeMaxDynamicSharedMemorySize, LDS_BYTES);
        (void)hipOccupancyMaxActiveBlocksPerMultiprocessor(&per, (const void*)mega, 512, LDS_BYTES);
        if (per < 1) { fprintf(stderr, "occupancy query says %d blocks/CU\n", per); per = 1; }
        grid = cus;
    }
    if (n_in != 21 || ws_size < WS_NEED) { fprintf(stderr, "kernel_launch: unexpected inputs / workspace (%d, %zu)\n", n_in, ws_size); return; }
    Args a{};
    for (int i = 0; i < 21; ++i) a.in[i] = (const float*)d_in[i];
    a.out = (float*)d_out; a.ws = (unsigned char*)d_ws;
    int nd = 0;
    auto add = [&](int si, size_t soff, int gi, size_t goff, size_t dstoff, int ldsrc, int col0, int ncols, int K, int dstrow0, int mode) {
        WDesc& w = a.wd[nd++]; w.src_idx = si; w.src_off = (unsigned)soff; w.gain_idx = gi; w.gain_off = (unsigned)goff; w.dst_off = dstoff; w.ldsrc = ldsrc; w.col0 = col0; w.ncols = ncols; w.K = K; w.dstrow0 = dstrow0; w.mode = mode; };
    const size_t offgu[4] = {OFF_WGU00, OFF_WGU01, OFF_WGU10, OFF_WGU11}, offd[4] = {OFF_WD00, OFF_WD01, OFF_WD10, OFF_WD11};
    auto addgu = [&](int f) { add(3, (size_t)f * 1024 * 2816, 2, f * 1024, offgu[f], 2816, 0, 2816, 1024, 0, 1); add(4, (size_t)f * 1024 * 2816, 2, f * 1024, offgu[f], 2816, 0, 2816, 1024, 0, 2); };
    auto addd = [&](int f) { add(5, (size_t)f * 2816 * 1024, -1, 0, offd[f], 1024, 0, 1024, 2816, 0, 0); };
    addgu(0);
    addd(0); add(7, 0, 6, 0, OFF_WATTIN, 2304, 0, 2304, 1024, 0, 0); add(11, 0, -1, 0, OFF_WATTOUT, 1024, 0, 1024, 1024, 0, 0);
    addgu(1); addd(1); add(19, 0, 18, 0, OFF_WPG0, 1024, 0, 1024, 1024, 0, 0); add(20, 0, -1, 0, OFF_WPP0, 1024, 0, 1024, 256, 0, 0);
    addgu(2); addd(2);
    add(12, 0, 6, 1024, OFF_WQKVG, 6176, 0, 4096, 1024, 0, 0); add(12, 0, 6, 1024, OFF_WQKVG, 6176, 6144, 32, 1024, 4096, 0); add(12, 0, 6, 1024, OFF_WZ, 6176, 4096, 2048, 1024, 0, 0); add(17, 0, -1, 0, OFF_WGO, 1024, 0, 1024, 2048, 0, 0);
    addgu(3); addd(3); add(19, 1024 * 1024, 18, 1024, OFF_WPG1, 1024, 0, 1024, 1024, 0, 0); add(20, 256 * 1024, -1, 0, OFF_WPP1, 1024, 0, 1024, 256, 0, 0);
    (void)hipMemsetAsync((unsigned char*)d_ws + 246 * MIB, 0, XCD_BAR_WORDS * 4, stream);
    void* args[] = {&a};
    hipError_t e = hipLaunchCooperativeKernel((const void*)mega, dim3(grid), dim3(512), args, LDS_BYTES, stream);
    if (e != hipSuccess) fprintf(stderr, "cooperative launch failed: %s (grid %d)\n", hipGetErrorString(e), grid);
}
```

```cpp
#include <hip/hip_runtime.h>
#include <hip/hip_cooperative_groups.h>
#include <cstdio>
namespace cg = cooperative_groups;
__device__ __forceinline__ int tid_fresh() { int t = threadIdx.x; asm volatile("" : "+v"(t)); return t; }
namespace pg8 {
#define PG8_LAS __attribute__((address_space(3)))
typedef unsigned short bf16_t;
typedef short bf16x8 __attribute__((ext_vector_type(8)));
typedef float f32x4 __attribute__((ext_vector_type(4)));
typedef unsigned u32x4 __attribute__((ext_vector_type(4)));
constexpr int BM = 256, BK = 64, HALF = 128, HTB = HALF * BK * 2  , STAGE_BYTES = 8 * HTB, NXCD = 8, WGM = 8;

__host__ __device__ __forceinline__ int lds_byte(int r, int c) { const int st = (r >> 4) * 2 + (c >> 5), rr = r & 15, cc = c & 31, ob = rr * 64 + cc * 2; return st * 1024 + (ob ^ (((ob >> 9) & 1) << 5)); }
__host__ __device__ __forceinline__ void stage_rc(int b, int& R, int& C) { const int st = b / 1024, sb = b % 1024, swz = sb ^ (((sb >> 9) & 1) << 5); R = (st >> 1) * 16 + swz / 64; C = (st & 1) * 32 + (swz % 64) / 2; }
__host__ __device__ __forceinline__ int perm32(int rho) { const int n = rho >> 4, i = rho & 15; return 8 * (i >> 2) + 4 * n + (i & 3); }

struct Unit { int pm, pn; };
struct Gemm { const bf16_t* A; const bf16_t* Bt; int M, N, K; int atiled; int krot; };

struct StaticOrder {
    int nM, nN, nwg, G, c;
    __host__ __device__ void init(int M, int N, int G_, int c_) { nM = M / BM; nN = N / BM; nwg = nM * nN; G = G_; c = c_; }
    __host__ __device__ bool next(int i, Unit& u) const {
        const long L = (long)i * G + c; if (L >= nwg) return false;
        int wgid = (int)L; { const int q = nwg / NXCD, r = nwg % NXCD, xcd = wgid % NXCD, off = wgid / NXCD; wgid = (xcd < r ? xcd * (q + 1) : r * (q + 1) + (xcd - r) * q) + off; }
        const int nig = WGM * nN, gid = wgid / nig, fm = gid * WGM, gsz = (nM - fm) < WGM ? (nM - fm) : WGM;
        u.pm = fm + ((wgid % nig) % gsz); u.pn = (wgid % nig) / gsz; return true;
    }
    __device__ __forceinline__ void a_ready(const Unit&) const {}
    __device__ __forceinline__ void done(const Unit&) const {}
};
__device__ __forceinline__ unsigned cvt_pk_bf16(float lo, float hi) { unsigned r; asm volatile("v_cvt_pk_bf16_f32 %0, %1, %2" : "=v"(r) : "v"(lo), "v"(hi)); return r; }
template <class Epi, class Sched, bool STAMP = false>
__device__ __forceinline__ void gemm_phase(PG8_LAS unsigned char* lds, const Gemm g, const Sched& S, const Epi& E, unsigned long long* stamps) {
    const int tid = tid_fresh(), wid = __builtin_amdgcn_readfirstlane(tid >> 6), lane = tid & 63, wr = wid >> 2, wc = wid & 3, fr = lane & 15, fq = lane >> 4;
    const int K = g.K, nt = K / BK;
    int ts_lo = 0, ts_hi = 0, nts = 0; const unsigned long long rt_entry = STAMP ? (unsigned long long)wall_clock64() : 0ull;
#define PG8_STAMP() do { if (STAMP && wid == 0 && nts < 64) { const unsigned long long _c = (unsigned long long)clock64(); \
        ts_lo = (lane == nts) ? (int)(unsigned)_c : ts_lo; ts_hi = (lane == nts) ? (int)(unsigned)(_c >> 32) : ts_hi; ++nts; } } while (0)
    PG8_STAMP();
    unsigned voffA[2], voffB[2];
#pragma unroll
    for (int i = 0; i < 2; ++i) { int R, C; stage_rc(tid * 16 + i * 8192, R, C); const int Rb = Epi::PERM ? ((R & ~31) + perm32(R & 31)) : R;
        voffA[i] = (unsigned)(R * (g.atiled ? BK : K) + C) * 2u; voffB[i] = (unsigned)(Rb * K + C) * 2u; }
    const size_t kstep = (size_t)(BK * 2);
    const size_t hstep = (size_t)HALF * K * 2;
    const size_t tstep = 2 * hstep;
    const size_t kstepA = g.atiled ? (size_t)(BM * BK * 2) : kstep, hstepA = g.atiled ? (size_t)(HALF * BK * 2) : hstep;
    const unsigned ldsw = (unsigned)wid * 1024u;
    const int aoff = lds_byte(wr * 64 + fr, fq * 8), boff = lds_byte(wc * 32 + fr, fq * 8);
#define PG8_SA(b, h) (((b) * 2 + (h)) * HTB)
#define PG8_SB(b, h) ((4 + (b) * 2 + (h)) * HTB)
#define PG8_STAGE(bufoff, gbase, voff) do { _Pragma("unroll") for (int _i = 0; _i < 2; ++_i) \
        __builtin_amdgcn_global_load_lds((const unsigned*)((const char*)(gbase) + (voff)[_i]), (PG8_LAS unsigned*)(lds + (bufoff) + ldsw + _i * 8192), 16, 0, 0); } while (0)
#define PG8_LDA(dst, b, h) do { _Pragma("unroll") for (int m = 0; m < 4; ++m) _Pragma("unroll") for (int k = 0; k < 2; ++k) dst[m][k] = *(const PG8_LAS bf16x8*)(lds + PG8_SA(b, h) + aoff + m * 2048 + k * 1024); } while (0)
#define PG8_LDB(dst, b, h) do { _Pragma("unroll") for (int n = 0; n < 2; ++n) _Pragma("unroll") for (int k = 0; k < 2; ++k) dst[n][k] = *(const PG8_LAS bf16x8*)(lds + PG8_SB(b, h) + boff + n * 2048 + k * 1024); } while (0)
#define PG8_MMA(ai, bj, At, Bt) do { __builtin_amdgcn_s_setprio(1); _Pragma("unroll") for (int m = 0; m < 4; ++m) _Pragma("unroll") for (int n = 0; n < 2; ++n) _Pragma("unroll") for (int k = 0; k < 2; ++k) \
        acc[ai][bj][m][n] = __builtin_amdgcn_mfma_f32_16x16x32_bf16(Bt[n][k], At[m][k], acc[ai][bj][m][n], 0, 0, 0); __builtin_amdgcn_s_setprio(0); } while (0)
#define PG8_WAIT_V(n) asm volatile("s_waitcnt vmcnt(" #n ")" ::: "memory")
#define PG8_WAIT_L(n) asm volatile("s_waitcnt lgkmcnt(" #n ")" ::: "memory")
#define PG8_BAR __builtin_amdgcn_s_barrier()
#define PG8_SCHED __builtin_amdgcn_sched_barrier(0)
    Unit cur, nxt; int ui = 0;
    if (!S.next(0, cur)) return;
    f32x4 acc[2][2][4][2];
#pragma unroll
    for (int a = 0; a < 2; ++a)
#pragma unroll
        for (int b = 0; b < 2; ++b)
#pragma unroll
            for (int m = 0; m < 4; ++m)
#pragma unroll
                for (int n = 0; n < 2; ++n) acc[a][b][m][n] = (f32x4){0.f, 0.f, 0.f, 0.f};
    bf16x8 At[4][2], B0[2][2], B1[2][2];
    const char* cA = (const char*)g.A + (size_t)cur.pm * tstep; const char* cB = (const char*)g.Bt + (size_t)cur.pn * tstep;
    int rc = g.krot ? (2 * (cur.pm & 7)) % nt : 0;
    S.a_ready(cur);
    PG8_STAGE(PG8_SB(0, 0), cB + rc * kstep, voffB); PG8_STAGE(PG8_SA(0, 0), cA + rc * kstepA, voffA); PG8_STAGE(PG8_SB(0, 1), cB + hstep + rc * kstep, voffB); PG8_STAGE(PG8_SA(0, 1), cA + hstepA + rc * kstepA, voffA);
    if (wr == 1) PG8_BAR;
    PG8_WAIT_V(4); PG8_BAR;
    PG8_STAGE(PG8_SB(1, 0), cB + (rc + 1) * kstep, voffB); PG8_STAGE(PG8_SA(1, 0), cA + (rc + 1) * kstepA, voffA); PG8_STAGE(PG8_SB(1, 1), cB + hstep + (rc + 1) * kstep, voffB);
    PG8_WAIT_V(6); PG8_BAR;
    PG8_STAMP();
    for (;;) {
        const bool has_next = S.next(ui + 1, nxt);
        const char* nA = has_next ? (const char*)g.A + (size_t)nxt.pm * tstep : cA; const char* nB = has_next ? (const char*)g.Bt + (size_t)nxt.pn * tstep : cB;
        const int rn = has_next ? (g.krot ? (2 * (nxt.pm & 7)) % nt : 0) : rc;
        for (int t = 0; t < nt; t += 2) {
            const bool last = (t == nt - 2);
            int p0 = t + rc; if (p0 >= nt) p0 -= nt; int p2 = p0 + 2; if (p2 >= nt) p2 -= nt;
            const char* a1 = cA + (size_t)(p0 + 1) * kstepA;
            const char* a2 = last ? nA + (size_t)rn * kstepA : cA + (size_t)p2 * kstepA; const char* b2 = last ? nB + (size_t)rn * kstep : cB + (size_t)p2 * kstep;
            const char* a3 = a2 + kstepA; const char* b3 = b2 + kstep;
            if (last && has_next) S.a_ready(nxt);
            PG8_LDB(B0, 0, 0); PG8_SCHED; PG8_LDA(At, 0, 0); PG8_STAGE(PG8_SA(1, 1), a1 + hstepA, voffA);
            PG8_WAIT_L(8); PG8_BAR; PG8_WAIT_L(0); PG8_MMA(0, 0, At, B0); PG8_BAR; PG8_SCHED;
            PG8_LDB(B1, 0, 1); PG8_STAGE(PG8_SB(0, 0), b2, voffB);
            PG8_BAR; PG8_WAIT_L(0); PG8_MMA(0, 1, At, B1); PG8_BAR;
            PG8_LDA(At, 0, 1); PG8_STAGE(PG8_SA(0, 0), a2, voffA);
            PG8_BAR; PG8_WAIT_L(0); PG8_MMA(1, 0, At, B0); PG8_BAR; PG8_SCHED;
            PG8_STAGE(PG8_SB(0, 1), b2 + hstep, voffB);
            PG8_WAIT_V(6); PG8_BAR; PG8_MMA(1, 1, At, B1); PG8_BAR;
            PG8_LDB(B0, 1, 0); PG8_SCHED; PG8_LDA(At, 1, 0); PG8_STAGE(PG8_SA(0, 1), a2 + hstepA, voffA);
            PG8_WAIT_L(8); PG8_BAR; PG8_WAIT_L(0); PG8_MMA(0, 0, At, B0); PG8_BAR; PG8_SCHED;
            PG8_LDB(B1, 1, 1); PG8_STAGE(PG8_SB(1, 0), b3, voffB);
            PG8_BAR; PG8_WAIT_L(0); PG8_MMA(0, 1, At, B1); PG8_BAR;
            PG8_LDA(At, 1, 1); PG8_STAGE(PG8_SA(1, 0), a3, voffA);
            PG8_BAR; PG8_WAIT_L(0); PG8_MMA(1, 0, At, B0); PG8_BAR; PG8_SCHED;
            PG8_STAGE(PG8_SB(1, 1), b3 + hstep, voffB);
            PG8_WAIT_V(6); PG8_BAR; PG8_MMA(1, 1, At, B1); PG8_BAR;
        }
        PG8_STAMP();
        if constexpr (!Epi::AFTER_DRAIN) { E(acc, cur, wr, wc, fr, fq); S.done(cur); }
        PG8_STAMP();
        if (!has_next) break;
#pragma unroll
        for (int a = 0; a < 2; ++a)
#pragma unroll
            for (int b = 0; b < 2; ++b)
#pragma unroll
                for (int m = 0; m < 4; ++m)
#pragma unroll
                    for (int n = 0; n < 2; ++n) acc[a][b][m][n] = (f32x4){0.f, 0.f, 0.f, 0.f};
        cur = nxt; cA = nA; cB = nB; rc = rn; ++ui;
    }
    PG8_WAIT_V(0);
    if (wr == 0) PG8_BAR;
    PG8_BAR;
    if constexpr (Epi::AFTER_DRAIN) { E.fused(acc, cur, wr, wc, fr, fq, lds, wid, lane); S.done(cur); }
    PG8_STAMP();
    if (STAMP && wid == 0) { stamps[lane] = lane < nts ? (((unsigned long long)(unsigned)ts_hi << 32) | (unsigned)ts_lo) : 0ull;
        if (lane == 62) stamps[62] = rt_entry; if (lane == 63) stamps[63] = (unsigned long long)wall_clock64(); }
#undef PG8_STAMP
#undef PG8_SA
#undef PG8_SB
#undef PG8_STAGE
#undef PG8_LDA
#undef PG8_LDB
#undef PG8_MMA
#undef PG8_WAIT_V
#undef PG8_WAIT_L
#undef PG8_BAR
#undef PG8_SCHED
}
}

using pg8::bf16_t; using pg8::bf16x8; using pg8::f32x4; using pg8::u32x4; using pg8::Unit;
typedef unsigned u32x2 __attribute__((ext_vector_type(2)));
typedef __bf16 bf2_t __attribute__((ext_vector_type(2)));
#define LAS __attribute__((address_space(3)))

constexpr int MROWS = 16384;
#define VCU(lds) (*(LAS const int*)((lds) + 163788))
#define VB(lds) (*(LAS const int*)((lds) + 163776))
constexpr size_t MIB = 1048576;
constexpr size_t OFF_WZ = 0, OFF_WGO = 4 * MIB, OFF_WGU11 = 8 * MIB, OFF_WD11 = 19 * MIB, OFF_WPG1 = 24 * MIB + MIB / 2, OFF_WPP1 = 26 * MIB + MIB / 2,
    OFF_WQKVG = 27 * MIB, OFF_WE = 35 * MIB + MIB / 2,
    OFF_WGU00 = OFF_WE, OFF_WD00 = OFF_WGU00 + 11 * MIB, OFF_WGU01 = OFF_WD00 + 11 * MIB / 2, OFF_WD01 = OFF_WGU01 + 11 * MIB,
    OFF_WATTIN = OFF_WD01 + 11 * MIB / 2, OFF_WATTOUT = OFF_WATTIN + 9 * MIB / 2, OFF_WPG0 = OFF_WATTOUT + 2 * MIB, OFF_WPP0 = OFF_WPG0 + 2 * MIB,
    OFF_WGU10 = OFF_WPP0 + MIB / 2, OFF_WD10 = OFF_WGU10 + 11 * MIB,
    OFF_SB = 94 * MIB, OFF_BIG = 126 * MIB, OFF_SSQA = 235 * MIB + MIB / 2, OFF_SSQB = OFF_SSQA + MIB, OFF_PB = OFF_SSQB + MIB, OFF_SA = 263422976,
    WS_NEED = OFF_SA + 32 * MIB,
    OFF_QKV = OFF_WE, OFF_GATES = OFF_QKV + 128 * MIB, OFF_HALO = OFF_GATES + 2 * MIB, OFF_TINV = OFF_HALO + 6 * MIB, OFF_ATTN = OFF_TINV + 32 * MIB,
    OFF_GB = OFF_WQKVG, OFF_OB = OFF_TINV, OFF_H2 = OFF_WE, OFF_ACT11 = OFF_H2 + 32 * MIB, OFF_H3 = OFF_ACT11 + 88 * MIB, OFF_PP1 = OFF_WE;
static_assert(OFF_WD10 + 11 * MIB / 2 == OFF_SB, "weights map");
static_assert(OFF_ATTN + 32 * MIB == OFF_SSQA, "gdn map");
static_assert(OFF_PB + 8 * MIB <= OFF_SA && WS_NEED <= 296977568ull, "ws size");

struct WDesc { unsigned long long dst_off; unsigned src_off, gain_off; int src_idx, gain_idx, ldsrc, col0, ncols, K, dstrow0, mode; };
constexpr int NDESC = 22;
struct Args { const float* in[21]; float* out; unsigned char* ws; WDesc wd[NDESC]; };

typedef float f2v_t __attribute__((ext_vector_type(2)));
__device__ __forceinline__ unsigned pk2(float lo, float hi) { const f2v_t f = {lo, hi}; const bf2_t r = __builtin_convertvector(f, bf2_t); return __builtin_bit_cast(unsigned, r); }
__device__ __forceinline__ float bf_lo(unsigned u) { return __uint_as_float(u << 16); }
__device__ __forceinline__ float bf_hi(unsigned u) { return __uint_as_float(u & 0xffff0000u); }
__device__ __forceinline__ float bf2f(bf16_t b) { return __uint_as_float(((unsigned)b) << 16); }
__device__ __forceinline__ float sigm(float x) { return __builtin_amdgcn_rcpf(1.f + __expf(-x)); }
__device__ __forceinline__ float silu_(float x) { return x * __builtin_amdgcn_rcpf(1.f + __expf(-x)); }
__device__ __forceinline__ float wave_sum(float v) {
#pragma unroll
    for (int o = 1; o < 64; o <<= 1) v += __shfl_xor(v, o);
    return v;
}
__device__ __forceinline__ float row_rstd(const float* ssq, int row) {
    const f32x4* p = (const f32x4*)(ssq + (size_t)row * 16);
    const f32x4 a = p[0], b = p[1], c = p[2], d = p[3];
    const float s = (((a.x + a.y) + (a.z + a.w)) + ((b.x + b.y) + (b.z + b.w))) + (((c.x + c.y) + (c.z + c.w)) + ((d.x + d.y) + (d.z + d.w)));
    return rsqrtf(s * (1.f / 1024.f) + 1e-6f);
}
__device__ __forceinline__ float dot2bf(unsigned a, unsigned b, float c) {
    return __builtin_amdgcn_fdot2_f32_bf16(__builtin_bit_cast(bf2_t, a), __builtin_bit_cast(bf2_t, b), c, false);
}

constexpr int TABR_OFF = 131072, TABO_OFF = 131072 + 8192;
__device__ __forceinline__ int unit_ordinal(const pg8::StaticOrder& S, const Unit& u) {
    int r = 0;
    for (int i = 0; i < 8; ++i) { Unit t; if (S.next(i, t) && t.pm == u.pm && t.pn == u.pn) r = i; }
    return r;
}
struct EpiT {
    static constexpr bool PERM = true, AFTER_DRAIN = false;
    int mode;
    LAS const float* tabr; bf16_t* out; int ldo;
    bf16_t* halo; float* gates;
    const bf16_t* osrc; const float* ogain; LAS const float* tabo; pg8::StaticOrder S;
    __device__ __forceinline__ void operator()(const f32x4 (&acc)[2][2][4][2], const Unit& u, int wr, int wc, int fr_, int fq_) const {
        int fr = fr_, fq = fq_; asm volatile("" : "+v"(fr), "+v"(fq));
        const int ui = unit_ordinal(S, u);
        if (mode == 3) {
            const int cg = wc * 32 + 8 * fq;
            const f32x4 ga = *(const f32x4*)(ogain + cg), gb = *(const f32x4*)(ogain + cg + 4);
#pragma unroll
            for (int ai = 0; ai < 2; ++ai) {
                u32x4 o8[4][2];
#pragma unroll
                for (int m = 0; m < 4; ++m)
#pragma unroll
                    for (int bj = 0; bj < 2; ++bj) o8[m][bj] = *(const u32x4*)(osrc + (size_t)(u.pm * 256 + ai * 128 + wr * 64 + m * 16 + fr) * 4096 + 2048 + u.pn * 256 + bj * 128 + cg);
#pragma unroll
                for (int m = 0; m < 4; ++m) {
                    const int rl = ai * 128 + wr * 64 + m * 16 + fr, row = u.pm * 256 + rl;
                    const float rs = tabr[ui * 256 + rl];
#pragma unroll
                    for (int bj = 0; bj < 2; ++bj) {
                        const int c0 = u.pn * 256 + bj * 128 + cg;
                        const f32x4 v0 = acc[ai][bj][m][0] * rs, v1 = acc[ai][bj][m][1] * rs;
                        const float ro = tabo[ui * 512 + rl * 2 + bj];
                        const u32x4 o = o8[m][bj];
                        u32x4 w;
                        w.x = pk2(bf_lo(o.x) * ro * ga[0] * silu_(v0[0]), bf_hi(o.x) * ro * ga[1] * silu_(v0[1]));
                        w.y = pk2(bf_lo(o.y) * ro * ga[2] * silu_(v0[2]), bf_hi(o.y) * ro * ga[3] * silu_(v0[3]));
                        w.z = pk2(bf_lo(o.z) * ro * gb[0] * silu_(v1[0]), bf_hi(o.z) * ro * gb[1] * silu_(v1[1]));
                        w.w = pk2(bf_lo(o.w) * ro * gb[2] * silu_(v1[2]), bf_hi(o.w) * ro * gb[3] * silu_(v1[3]));
                        *(u32x4*)(out + (size_t)row * 2048 + c0) = w;
                    }
                }
            }
            return;
        }
#pragma unroll
        for (int ai = 0; ai < 2; ++ai)
#pragma unroll
            for (int m = 0; m < 4; ++m) {
                const int rl = ai * 128 + wr * 64 + m * 16 + fr, row = u.pm * 256 + rl;
                const float rs = tabr[ui * 256 + rl];
                if (mode == 0) {
                    const f32x4 g0 = acc[ai][0][m][0] * rs, g1 = acc[ai][0][m][1] * rs, u0 = acc[ai][1][m][0] * rs, u1 = acc[ai][1][m][1] * rs;
                    u32x4 w;
                    w.x = pk2(silu_(g0[0]) * u0[0], silu_(g0[1]) * u0[1]); w.y = pk2(silu_(g0[2]) * u0[2], silu_(g0[3]) * u0[3]);
                    w.z = pk2(silu_(g1[0]) * u1[0], silu_(g1[1]) * u1[1]); w.w = pk2(silu_(g1[2]) * u1[2], silu_(g1[3]) * u1[3]);
                    { const int f0 = u.pn * 128 + wc * 32 + 8 * fq;
                      *(u32x4*)(out + ((size_t)(u.pm * 44 + (f0 >> 6)) * 256 + rl) * 64 + (f0 & 63)) = w; }
                } else {
#pragma unroll
                    for (int bj = 0; bj < 2; ++bj) {
                        const int c0 = u.pn * 256 + bj * 128 + wc * 32 + 8 * fq;
                        const f32x4 v0 = acc[ai][bj][m][0] * rs, v1 = acc[ai][bj][m][1] * rs;
                        u32x4 w; w.x = pk2(v0[0], v0[1]); w.y = pk2(v0[2], v0[3]); w.z = pk2(v1[0], v1[1]); w.w = pk2(v1[2], v1[3]);
                        if (mode == 1) { *(u32x4*)(out + (size_t)row * ldo + c0) = w; }
                        else if (c0 < 4096) {
                            *(u32x4*)(out + (size_t)row * 4096 + c0) = w;
                            const int t = row & 4095;
                            if ((t & 63) >= 61) *(u32x4*)(halo + ((size_t)((row >> 12) * 64 + (t >> 6)) * 3 + ((t & 63) - 61)) * 4096 + c0) = w;
                        } else if (c0 < 4128) {
                            float* gp = gates + (size_t)row * 32 + (c0 - 4096);
                            *(f32x4*)gp = v0; *(f32x4*)(gp + 4) = v1;
                        }
                    }
                }
            }
    }
};
__device__ __forceinline__ float lo_scale(float hif) { return __uint_as_float(__float_as_uint(hif) & 0x7f800000u) * 3.0517578125e-5f; }
struct EpiF {
    static constexpr bool PERM = true, AFTER_DRAIN = false;
    int mode;
    const float* xin; const bf16_t* hbin; const signed char* loin;
    float* fout; bf16_t* hb; signed char* loout;
    float* ssqo; float scale; LAS const float* tabr; bf16_t* pp; pg8::StaticOrder S;
    __device__ __forceinline__ void operator()(const f32x4 (&acc)[2][2][4][2], const Unit& u, int wr, int wc, int fr_, int fq_) const {
        int fr = fr_, fq = fq_; asm volatile("" : "+v"(fr), "+v"(fq));
        const int ui = mode == 2 ? unit_ordinal(S, u) : 0;
        const size_t cb = (size_t)u.pn * 256 + wc * 32 + 8 * fq;
#pragma unroll
        for (int ai = 0; ai < 2; ++ai)
#pragma unroll
            for (int mp = 0; mp < 2; ++mp) {
                if (mode == 1) {
#pragma unroll
                    for (int m2 = 0; m2 < 2; ++m2)
#pragma unroll
                        for (int bj = 0; bj < 2; ++bj) { const f32x4 v0 = acc[ai][bj][2 * mp + m2][0], v1 = acc[ai][bj][2 * mp + m2][1];
                            u32x4 w; w.x = pk2(v0[0], v0[1]); w.y = pk2(v0[2], v0[3]); w.z = pk2(v1[0], v1[1]); w.w = pk2(v1[2], v1[3]);
                            *(u32x4*)(pp + (size_t)(u.pm * 256 + ai * 128 + wr * 64 + (2 * mp + m2) * 16 + fr) * 1024 + cb + bj * 128) = w; }
                    continue;
                }
                f32x4 hv[2][2][2]; u32x4 qv[2][2];
                if (xin) {
#pragma unroll
                    for (int m2 = 0; m2 < 2; ++m2)
#pragma unroll
                        for (int bj = 0; bj < 2; ++bj)
#pragma unroll
                            for (int n = 0; n < 2; ++n) hv[m2][bj][n] = *(const f32x4*)(xin + (size_t)(u.pm * 256 + ai * 128 + wr * 64 + (2 * mp + m2) * 16 + fr) * 1024 + cb + bj * 128 + 4 * n);
                } else {
                    u32x4 hi4[2][2]; u32x2 lo8[2][2];
#pragma unroll
                    for (int m2 = 0; m2 < 2; ++m2)
#pragma unroll
                        for (int bj = 0; bj < 2; ++bj) { const size_t idx = (size_t)(u.pm * 256 + ai * 128 + wr * 64 + (2 * mp + m2) * 16 + fr) * 1024 + cb + bj * 128;
                            hi4[m2][bj] = *(const u32x4*)(hbin + idx); lo8[m2][bj] = *(const u32x2*)(loin + idx); }
#pragma unroll
                    for (int m2 = 0; m2 < 2; ++m2)
#pragma unroll
                        for (int bj = 0; bj < 2; ++bj)
#pragma unroll
                            for (int n = 0; n < 2; ++n) { const unsigned ha = n ? hi4[m2][bj].z : hi4[m2][bj].x, hb_ = n ? hi4[m2][bj].w : hi4[m2][bj].y, ll = n ? lo8[m2][bj].y : lo8[m2][bj].x;
                                const float h0 = bf_lo(ha), h1 = bf_hi(ha), h2 = bf_lo(hb_), h3 = bf_hi(hb_);
                                f32x4 r;
                                r[0] = h0 + (float)(int)(signed char)(ll & 0xffu) * lo_scale(h0); r[1] = h1 + (float)(int)(signed char)((ll >> 8) & 0xffu) * lo_scale(h1);
                                r[2] = h2 + (float)(int)(signed char)((ll >> 16) & 0xffu) * lo_scale(h2); r[3] = h3 + (float)(int)(signed char)(ll >> 24) * lo_scale(h3);
                                hv[m2][bj][n] = r; }
                }
                if (mode == 2) {
#pragma unroll
                    for (int m2 = 0; m2 < 2; ++m2)
#pragma unroll
                        for (int bj = 0; bj < 2; ++bj) qv[m2][bj] = *(const u32x4*)(pp + (size_t)(u.pm * 256 + ai * 128 + wr * 64 + (2 * mp + m2) * 16 + fr) * 1024 + cb + bj * 128);
                }
#pragma unroll
                for (int m2 = 0; m2 < 2; ++m2) {
                    const int m = 2 * mp + m2, rl = ai * 128 + wr * 64 + m * 16 + fr, row = u.pm * 256 + rl;
                    const float rs = mode == 2 ? tabr[ui * 256 + rl] : 0.f;
                    float sq = 0.f;
#pragma unroll
                    for (int bj = 0; bj < 2; ++bj) {
                        const size_t idx = (size_t)row * 1024 + cb + bj * 128;
                        unsigned hw[4], lw[2];
#pragma unroll
                        for (int n = 0; n < 2; ++n) {
                            const f32x4 v = acc[ai][bj][m][n];
                            f32x4 h = hv[m2][bj][n];
                            if (mode == 0) h = h + v * scale;
                            else { const unsigned qa = n ? qv[m2][bj].z : qv[m2][bj].x, qb = n ? qv[m2][bj].w : qv[m2][bj].y;
                                h[0] += sigm(v[0] * rs) * bf_lo(qa); h[1] += sigm(v[1] * rs) * bf_hi(qa); h[2] += sigm(v[2] * rs) * bf_lo(qb); h[3] += sigm(v[3] * rs) * bf_hi(qb); }
                            if (fout) *(f32x4*)(fout + idx + 4 * n) = h;
                            else {
                                const unsigned w0 = pk2(h[0], h[1]), w1 = pk2(h[2], h[3]); hw[2 * n] = w0; hw[2 * n + 1] = w1;
                                const float g0 = bf_lo(w0), g1 = bf_hi(w0), g2 = bf_lo(w1), g3 = bf_hi(w1);
                                const float q0 = __builtin_amdgcn_fmed3f(rintf((h[0] - g0) * __uint_as_float(0x86800000u - (__float_as_uint(g0) & 0x7f800000u))), -128.f, 127.f);
                                const float q1 = __builtin_amdgcn_fmed3f(rintf((h[1] - g1) * __uint_as_float(0x86800000u - (__float_as_uint(g1) & 0x7f800000u))), -128.f, 127.f);
                                const float q2 = __builtin_amdgcn_fmed3f(rintf((h[2] - g2) * __uint_as_float(0x86800000u - (__float_as_uint(g2) & 0x7f800000u))), -128.f, 127.f);
                                const float q3 = __builtin_amdgcn_fmed3f(rintf((h[3] - g3) * __uint_as_float(0x86800000u - (__float_as_uint(g3) & 0x7f800000u))), -128.f, 127.f);
                                lw[n] = ((unsigned)(int)q0 & 0xffu) | (((unsigned)(int)q1 & 0xffu) << 8) | (((unsigned)(int)q2 & 0xffu) << 16) | (((unsigned)(int)q3 & 0xffu) << 24);
                            }
                            sq += (h[0] * h[0] + h[1] * h[1]) + (h[2] * h[2] + h[3] * h[3]);
                        }
                        if (!fout) { const u32x4 hs = {hw[0], hw[1], hw[2], hw[3]}; const u32x2 ls = {lw[0], lw[1]}; *(u32x4*)(hb + idx) = hs; *(u32x2*)(loout + idx) = ls; }
                    }
                    if (ssqo) { sq += __shfl_xor(sq, 16); sq += __shfl_xor(sq, 32); if (fq == 0) ssqo[(size_t)row * 16 + u.pn * 4 + wc] = sq; }
                }
            }
    }
};
__device__ __forceinline__ void fill_rstd_tab(LAS unsigned char* lds, const float* ssq, int N) {
    const int tid = tid_fresh(), rl = tid & 255, hi = tid >> 8;
    LAS float* tab = (LAS float*)(lds + TABR_OFF);
    pg8::StaticOrder S; S.init(MROWS, N, gridDim.x, VB(lds));
    f32x4 v[4][4]; bool ok[4];
#pragma unroll
    for (int ps = 0; ps < 4; ++ps) { Unit u; ok[ps] = S.next(2 * ps + hi, u);
        if (ok[ps]) { const f32x4* p = (const f32x4*)(ssq + (size_t)(u.pm * 256 + rl) * 16); v[ps][0] = p[0]; v[ps][1] = p[1]; v[ps][2] = p[2]; v[ps][3] = p[3]; } }
#pragma unroll
    for (int ps = 0; ps < 4; ++ps) if (ok[ps]) {
        const f32x4 a = v[ps][0], b = v[ps][1], c = v[ps][2], d = v[ps][3];
        const float s = (((a.x + a.y) + (a.z + a.w)) + ((b.x + b.y) + (b.z + b.w))) + (((c.x + c.y) + (c.z + c.w)) + ((d.x + d.y) + (d.z + d.w)));
        tab[(2 * ps + hi) * 256 + rl] = rsqrtf(s * (1.f / 1024.f) + 1e-6f); }
    __syncthreads();
}
template <class Epi> __device__ __forceinline__ void run_gemm(LAS unsigned char* lds, const bf16_t* A, const bf16_t* Bt, int N, int K, const Epi& E, int atiled = 0, int krot = 0) {
    pg8::StaticOrder S; S.init(MROWS, N, gridDim.x, VB(lds));
    const pg8::Gemm g{A, Bt, MROWS, N, K, atiled, krot};
    pg8::gemm_phase<Epi, pg8::StaticOrder, false>(lds, g, S, E, nullptr);
}
__device__ __forceinline__ void gemm_gu(LAS unsigned char* lds, const bf16_t* A, const float* ssq, const bf16_t* W, bf16_t* act) {
    fill_rstd_tab(lds, ssq, 5632);
    EpiT e{}; e.mode = 0; e.tabr = (LAS const float*)(lds + TABR_OFF); e.out = act; e.S.init(MROWS, 5632, gridDim.x, VB(lds)); run_gemm(lds, A, W, 5632, 1024, e);
}
struct HRef { const float* x; const bf16_t* hi; const signed char* lo; };
struct HDst { float* f; bf16_t* hi; signed char* lo; float* ssq; };
__device__ __forceinline__ void gemm_res(LAS unsigned char* lds, const bf16_t* A, const bf16_t* W, int K, HRef in, HDst out, float scale) {
    EpiF e{}; e.mode = 0; e.xin = in.x; e.hbin = in.hi; e.loin = in.lo; e.fout = out.f; e.hb = out.hi; e.loout = out.lo; e.ssqo = out.ssq; e.scale = scale;
    run_gemm(lds, A, W, 1024, K, e, K == 2816 ? 1 : 0, 0);
}
__device__ __forceinline__ void ple_phase(LAS unsigned char* lds, const bf16_t* pb, const bf16_t* Wpp, bf16_t* pp, const bf16_t* A, const float* ssqi, const bf16_t* Wpg, HRef in, HDst out, bool pp_ready = false) {
    fill_rstd_tab(lds, ssqi, 1024);
    pg8::StaticOrder S; S.init(MROWS, 1024, gridDim.x, VB(lds));
    if (!pp_ready) {
        run_gemm(lds, pb, Wpp, 1024, 256, EpiF{1, nullptr, nullptr, nullptr, nullptr, nullptr, nullptr, nullptr, 0.f, nullptr, pp, S});
        __threadfence(); __syncthreads(); __builtin_amdgcn_fence(__ATOMIC_ACQUIRE, "agent"); }
    run_gemm(lds, A, Wpg, 1024, 1024, EpiF{2, in.x, in.hi, in.lo, out.f, out.hi, out.lo, out.ssq, 0.f, (LAS const float*)(lds + TABR_OFF), pp, S});
}

__device__ __forceinline__ void cvt_rows_bf16(const float* src, bf16_t* dst, int ncol4  , int lane, int gw, int NGW) {
    for (int row = gw; row < MROWS; row += NGW) {
        const f32x4 v = *(const f32x4*)(src + (size_t)row * 256 + 4 * lane);
        u32x2 w; w.x = pk2(v[0], v[1]); w.y = pk2(v[2], v[3]);
        *(u32x2*)(dst + (size_t)row * 256 + 4 * lane) = w;
    }
}
__device__ __forceinline__ void convert_descs(const Args& a, int d_lo, int d_hi, int rank, int n) {
    const int lane = tid_fresh() & 63, wave = tid_fresh() >> 6;
    int total = 0;
    for (int d = d_lo; d < d_hi; ++d) total += (a.wd[d].K >> 6) * (a.wd[d].ncols >> 5);
    const int kc = lane & 7, ng = lane >> 3;
    for (int it = rank * 8 + wave; it < total; it += n * 8) {
        int r = it, d = d_lo;
        for (;;) { const int c = (a.wd[d].K >> 6) * (a.wd[d].ncols >> 5); if (r < c) break; r -= c; ++d; }
        const float* src = a.in[a.wd[d].src_idx] + a.wd[d].src_off; const float* gain = a.wd[d].gain_idx >= 0 ? a.in[a.wd[d].gain_idx] + a.wd[d].gain_off : nullptr; bf16_t* dst = (bf16_t*)(a.ws + a.wd[d].dst_off);
        const int ldsrc = a.wd[d].ldsrc, col0 = a.wd[d].col0, K = a.wd[d].K, dstrow0 = a.wd[d].dstrow0, mode = a.wd[d].mode;
        const int nblk = a.wd[d].ncols >> 5, kb = r / nblk, nb = r % nblk, k0 = 64 * kb + 8 * kc, n0 = 32 * nb + 4 * ng;
        f32x4 v[8];
#pragma unroll
        for (int i = 0; i < 8; ++i) v[i] = *(const f32x4*)(src + (size_t)(k0 + i) * ldsrc + col0 + n0);
        if (gain) { const f32x4 g0 = *(const f32x4*)(gain + k0), g1 = *(const f32x4*)(gain + k0 + 4);
#pragma unroll
            for (int i = 0; i < 4; ++i) { v[i] = v[i] * g0[i]; v[4 + i] = v[4 + i] * g1[i]; } }
#pragma unroll
        for (int j = 0; j < 4; ++j) { const int f = n0 + j;
            const int drow = mode == 0 ? dstrow0 + f : (256 * (f >> 7) + (f & 127) + (mode == 2 ? 128 : 0));
            u32x4 o; o.x = pk2(v[0][j], v[1][j]); o.y = pk2(v[2][j], v[3][j]); o.z = pk2(v[4][j], v[5][j]); o.w = pk2(v[6][j], v[7][j]);
            *(u32x4*)(dst + (size_t)drow * K + k0) = o; }
    }
}
__device__ __forceinline__ bool slack_pp(LAS unsigned char* lds, int N, const bf16_t* pb, const bf16_t* Wpp, bf16_t* pp) {
    const int G = (int)gridDim.x, nwg = 64 * (N >> 8), busy_last = nwg - ((nwg + G - 1) / G - 1) * G, c = VB(lds);
    if (busy_last >= G) return false;
    if (c >= busy_last) { pg8::StaticOrder S; S.init(MROWS, 1024, G - busy_last, c - busy_last); const pg8::Gemm g{pb, Wpp, MROWS, 1024, 256, 0, 0};
        const EpiF e{1, nullptr, nullptr, nullptr, nullptr, nullptr, nullptr, nullptr, 0.f, nullptr, pp, S}; pg8::gemm_phase<EpiF, pg8::StaticOrder, false>(lds, g, S, e, nullptr); }
    return true;
}
__device__ __forceinline__ void slack_convert(const Args& a, LAS unsigned char* lds, int N, int d_lo, int d_hi) {
    const int G = (int)gridDim.x, nwg = 64 * (N >> 8), busy_last = nwg - ((nwg + G - 1) / G - 1) * G, c = VB(lds);
    if (busy_last >= G) convert_descs(a, d_lo, d_hi, c, G);
    else if (c >= busy_last) convert_descs(a, d_lo, d_hi, c - busy_last, G - busy_last);
}
__device__ __forceinline__ void p0_phase(const Args& a, LAS unsigned char* lds) {
    const int lane = tid_fresh() & 63, wave = tid_fresh() >> 6;
    const int gw = blockIdx.x * 8 + wave, NGW = gridDim.x * 8;
    convert_descs(a, 0, 2, blockIdx.x, gridDim.x);
    const float* x = a.in[0]; bf16_t* xb = (bf16_t*)(a.ws + OFF_SA); float* ssq = (float*)(a.ws + OFF_SSQA);
    for (int row = gw; row < MROWS; row += NGW) {
        float s = 0.f;
#pragma unroll
        for (int j = 0; j < 4; ++j) { const f32x4 v = *(const f32x4*)(x + (size_t)row * 1024 + 256 * j + 4 * lane);
            s += (v[0] * v[0] + v[1] * v[1]) + (v[2] * v[2] + v[3] * v[3]);
            u32x2 w; w.x = pk2(v[0], v[1]); w.y = pk2(v[2], v[3]); *(u32x2*)(xb + (size_t)row * 1024 + 256 * j + 4 * lane) = w; }
        s = wave_sum(s);
        if (lane < 16) ssq[(size_t)row * 16 + lane] = lane == 0 ? s : 0.f;
    }
    cvt_rows_bf16(a.in[1], (bf16_t*)(a.ws + OFF_PB), 64, lane, gw, NGW);
}
#define XB_TMO      128
#define XB_XCNT(j)  (256  + 64 * (j))
#define XB_XSUB(j)  (1280 + 64 * (j))
#define XB_XGEN(j)  (2304 + 64 * (j))
#define XB_TOP      3328
#define XB_TOPGEN   3392
#define XCD_BAR_WORDS 3456
#define XB_SPIN_CAP (1u << 18)
__device__ __forceinline__ unsigned xb_ld(unsigned* p)              { return __hip_atomic_load(p, __ATOMIC_RELAXED, __HIP_MEMORY_SCOPE_AGENT); }
__device__ __forceinline__ unsigned xb_add(unsigned* p, unsigned v) { return __hip_atomic_fetch_add(p, v, __ATOMIC_RELAXED, __HIP_MEMORY_SCOPE_AGENT); }
__device__ __forceinline__ unsigned xb_xcc_id() { return (unsigned)__builtin_amdgcn_s_getreg((3 << 11) | 20) & 0xFu; }
#define XB_SPIN(cond, bar) do { unsigned _sp = 0; while (cond) { __builtin_amdgcn_s_sleep(1); \
    if ((++_sp & 255u) == 0u) { if (xb_ld(&(bar)[XB_TMO])) break; if (_sp > XB_SPIN_CAP) { atomicAdd(&(bar)[XB_TMO], 1u); break; } } } } while (0)

struct XcdBarrier {
    unsigned* bar; unsigned x;
    volatile LAS unsigned* st;
};

__device__ __forceinline__ XcdBarrier xcd_barrier_post(unsigned* bar, volatile LAS unsigned* st) {
    XcdBarrier b; b.bar = bar; b.x = xb_xcc_id(); b.st = st;
    if (tid_fresh() == 0) (void)xb_add(&bar[XB_XCNT(b.x)], 1u);
    return b;
}
__device__ __forceinline__ void xcd_barrier_complete(unsigned* bar, unsigned x, unsigned& nloc, unsigned& nx) {
    const unsigned G = gridDim.x * gridDim.y * gridDim.z;
    unsigned sum, cnt, mine, sp = 0u;
    for (;;) {
        sum = 0u; cnt = 0u; mine = 0u;
#pragma unroll
        for (unsigned j = 0; j < 16; ++j) { const unsigned c = xb_ld(&bar[XB_XCNT(j)]); sum += c; cnt += (c > 0u) ? 1u : 0u; mine = (j == x) ? c : mine; }
        if (sum == G) break;
        __builtin_amdgcn_s_sleep(1);
        if ((++sp & 255u) == 0u) { if (xb_ld(&bar[XB_TMO])) break; if (sp > XB_SPIN_CAP) { atomicAdd(&bar[XB_TMO], 1u); break; } }
    }
    nloc = mine > 0u ? mine : 1u; nx = cnt > 0u ? cnt : 1u;
}

__device__ __forceinline__ void xcd_barrier(const XcdBarrier& b) {
    asm volatile("s_waitcnt vmcnt(0)" ::: "memory");
    __syncthreads();
    if (tid_fresh() == 0) {
        unsigned* bar = b.bar;
        __builtin_amdgcn_s_waitcnt(0);
        unsigned nloc = b.st[0], nx = b.st[1];
        if (nloc == 0u) { xcd_barrier_complete(bar, b.x, nloc, nx); b.st[0] = nloc; b.st[1] = nx; }
        const unsigned old = xb_add(&bar[XB_XSUB(b.x)], 1u);
        const unsigned gen = old / nloc;
        if (old + 1u == (gen + 1u) * nloc) {
            __builtin_amdgcn_fence(__ATOMIC_RELEASE, "agent");
            asm volatile("s_waitcnt vmcnt(0)" ::: "memory");
            const unsigned og = xb_add(&bar[XB_TOP], 1u);
            const unsigned tg = og / nx;
            if (og + 1u == (tg + 1u) * nx) xb_add(&bar[XB_TOPGEN], 1u);
            else XB_SPIN(xb_ld(&bar[XB_TOPGEN]) == tg, bar);
            __builtin_amdgcn_fence(__ATOMIC_ACQUIRE, "agent");
            xb_add(&bar[XB_XGEN(b.x)], 1u);
            asm volatile("s_waitcnt vmcnt(0)" ::: "memory");
        } else {
            XB_SPIN(xb_ld(&bar[XB_XGEN(b.x)]) == gen, bar);
            __builtin_amdgcn_fence(__ATOMIC_ACQUIRE, "agent");
            asm volatile("s_waitcnt vmcnt(0)" ::: "memory");
        }
    }
    __syncthreads();
}

__device__ __forceinline__ void stage_k(const bf16_t* src, LAS unsigned char* Kt, int lane) {
#pragma unroll
    for (int i = 0; i < 8; ++i) { const int r = (lane >> 3) + 8 * i;
        const u32x4 v = *(const u32x4*)(src + (size_t)r * 2304 + (lane & 7) * 8);
        *(LAS u32x4*)(Kt + r * 144 + (lane & 7) * 16) = v; }
}
__device__ __forceinline__ void stage_k_norm(const bf16_t* src, const float* kg, LAS unsigned char* Kt, int lane) {
    const f32x4 g0 = *(const f32x4*)(kg + (lane & 7) * 8), g1 = *(const f32x4*)(kg + (lane & 7) * 8 + 4);
#pragma unroll
    for (int i = 0; i < 8; ++i) { const int r = (lane >> 3) + 8 * i;
        const u32x4 v = *(const u32x4*)(src + (size_t)r * 2304 + (lane & 7) * 8);
        float f[8] = {bf_lo(v.x), bf_hi(v.x), bf_lo(v.y), bf_hi(v.y), bf_lo(v.z), bf_hi(v.z), bf_lo(v.w), bf_hi(v.w)};
        float s = 0.f;
#pragma unroll
        for (int e = 0; e < 8; ++e) s += f[e] * f[e];
        s += __shfl_xor(s, 1); s += __shfl_xor(s, 2); s += __shfl_xor(s, 4);
        const float inv = rsqrtf(s * (1.f / 64.f) + 1e-6f);
        u32x4 w; w.x = pk2(f[0] * inv * g0[0], f[1] * inv * g0[1]); w.y = pk2(f[2] * inv * g0[2], f[3] * inv * g0[3]);
        w.z = pk2(f[4] * inv * g1[0], f[5] * inv * g1[1]); w.w = pk2(f[6] * inv * g1[2], f[7] * inv * g1[3]);
        *(LAS u32x4*)(Kt + r * 144 + (lane & 7) * 16) = w; }
}
__device__ __forceinline__ void stage_vt(const bf16_t* src, LAS unsigned char* Vt, int lane) {
#pragma unroll
    for (int c = 0; c < 8; ++c) {
        const u32x4 v = *(const u32x4*)(src + (size_t)lane * 2304 + c * 8);
        LAS unsigned short* p = (LAS unsigned short*)(Vt + (8 * c) * 144 + lane * 2);
        p[0 * 72] = (unsigned short)(v.x & 0xffffu); p[1 * 72] = (unsigned short)(v.x >> 16);
        p[2 * 72] = (unsigned short)(v.y & 0xffffu); p[3 * 72] = (unsigned short)(v.y >> 16);
        p[4 * 72] = (unsigned short)(v.z & 0xffffu); p[5 * 72] = (unsigned short)(v.z >> 16);
        p[6 * 72] = (unsigned short)(v.w & 0xffffu); p[7 * 72] = (unsigned short)(v.w >> 16);
    }
}
typedef short s16x4 __attribute__((ext_vector_type(4)));
__device__ __forceinline__ s16x4 lds_tr4(LAS const unsigned char* p) { return __builtin_amdgcn_ds_read_tr16_b64_v4i16((LAS s16x4*)p); }
__device__ __forceinline__ void tile_fetch(u32x4 (&r)[8], const bf16_t* src, int lane) {
#pragma unroll
    for (int i = 0; i < 8; ++i) r[i] = *(const u32x4*)(src + (size_t)((lane >> 3) + 8 * i) * 2304 + (lane & 7) * 8);
}
__device__ __forceinline__ void tile_park(const u32x4 (&r)[8], LAS unsigned char* T, int lane) {
#pragma unroll
    for (int i = 0; i < 8; ++i) *(LAS u32x4*)(T + ((lane >> 3) + 8 * i) * 144 + (lane & 7) * 16) = r[i];
}
template <int I0, int N> __device__ __forceinline__ void tile_fetch_part(u32x4 (&r)[N], const bf16_t* src, int lane) {
#pragma unroll
    for (int i = 0; i < N; ++i) r[i] = *(const u32x4*)(src + (size_t)((lane >> 3) + 8 * (I0 + i)) * 2304 + (lane & 7) * 8);
}
template <int I0, int N> __device__ __forceinline__ void tile_park_part(const u32x4 (&r)[N], LAS unsigned char* T, int lane) {
#pragma unroll
    for (int i = 0; i < N; ++i) *(LAS u32x4*)(T + ((lane >> 3) + 8 * (I0 + i)) * 144 + (lane & 7) * 16) = r[i];
}
__device__ __forceinline__ void tile_park_norm(const u32x4 (&r)[8], const float* kg, LAS unsigned char* T, int lane) {
    const f32x4 g0 = *(const f32x4*)(kg + (lane & 7) * 8), g1 = *(const f32x4*)(kg + (lane & 7) * 8 + 4);
#pragma unroll
    for (int i = 0; i < 8; ++i) { const u32x4 v = r[i];
        float f[8] = {bf_lo(v.x), bf_hi(v.x), bf_lo(v.y), bf_hi(v.y), bf_lo(v.z), bf_hi(v.z), bf_lo(v.w), bf_hi(v.w)};
        float s = 0.f;
#pragma unroll
        for (int e = 0; e < 8; ++e) s += f[e] * f[e];
        s += __shfl_xor(s, 1); s += __shfl_xor(s, 2); s += __shfl_xor(s, 4);
        const float inv = rsqrtf(s * (1.f / 64.f) + 1e-6f);
        u32x4 w; w.x = pk2(f[0] * inv * g0[0], f[1] * inv * g0[1]); w.y = pk2(f[2] * inv * g0[2], f[3] * inv * g0[3]);
        w.z = pk2(f[4] * inv * g1[0], f[5] * inv * g1[1]); w.w = pk2(f[6] * inv * g1[2], f[7] * inv * g1[3]);
        *(LAS u32x4*)(T + ((lane >> 3) + 8 * i) * 144 + (lane & 7) * 16) = w; }
}
__device__ __forceinline__ void wave_lds_fence() { asm volatile("s_waitcnt lgkmcnt(0)" ::: "memory"); }
__device__ __forceinline__ f32x4 amfma(bf16x8 x, bf16x8 y, f32x4 c) { return __builtin_amdgcn_mfma_f32_16x16x32_bf16(x, y, c, 0, 0, 0); }
__device__ __forceinline__ bf16x8 mk8(unsigned a, unsigned b, unsigned c, unsigned d) { const u32x4 t = {a, b, c, d}; return __builtin_bit_cast(bf16x8, t); }

template <int KIND, int NQS>
__device__ __forceinline__ void att_item(const bf16_t* proj, bf16_t* oatt, const float* qg, const float* kg, const float* sinks, LAS unsigned char* wl, int b, int h, int qbi, int lane) {
    const int t0 = qbi * (16 * NQS);
    LAS unsigned char* Kt = wl; LAS unsigned char* Vt = wl + 9216;
    const int l15 = lane & 15, l4 = lane >> 4;
    const int kvh = KIND ? (h >> 2) : h;
    const int qcol = KIND ? 1536 + h * 64 : h * 64, kcol = KIND ? 2048 + kvh * 64 : 512 + h * 64, vcol = KIND ? 2176 + kvh * 64 : 1024 + h * 64, ocol = KIND ? 512 + h * 64 : h * 64;
    const float slope = exp2f(-(float)(h + 1));
    const size_t rowb = (size_t)b * 4096 + t0;
    bf16x8 qf[NQS][2];
#pragma unroll
    for (int qs = 0; qs < NQS; ++qs) {
        const u32x4 r0 = *(const u32x4*)(proj + (rowb + 16 * qs + l15) * 2304 + qcol + 8 * l4), r1 = *(const u32x4*)(proj + (rowb + 16 * qs + l15) * 2304 + qcol + 32 + 8 * l4);
        if (KIND == 0) { qf[qs][0] = __builtin_bit_cast(bf16x8, r0); qf[qs][1] = __builtin_bit_cast(bf16x8, r1); }
        else {
            float f[16] = {bf_lo(r0.x), bf_hi(r0.x), bf_lo(r0.y), bf_hi(r0.y), bf_lo(r0.z), bf_hi(r0.z), bf_lo(r0.w), bf_hi(r0.w),
                           bf_lo(r1.x), bf_hi(r1.x), bf_lo(r1.y), bf_hi(r1.y), bf_lo(r1.z), bf_hi(r1.z), bf_lo(r1.w), bf_hi(r1.w)};
            float ss = 0.f;
#pragma unroll
            for (int e = 0; e < 16; ++e) ss += f[e] * f[e];
            ss += __shfl_xor(ss, 16); ss += __shfl_xor(ss, 32);
            const float inv = rsqrtf(ss * (1.f / 64.f) + 1e-6f) * 0.125f;
            const f32x4 g0 = *(const f32x4*)(qg + 8 * l4), g1 = *(const f32x4*)(qg + 8 * l4 + 4), g2 = *(const f32x4*)(qg + 32 + 8 * l4), g3 = *(const f32x4*)(qg + 36 + 8 * l4);
            qf[qs][0] = mk8(pk2(f[0] * inv * g0[0], f[1] * inv * g0[1]), pk2(f[2] * inv * g0[2], f[3] * inv * g0[3]), pk2(f[4] * inv * g1[0], f[5] * inv * g1[1]), pk2(f[6] * inv * g1[2], f[7] * inv * g1[3]));
            qf[qs][1] = mk8(pk2(f[8] * inv * g2[0], f[9] * inv * g2[1]), pk2(f[10] * inv * g2[2], f[11] * inv * g2[3]), pk2(f[12] * inv * g3[0], f[13] * inv * g3[1]), pk2(f[14] * inv * g3[2], f[15] * inv * g3[3]));
        }
    }
    f32x4 O[NQS][4];
#pragma unroll
    for (int qs = 0; qs < NQS; ++qs)
#pragma unroll
        for (int dt = 0; dt < 4; ++dt) O[qs][dt] = (f32x4){0.f, 0.f, 0.f, 0.f};
    float st0[NQS], st1[NQS];
#pragma unroll
    for (int qs = 0; qs < NQS; ++qs) { st0[qs] = KIND ? sinks[h] : 0.f; st1[qs] = (KIND && l4 == 0) ? 1.f : 0.f; }
    const int kb_hi = (t0 + 16 * NQS - 1) >> 6, kb_lo = t0 >= 127 ? ((t0 - 127) >> 6) : 0;
    const int kb_first = KIND ? kb_lo : kb_hi, kb_last = KIND ? kb_hi : 0, kb_step = KIND ? 1 : -1;
    u32x4 kr[8], vlo[4];
    { const bf16_t* kbase = proj + ((size_t)b * 4096 + kb_first * 64) * 2304; tile_fetch(kr, kbase + kcol, lane); tile_fetch_part<0, 4>(vlo, kbase + vcol, lane); }
    for (int kb = kb_first; KIND ? (kb <= kb_last) : (kb >= kb_last); kb += kb_step) {
        wave_lds_fence();
        { u32x4 vhi[4]; tile_fetch_part<4, 4>(vhi, proj + ((size_t)b * 4096 + kb * 64) * 2304 + vcol, lane);
          if (KIND) tile_park_norm(kr, kg, Kt, lane); else tile_park(kr, Kt, lane);
          tile_park_part<0, 4>(vlo, Vt, lane); tile_park_part<4, 4>(vhi, Vt, lane); }
        { const int kn = kb + kb_step;
          if (KIND ? (kn <= kb_last) : (kn >= kb_last)) { const bf16_t* kbase = proj + ((size_t)b * 4096 + kn * 64) * 2304; tile_fetch(kr, kbase + kcol, lane); tile_fetch_part<0, 4>(vlo, kbase + vcol, lane); } }
        wave_lds_fence();
#pragma unroll
        for (int qs = 0; qs < NQS; ++qs) {
            f32x4 S[4];
#pragma unroll
            for (int kt = 0; kt < 4; ++kt) { const bf16x8 k0 = *(LAS const bf16x8*)(Kt + (16 * kt + l15) * 144 + (8 * l4) * 2), k1 = *(LAS const bf16x8*)(Kt + (16 * kt + l15) * 144 + (32 + 8 * l4) * 2);
                S[kt] = amfma(k0, qf[qs][0], (f32x4){0.f, 0.f, 0.f, 0.f}); S[kt] = amfma(k1, qf[qs][1], S[kt]); }
            const int t = t0 + 16 * qs + l15, key0 = kb * 64 + 4 * l4;
            float w[4][4];
            if (KIND == 0) {
                float sp[4][4], q4[4], hi[4], tot[4];
#pragma unroll
                for (int kt = 0; kt < 4; ++kt) { q4[kt] = 0.f;
#pragma unroll
                    for (int r = 0; r < 4; ++r) { const float z = S[kt][r] * 0.125f; S[kt][r] = z;
                        const float v = fmaxf(z, 0.f) + __logf(1.f + __expf(-fabsf(z)));
                        sp[kt][r] = (key0 + 16 * kt + r < t) ? v : 0.f; q4[kt] += sp[kt][r]; } }
#pragma unroll
                for (int kt = 0; kt < 4; ++kt) {
                    const float a1 = __shfl(q4[kt], (lane + 16) & 63), a2 = __shfl(q4[kt], (lane + 32) & 63), a3 = __shfl(q4[kt], (lane + 48) & 63);
                    hi[kt] = (l4 < 3 ? a1 : 0.f) + (l4 < 2 ? a2 : 0.f) + (l4 < 1 ? a3 : 0.f);
                    tot[kt] = __shfl(hi[kt] + q4[kt], l15); }
                float above = st0[qs];
#pragma unroll
                for (int kt = 3; kt >= 0; --kt) { float run = above + hi[kt];
#pragma unroll
                    for (int r = 3; r >= 0; --r) { w[kt][r] = (key0 + 16 * kt + r < t) ? __expf(S[kt][r] - sp[kt][r] - run) : 0.f; run += sp[kt][r]; }
                    above += tot[kt]; }
                st0[qs] = above;
            } else {
                float mx = st0[qs];
#pragma unroll
                for (int kt = 0; kt < 4; ++kt)
#pragma unroll
                    for (int r = 0; r < 4; ++r) { const int dist = t - (key0 + 16 * kt + r); const bool valid = dist >= 0 && dist < 128;
                        const float sc = valid ? S[kt][r] - slope * (float)dist : -1e30f; S[kt][r] = sc; mx = fmaxf(mx, sc); }
                mx = fmaxf(mx, __shfl_xor(mx, 16)); mx = fmaxf(mx, __shfl_xor(mx, 32));
                const float corr = __expf(st0[qs] - mx); st0[qs] = mx;
                float ls = 0.f;
#pragma unroll
                for (int kt = 0; kt < 4; ++kt)
#pragma unroll
                    for (int r = 0; r < 4; ++r) { w[kt][r] = S[kt][r] > -1e29f ? __expf(S[kt][r] - mx) : 0.f; ls += w[kt][r]; }
                st1[qs] = st1[qs] * corr + ls;
#pragma unroll
                for (int dt = 0; dt < 4; ++dt) O[qs][dt] = O[qs][dt] * corr;
            }
            const bf16x8 pf0 = mk8(pk2(w[0][0], w[0][1]), pk2(w[0][2], w[0][3]), pk2(w[1][0], w[1][1]), pk2(w[1][2], w[1][3]));
            const bf16x8 pf1 = mk8(pk2(w[2][0], w[2][1]), pk2(w[2][2], w[2][3]), pk2(w[3][0], w[3][1]), pk2(w[3][2], w[3][3]));
            {
                LAS const unsigned char* vb = Vt + (4 * l4 + (l15 >> 2)) * 144 + 8 * (l15 & 3);
#pragma unroll
                for (int dt = 0; dt < 4; ++dt) {
                    const s16x4 a0 = lds_tr4(vb + 32 * dt), b0 = lds_tr4(vb + 16 * 144 + 32 * dt), a1 = lds_tr4(vb + 32 * 144 + 32 * dt), b1 = lds_tr4(vb + 48 * 144 + 32 * dt);
                    const bf16x8 v0 = {a0[0], a0[1], a0[2], a0[3], b0[0], b0[1], b0[2], b0[3]}, v1 = {a1[0], a1[1], a1[2], a1[3], b1[0], b1[1], b1[2], b1[3]};
                    O[qs][dt] = amfma(v0, pf0, O[qs][dt]);
                    O[qs][dt] = amfma(v1, pf1, O[qs][dt]);
                }
            }
        }
        if (KIND == 0) { float rmin = st0[0];
#pragma unroll
            for (int qs = 1; qs < NQS; ++qs) rmin = fminf(rmin, st0[qs]);
            if (__all(rmin > 104.f)) break; }
    }
#pragma unroll
    for (int qs = 0; qs < NQS; ++qs) {
        float sc = 1.f;
        if (KIND) { float l = st1[qs]; l += __shfl_xor(l, 16); l += __shfl_xor(l, 32); sc = 1.f / l; }
#pragma unroll
        for (int dt = 0; dt < 4; ++dt) { u32x2 o; o.x = pk2(O[qs][dt][0] * sc, O[qs][dt][1] * sc); o.y = pk2(O[qs][dt][2] * sc, O[qs][dt][3] * sc);
            *(u32x2*)(oatt + (rowb + 16 * qs + l15) * 1024 + ocol + 16 * dt + 4 * l4) = o; }
    }
}
__device__ __forceinline__ void att_phase(const Args& a, LAS unsigned char* lds, const bf16_t* proj, bf16_t* oatt) {
    const int lane = tid_fresh() & 63, wave = tid_fresh() >> 6;
    LAS unsigned char* wl = lds + wave * 18432;
    const int NGW = gridDim.x * 8;
    for (int it = blockIdx.x * 8 + wave; it < 8192; it += NGW) {
        const int kind = it >> 12, r = it & 4095;
        const int qbi = 127 - (r & 127), h = (r >> 7) & 7, b = r >> 10;
        if (kind == 0) att_item<0, 2>(proj, oatt, a.in[8], a.in[9], a.in[10], wl, b, h, qbi, lane);
        else att_item<1, 2>(proj, oatt, a.in[8], a.in[9], a.in[10], wl, b, h, qbi, lane);
    }
}
__device__ __forceinline__ f32x4 mfma16(bf16x8 x, bf16x8 y, f32x4 c) { return __builtin_amdgcn_mfma_f32_16x16x32_bf16(x, y, c, 0, 0, 0); }
__device__ __forceinline__ bf16_t f2bf(float x) { return (bf16_t)(pk2(x, 0.f) & 0xffffu); }

__device__ __forceinline__ void gdn_prep_phase(const Args& a, LAS unsigned char* lds, const bool dry = false) {
    const int tid = tid_fresh(), lane = tid & 63, wave = tid >> 6;
    unsigned char* ws = a.ws;
    bf16_t* QKV = (bf16_t*)(ws + OFF_QKV); const bf16_t* halo = (const bf16_t*)(ws + OFF_HALO); const float* gates = (const float*)(ws + OFF_GATES);
    float* gb = (float*)(ws + OFF_GB); bf16_t* Tinv = (bf16_t*)(ws + OFF_TINV); bf16_t* attn = (bf16_t*)(ws + OFF_ATTN);
    const float* convw = a.in[13]; const float* a_log = a.in[14]; const float* dtb = a.in[15];
    constexpr int CSP = 1040;
    LAS unsigned char* cs = lds;
    LAS float* kkf = (LAS float*)(lds + 69888);
    LAS float* qkf = (LAS float*)(lds + 69888 + 17408);
    LAS float* Lm = (LAS float*)(lds + 104704);
    LAS float* betas = (LAS float*)(lds + 137472);
    LAS float* gcs = betas + 128;
    auto fetch_raw = [&](int item, u32x4 (&raw)[9]) {
        const int n = item & 63, hk = (item >> 6) & 7, b = item >> 9;
        const size_t row0 = (size_t)b * 4096 + 64 * n;
#pragma unroll
        for (int i = 0; i < 9; ++i) { const int v = tid + 512 * i; raw[i] = (u32x4){0u, 0u, 0u, 0u};
            if (v < 67 * 64) { const int r = v >> 6, ch = 8 * (v & 63);
                const int gcol = ch < 128 ? hk * 128 + ch : (ch < 256 ? 1024 + hk * 128 + (ch - 128) : 2048 + hk * 256 + (ch - 256));
                if (r >= 3) raw[i] = *(const u32x4*)(QKV + (row0 + r - 3) * 4096 + gcol);
                else if (n > 0) raw[i] = *(const u32x4*)(halo + ((size_t)(b * 64 + n - 1) * 3 + r) * 4096 + gcol); } }
    };
    u32x4 raw[9];
    if ((int)blockIdx.x < 2048) fetch_raw(blockIdx.x, raw);
    for (int item = blockIdx.x; item < 2048; item += gridDim.x) {
        const int n = item & 63, hk = (item >> 6) & 7, b = item >> 9;
        const size_t row0 = (size_t)b * 4096 + 64 * n;
        __syncthreads();
#pragma unroll
        for (int i = 0; i < 9; ++i) { const int v = tid + 512 * i; if (v < 67 * 64) *(LAS u32x4*)(cs + (v >> 6) * CSP + 16 * (v & 63)) = raw[i]; }
        if (item + (int)gridDim.x < 2048) fetch_raw(item + gridDim.x, raw);
        __syncthreads();
        {
            const int ch = tid;
            const int gcol = ch < 128 ? hk * 128 + ch : (ch < 256 ? 1024 + hk * 128 + (ch - 128) : 2048 + hk * 256 + (ch - 256));
            const float w0 = convw[gcol], w1 = convw[4096 + gcol], w2 = convw[8192 + gcol], w3 = convw[12288 + gcol];
            LAS bf16_t* col = (LAS bf16_t*)(cs + ch * 2);
            float x0 = bf2f(col[0]), x1 = bf2f(col[520]), x2 = bf2f(col[1040]);
#pragma unroll 8
            for (int t = 0; t < 64; ++t) { const float x3 = bf2f(col[(t + 3) * 520]);
                const float y = (w0 * x0 + w1 * x1) + (w2 * x2 + w3 * x3);
                col[(t + 3) * 520] = f2bf(silu_(y)); x0 = x1; x1 = x2; x2 = x3; }
        }
        __syncthreads();
        {
            const int pair = tid >> 2, t = pair >> 1, part = pair & 1, qd = tid & 3;
            LAS u32x4* p = (LAS u32x4*)(cs + (t + 3) * CSP + part * 256 + qd * 64);
            u32x4 u[4]; float ss = 0.f;
#pragma unroll
            for (int i = 0; i < 4; ++i) { u[i] = p[i];
                ss += (bf_lo(u[i].x) * bf_lo(u[i].x) + bf_hi(u[i].x) * bf_hi(u[i].x)) + (bf_lo(u[i].y) * bf_lo(u[i].y) + bf_hi(u[i].y) * bf_hi(u[i].y))
                    + (bf_lo(u[i].z) * bf_lo(u[i].z) + bf_hi(u[i].z) * bf_hi(u[i].z)) + (bf_lo(u[i].w) * bf_lo(u[i].w) + bf_hi(u[i].w) * bf_hi(u[i].w)); }
            ss += __shfl_xor(ss, 1); ss += __shfl_xor(ss, 2);
            const float inv = rsqrtf(ss + 1e-6f) * (part == 0 ? 0.08838834764831845f : 1.f);
            bf16_t* gp = QKV + (row0 + t) * 4096 + part * 1024 + hk * 128 + qd * 32;
#pragma unroll
            for (int i = 0; i < 4; ++i) { u32x4 w;
                w.x = pk2(bf_lo(u[i].x) * inv, bf_hi(u[i].x) * inv); w.y = pk2(bf_lo(u[i].y) * inv, bf_hi(u[i].y) * inv);
                w.z = pk2(bf_lo(u[i].z) * inv, bf_hi(u[i].z) * inv); w.w = pk2(bf_lo(u[i].w) * inv, bf_hi(u[i].w) * inv);
                p[i] = w; if (!dry) *(u32x4*)(gp + 8 * i) = w; }
        }
        for (int v = tid; v < 2048; v += 512) { const int t = v >> 5, c8 = v & 31;
            if (!dry) *(u32x4*)(QKV + (row0 + t) * 4096 + 2048 + hk * 256 + 8 * c8) = *(LAS const u32x4*)(cs + (t + 3) * CSP + 512 + 16 * c8); }
        if (tid < 128) {
            const int hvl = tid >> 6, hv = 2 * hk + hvl; const size_t row = row0 + lane;
            const float bl = gates[row * 32 + hv], av = gates[row * 32 + 16 + hv];
            const float beta = sigm(bl); const float xx = av + dtb[hv];
            const float ex = __expf(-fabsf(xx));
            const float sp = fmaxf(xx, 0.f) + (ex < 1e-4f ? ex * (1.f - 0.5f * ex) : __logf(1.f + ex));
            float g = -__expf(a_log[hv]) * sp;
#pragma unroll
            for (int o = 1; o < 64; o <<= 1) { const float y = __shfl_up(g, o); if (lane >= o) g += y; }
            betas[hvl * 64 + lane] = beta; gcs[hvl * 64 + lane] = g;
            float2 bg; bg.x = beta; bg.y = g; if (!dry) *(float2*)(gb + (row * 16 + hv) * 2) = bg;
        }
        __syncthreads();
        {
            const int ct = wave & 3, which = wave >> 2, l15 = lane & 15, l4 = lane >> 4;
            LAS float* dstm = which ? qkf : kkf;
            bf16x8 ya[4];
#pragma unroll
            for (int ks = 0; ks < 4; ++ks) ya[ks] = *(LAS const bf16x8*)(cs + (3 + 16 * ct + l15) * CSP + (which ? 0 : 256) + (32 * ks + 8 * l4) * 2);
#pragma unroll
            for (int st = 0; st < 4; ++st) { f32x4 acc = {0.f, 0.f, 0.f, 0.f};
#pragma unroll
                for (int ks = 0; ks < 4; ++ks) { const bf16x8 xs = *(LAS const bf16x8*)(cs + (3 + 16 * st + l15) * CSP + 256 + (32 * ks + 8 * l4) * 2); acc = mfma16(xs, ya[ks], acc); }
                *(LAS f32x4*)(dstm + (16 * ct + l15) * 68 + 16 * st + 4 * l4) = acc; }
        }
        __syncthreads();
        {
            const int hvl = tid >> 8, c = (tid >> 2) & 63, s0 = 16 * (tid & 3), hv = 2 * hk + hvl;
            const float gcc = gcs[hvl * 64 + c], bc = betas[hvl * 64 + c];
            unsigned aw[8];
#pragma unroll
            for (int i = 0; i < 16; i += 2) {
                float lv[2], av[2];
#pragma unroll
                for (int e = 0; e < 2; ++e) { const int s_ = s0 + i + e; const float dec = c >= s_ ? __expf(gcc - gcs[hvl * 64 + s_]) : 0.f;
                    lv[e] = c > s_ ? bc * kkf[c * 68 + s_] * dec : 0.f; av[e] = qkf[c * 68 + s_] * dec; }
                Lm[hvl * 4096 + c * 64 + s0 + i] = lv[0]; Lm[hvl * 4096 + c * 64 + s0 + i + 1] = lv[1];
                aw[i >> 1] = pk2(av[0], av[1]); }
            if (!dry) { bf16_t* ap = attn + ((size_t)((b * 16 + hv) * 64 + n)) * 4096 + c * 64 + s0;
                u32x4 w0 = {aw[0], aw[1], aw[2], aw[3]}, w1 = {aw[4], aw[5], aw[6], aw[7]}; *(u32x4*)ap = w0; *(u32x4*)(ap + 8) = w1; }
        }
        __syncthreads();
        LAS float* X = kkf;
        LAS float* Mb = (LAS float*)cs;
        if (tid < 128) {
            const int hvl = tid >> 6, half = lane >> 5, jj = lane & 31, base = 32 * half;
            LAS const float* Lh = Lm + hvl * 4096 + base * 64 + base;
            LAS float* Xh = X + hvl * 4096;
            float x[32];
#pragma unroll
            for (int c = 0; c < 32; ++c) x[c] = 0.f;
#pragma unroll
            for (int c = 0; c < 32; ++c) { float a0 = (c == jj) ? 1.f : 0.f, a1 = 0.f, a2 = 0.f, a3 = 0.f;
#pragma unroll
                for (int s4 = 0; s4 < (c + 3) / 4; ++s4) { const f32x4 Lv = *(LAS const f32x4*)(Lh + c * 64 + 4 * s4);
                    a0 -= Lv[0] * x[4 * s4]; a1 -= Lv[1] * x[4 * s4 + 1]; a2 -= Lv[2] * x[4 * s4 + 2]; a3 -= Lv[3] * x[4 * s4 + 3]; }
                x[c] = (a0 + a1) + (a2 + a3);
                Xh[(base + c) * 64 + base + jj] = x[c];
                if (half == 0) Xh[c * 64 + 32 + jj] = 0.f; }
        }
        __syncthreads();
        {
            const int hvl = tid >> 8, r = (tid >> 3) & 31, q0 = 4 * (tid & 7);
            LAS const float* Lh = Lm + hvl * 4096; LAS float* Xh = X + hvl * 4096;
            f32x4 m = {0.f, 0.f, 0.f, 0.f};
#pragma unroll 8
            for (int t = 0; t < 32; ++t) m = m + *(LAS const f32x4*)(Xh + t * 64 + q0) * Lh[(32 + r) * 64 + t];
            *(LAS f32x4*)(Mb + hvl * 1024 + r * 32 + q0) = m;
            __syncthreads();
            f32x4 e = {0.f, 0.f, 0.f, 0.f};
#pragma unroll 8
            for (int t = 0; t < 32; ++t) e = e - *(LAS const f32x4*)(Mb + hvl * 1024 + t * 32 + q0) * Xh[(32 + r) * 64 + 32 + t];
            *(LAS f32x4*)(Xh + (32 + r) * 64 + q0) = e;
        }
        __syncthreads();
        if (!dry) {
            const int hvl = tid >> 8, c = (tid >> 2) & 63, s0 = 16 * (tid & 3), hv = 2 * hk + hvl;
            LAS const float* xr = X + hvl * 4096 + c * 64 + s0;
            const f32x4 a0 = *(LAS const f32x4*)xr, a1 = *(LAS const f32x4*)(xr + 4), a2 = *(LAS const f32x4*)(xr + 8), a3 = *(LAS const f32x4*)(xr + 12);
            bf16_t* tp = Tinv + ((size_t)((b * 16 + hv) * 64 + n)) * 4096 + c * 64 + s0;
            u32x4 w0 = {pk2(a0[0], a0[1]), pk2(a0[2], a0[3]), pk2(a1[0], a1[1]), pk2(a1[2], a1[3])}, w1 = {pk2(a2[0], a2[1]), pk2(a2[2], a2[3]), pk2(a3[0], a3[1]), pk2(a3[2], a3[3])};
            *(u32x4*)tp = w0; *(u32x4*)(tp + 8) = w1;
        }
    }
}

constexpr int SC_KT = 0, SC_QT = 17408, SC_TT = 34816, SC_AT = 44032, SC_VT = 53248, SC_GB = 58368, SC_STRIDE = 58880, SC_BASE = 22528;
struct ScanStage { u32x4 k[2], q[2], t, a, v; f2v_t g; };
__device__ __forceinline__ void scan_fetch(ScanStage& o, const bf16_t* QKV, const float* gb, const bf16_t* Tinv, const bf16_t* attn, int b, int hv, int hk, int j, int n, int tid) {
    const size_t row0 = (size_t)b * 4096 + 64 * n;
    const size_t itm = (size_t)((b * 16 + hv) * 64 + n) * 4096;
#pragma unroll
    for (int i = 0; i < 2; ++i) { const int idx = tid + 512 * i, row = idx >> 4, c16 = idx & 15;
        o.q[i] = *(const u32x4*)(QKV + (row0 + row) * 4096 + hk * 128 + 8 * c16);
        o.k[i] = *(const u32x4*)(QKV + (row0 + row) * 4096 + 1024 + hk * 128 + 8 * c16); }
    o.t = *(const u32x4*)(Tinv + itm + (tid >> 3) * 64 + 8 * (tid & 7));
    o.a = *(const u32x4*)(attn + itm + (tid >> 3) * 64 + 8 * (tid & 7));
    if (tid < 256) o.v = *(const u32x4*)(QKV + (row0 + (tid >> 2)) * 4096 + 2048 + hv * 128 + 32 * j + 8 * (tid & 3));
    else if (tid < 320) o.g = *(const f2v_t*)(gb + ((row0 + (tid - 256)) * 16 + hv) * 2);
}
__device__ __forceinline__ void scan_park(const ScanStage& o, LAS unsigned char* img, int tid) {
#pragma unroll
    for (int i = 0; i < 2; ++i) { const int idx = tid + 512 * i, row = idx >> 4, c16 = idx & 15;
        *(LAS u32x4*)(img + SC_QT + row * 272 + c16 * 16) = o.q[i]; *(LAS u32x4*)(img + SC_KT + row * 272 + c16 * 16) = o.k[i]; }
    *(LAS u32x4*)(img + SC_TT + (tid >> 3) * 144 + (tid & 7) * 16) = o.t;
    *(LAS u32x4*)(img + SC_AT + (tid >> 3) * 144 + (tid & 7) * 16) = o.a;
    if (tid < 256) *(LAS u32x4*)(img + SC_VT + (tid >> 2) * 80 + (tid & 3) * 16) = o.v;
    else if (tid < 320) *(LAS f2v_t*)(img + SC_GB + (tid - 256) * 8) = o.g;
}
__device__ __forceinline__ void gdn_scan_phase(const Args& a, LAS unsigned char* lds, const bool dry = false) {
    const int tid = tid_fresh(), lane = tid & 63, wave = tid >> 6, l15 = lane & 15, l4 = lane >> 4, ct = wave >> 1, dt = wave & 1;
    unsigned char* ws = a.ws;
    bf16_t* QKV = (bf16_t*)(ws + OFF_QKV); const float* gb = (const float*)(ws + OFF_GB);
    const bf16_t* Tinv = (const bf16_t*)(ws + OFF_TINV); const bf16_t* attn = (const bf16_t*)(ws + OFF_ATTN);
    LAS unsigned char* Sb = lds; LAS unsigned char* RT = lds + 8704; LAS unsigned char* vnT = lds + 13312; LAS unsigned char* vnsT = lds + 17920;
    for (int item = VCU(lds); item < 256; item += gridDim.x) {
        const int j = item & 3, hv = (item >> 2) & 15, b = item >> 6, hk = hv >> 1;
        __syncthreads();
        for (int i = tid; i < 8704 / 4; i += 512) ((LAS unsigned*)Sb)[i] = 0u;
        f32x4 S0 = {0.f, 0.f, 0.f, 0.f}, S1 = {0.f, 0.f, 0.f, 0.f};
        { ScanStage s0; scan_fetch(s0, QKV, gb, Tinv, attn, b, hv, hk, j, 0, tid); scan_park(s0, lds + SC_BASE, tid); }
        __syncthreads();
        for (int n = 0; n < 64; ++n) {
            LAS const unsigned char* img = lds + SC_BASE + (n & 1) * SC_STRIDE;
            ScanStage nx; scan_fetch(nx, QKV, gb, Tinv, attn, b, hv, hk, j, n < 63 ? n + 1 : 63, tid);
            bf16_t* vcol = QKV + ((size_t)b * 4096 + 64 * n + 16 * ct + 4 * l4) * 4096 + 2048 + hv * 128 + 32 * j + 16 * dt + l15;
            float vv[4], be[4], gcr[4];
#pragma unroll
            for (int r = 0; r < 4; ++r) { vv[r] = bf2f(*(LAS const bf16_t*)(img + SC_VT + (16 * ct + 4 * l4 + r) * 80 + (16 * dt + l15) * 2));
                const f2v_t bg = *(LAS const f2v_t*)(img + SC_GB + (16 * ct + 4 * l4 + r) * 8); be[r] = bg.x; gcr[r] = bg.y; }
            const float gcl = *(LAS const float*)(img + SC_GB + 63 * 8 + 4);
            f32x4 KS = {0.f, 0.f, 0.f, 0.f}, QS = {0.f, 0.f, 0.f, 0.f};
#pragma unroll
            for (int ks = 0; ks < 4; ++ks) { const bf16x8 sf = *(LAS const bf16x8*)(Sb + (16 * dt + l15) * 272 + (32 * ks + 8 * l4) * 2);
                const bf16x8 kf = *(LAS const bf16x8*)(img + SC_KT + (16 * ct + l15) * 272 + (32 * ks + 8 * l4) * 2), qf = *(LAS const bf16x8*)(img + SC_QT + (16 * ct + l15) * 272 + (32 * ks + 8 * l4) * 2);
                KS = mfma16(kf, sf, KS); QS = mfma16(qf, sf, QS); }
            float Oacc[4], Rr[4];
#pragma unroll
            for (int r = 0; r < 4; ++r) { const float eg = __expf(gcr[r]); Rr[r] = be[r] * (vv[r] - eg * KS[r]); Oacc[r] = eg * QS[r]; }
            { u32x2 w; w.x = pk2(Rr[0], Rr[1]); w.y = pk2(Rr[2], Rr[3]); *(LAS u32x2*)(RT + (16 * dt + l15) * 144 + (16 * ct + 4 * l4) * 2) = w; }
            __syncthreads();
            f32x4 VN = {0.f, 0.f, 0.f, 0.f};
#pragma unroll
            for (int k2 = 0; k2 < 2; ++k2) { const bf16x8 rf = *(LAS const bf16x8*)(RT + (16 * dt + l15) * 144 + (32 * k2 + 8 * l4) * 2);
                const bf16x8 tf = *(LAS const bf16x8*)(img + SC_TT + (16 * ct + l15) * 144 + (32 * k2 + 8 * l4) * 2); VN = mfma16(tf, rf, VN); }
            { u32x2 w; w.x = pk2(VN[0], VN[1]); w.y = pk2(VN[2], VN[3]); *(LAS u32x2*)(vnT + (16 * dt + l15) * 144 + (16 * ct + 4 * l4) * 2) = w;
              u32x2 x; x.x = pk2(VN[0] * __expf(gcl - gcr[0]), VN[1] * __expf(gcl - gcr[1])); x.y = pk2(VN[2] * __expf(gcl - gcr[2]), VN[3] * __expf(gcl - gcr[3]));
              *(LAS u32x2*)(vnsT + (16 * dt + l15) * 144 + (16 * ct + 4 * l4) * 2) = x; }
            __syncthreads();
            f32x4 O = {Oacc[0], Oacc[1], Oacc[2], Oacc[3]};
#pragma unroll
            for (int k2 = 0; k2 < 2; ++k2) { const bf16x8 vf = *(LAS const bf16x8*)(vnT + (16 * dt + l15) * 144 + (32 * k2 + 8 * l4) * 2);
                const bf16x8 af = *(LAS const bf16x8*)(img + SC_AT + (16 * ct + l15) * 144 + (32 * k2 + 8 * l4) * 2); O = mfma16(af, vf, O); }
#pragma unroll
            for (int r = 0; r < 4; ++r) { if (!dry) vcol[(size_t)r * 4096] = f2bf(O[r]); }
            const float dec = __expf(gcl);
            S0 = S0 * dec; S1 = S1 * dec;
#pragma unroll
            for (int k2 = 0; k2 < 2; ++k2) {
                LAS const unsigned char* kb_ = img + SC_KT + (32 * k2 + 8 * l4 + (l15 >> 2)) * 272 + 32 * wave + 8 * (l15 & 3);
                const s16x4 ka = lds_tr4(kb_), kc = lds_tr4(kb_ + 4 * 272);
                const bf16x8 ktf = {ka[0], ka[1], ka[2], ka[3], kc[0], kc[1], kc[2], kc[3]};
                const bf16x8 v0 = *(LAS const bf16x8*)(vnsT + l15 * 144 + (32 * k2 + 8 * l4) * 2), v1 = *(LAS const bf16x8*)(vnsT + (16 + l15) * 144 + (32 * k2 + 8 * l4) * 2);
                S0 = mfma16(ktf, v0, S0); S1 = mfma16(ktf, v1, S1); }
            { u32x2 w; w.x = pk2(S0[0], S0[1]); w.y = pk2(S0[2], S0[3]); *(LAS u32x2*)(Sb + l15 * 272 + (16 * wave + 4 * l4) * 2) = w;
              u32x2 x; x.x = pk2(S1[0], S1[1]); x.y = pk2(S1[2], S1[3]); *(LAS u32x2*)(Sb + (16 + l15) * 272 + (16 * wave + 4 * l4) * 2) = x; }
            scan_park(nx, lds + SC_BASE + ((n + 1) & 1) * SC_STRIDE, tid);
            __syncthreads();
        }
    }
}

__device__ __forceinline__ void gdn_z_phase(const Args& a, LAS unsigned char* lds) {
    const int tid = tid_fresh();
    unsigned char* ws = a.ws;
    const bf16_t* QKV = (const bf16_t*)(ws + OFF_QKV);
    LAS float* tab = (LAS float*)(lds + TABO_OFF);
    pg8::StaticOrder S; S.init(MROWS, 2048, gridDim.x, VB(lds));
    Unit u;
    for (int i = 0; i < 8 && S.next(i, u); ++i) {
        const int rl = tid >> 1, bj = tid & 1;
        const bf16_t* op = QKV + (size_t)(u.pm * 256 + rl) * 4096 + 2048 + (2 * u.pn + bj) * 128;
        float ss = 0.f;
#pragma unroll
        for (int c = 0; c < 16; ++c) { const u32x4 v = *(const u32x4*)(op + 8 * c);
            ss += (bf_lo(v.x) * bf_lo(v.x) + bf_hi(v.x) * bf_hi(v.x)) + (bf_lo(v.y) * bf_lo(v.y) + bf_hi(v.y) * bf_hi(v.y)) + (bf_lo(v.z) * bf_lo(v.z) + bf_hi(v.z) * bf_hi(v.z)) + (bf_lo(v.w) * bf_lo(v.w) + bf_hi(v.w) * bf_hi(v.w)); }
        tab[i * 512 + rl * 2 + bj] = rsqrtf(ss * (1.f / 128.f) + 1e-6f);
    }
    fill_rstd_tab(lds, (const float*)(ws + OFF_SSQA), 2048);
    EpiT e{}; e.mode = 3; e.tabr = (LAS const float*)(lds + TABR_OFF); e.out = (bf16_t*)(ws + OFF_OB); e.osrc = QKV; e.ogain = a.in[16]; e.tabo = tab; e.S.init(MROWS, 2048, gridDim.x, VB(lds));
    run_gemm(lds, (const bf16_t*)(ws + OFF_SA), (const bf16_t*)(ws + OFF_WZ), 2048, 1024, e);
}
extern __shared__ __attribute__((aligned(16))) unsigned char dyn_lds[];
constexpr int LDS_BYTES = 160 * 1024;
__global__ void __launch_bounds__(512, 2) mega(Args a) {
    cg::grid_group grid = cg::this_grid();
    LAS unsigned char* lds = (LAS unsigned char*)dyn_lds;
    unsigned char* ws = a.ws;
#define WB(off) ((bf16_t*)(ws + (off)))
#define WF(off) ((float*)(ws + (off)))
    float* out = a.out;
    signed char* LO = (signed char*)a.out;
    signed char* LO2 = (signed char*)(ws + 187 * MIB + MIB / 2);
    unsigned* bar = (unsigned*)(ws + 246 * MIB);
    XcdBarrier xb; xb.bar = bar; xb.x = xb_xcc_id(); xb.st = (volatile LAS unsigned*)(lds + 163792);
    if (tid_fresh() == 0) {
        const unsigned rank = xb_add(&bar[XB_XCNT(xb.x)], 1u);
        *(LAS int*)(lds + 163780) = (int)xb.x; *(LAS int*)(lds + 163784) = (int)rank; xb.st[0] = 0u; xb.st[1] = 0u; }
    __syncthreads();
    p0_phase(a, lds);
    if (ws == nullptr) grid.sync();
    xcd_barrier(xb);
    if (tid_fresh() == 0) {
        const int xcc = *(LAS const int*)(lds + 163780), rank = *(LAS const int*)(lds + 163784), G = (int)gridDim.x;
        int pre = 0; for (int x = 0; x < 8; ++x) { const unsigned cx = xb_ld(&bar[XB_XCNT(x)]); if (x < xcc) pre += (int)cx; }
        const int vcu = pre + rank;
        *(LAS int*)(lds + 163776) = (G % 8 == 0) ? (vcu % (G / 8)) * 8 + vcu / (G / 8) : vcu; *(LAS int*)(lds + 163788) = vcu; }
    __syncthreads();
    gemm_gu(lds, WB(OFF_SA), WF(OFF_SSQA), WB(OFF_WGU00), WB(OFF_BIG));
    slack_convert(a, lds, 5632, 2, 5);
    xcd_barrier(xb);
    gemm_res(lds, WB(OFF_BIG), WB(OFF_WD00), 2816, HRef{a.in[0], nullptr, nullptr}, HDst{nullptr, WB(OFF_SB), LO, WF(OFF_SSQB)}, 0.5f);
    xcd_barrier(xb);
    fill_rstd_tab(lds, WF(OFF_SSQB), 2304);
    { EpiT e{}; e.mode = 1; e.tabr = (LAS const float*)(lds + TABR_OFF); e.out = WB(OFF_BIG); e.ldo = 2304; e.S.init(MROWS, 2304, gridDim.x, VB(lds)); run_gemm(lds, WB(OFF_SB), WB(OFF_WATTIN), 2304, 1024, e); }
    slack_convert(a, lds, 2304, 5, 10);
    xcd_barrier(xb);
    att_phase(a, lds, WB(OFF_BIG), WB(OFF_SA));
    xcd_barrier(xb);
    gemm_res(lds, WB(OFF_SA), WB(OFF_WATTOUT), 1024, HRef{nullptr, WB(OFF_SB), LO}, HDst{nullptr, WB(OFF_SB), LO, WF(OFF_SSQB)}, 1.0f);
    xcd_barrier(xb);
    gemm_gu(lds, WB(OFF_SB), WF(OFF_SSQB), WB(OFF_WGU01), WB(OFF_BIG));
    slack_convert(a, lds, 5632, 10, 13);
    xcd_barrier(xb);
    gemm_res(lds, WB(OFF_BIG), WB(OFF_WD01), 2816, HRef{nullptr, WB(OFF_SB), LO}, HDst{nullptr, WB(OFF_SA), LO, WF(OFF_SSQA)}, 0.5f);
    xcd_barrier(xb);
    ple_phase(lds, WB(OFF_PB), WB(OFF_WPP0), WB(OFF_BIG), WB(OFF_SA), WF(OFF_SSQA), WB(OFF_WPG0), HRef{nullptr, WB(OFF_SA), LO}, HDst{nullptr, WB(OFF_SB), LO, WF(OFF_SSQB)});
    xcd_barrier(xb);
    cvt_rows_bf16(a.in[1] + (size_t)MROWS * 256, WB(OFF_PB), 64, tid_fresh() & 63, blockIdx.x * 8 + (tid_fresh() >> 6), gridDim.x * 8);
    gemm_gu(lds, WB(OFF_SB), WF(OFF_SSQB), WB(OFF_WGU10), WB(OFF_BIG));
    slack_convert(a, lds, 5632, 13, 17);
    xcd_barrier(xb);
    gemm_res(lds, WB(OFF_BIG), WB(OFF_WD10), 2816, HRef{nullptr, WB(OFF_SB), LO}, HDst{nullptr, WB(OFF_SA), LO, WF(OFF_SSQA)}, 0.5f);
    xcd_barrier(xb);
    fill_rstd_tab(lds, WF(OFF_SSQA), 4352);
    { EpiT e{}; e.mode = 2; e.tabr = (LAS const float*)(lds + TABR_OFF); e.out = WB(OFF_QKV); e.halo = WB(OFF_HALO); e.gates = WF(OFF_GATES); e.S.init(MROWS, 4352, gridDim.x, VB(lds)); run_gemm(lds, WB(OFF_SA), WB(OFF_WQKVG), 4352, 1024, e); }
    slack_convert(a, lds, 4352, 17, 22);
    xcd_barrier(xb);
    gdn_prep_phase(a, lds);
    xcd_barrier(xb);
    gdn_scan_phase(a, lds);
    xcd_barrier(xb);
    gdn_z_phase(a, lds);
    xcd_barrier(xb);
    gemm_res(lds, WB(OFF_OB), WB(OFF_WGO), 2048, HRef{nullptr, WB(OFF_SA), LO}, HDst{nullptr, WB(OFF_H2), LO, WF(OFF_SSQB)}, 1.0f);
    xcd_barrier(xb);
    gemm_gu(lds, WB(OFF_H2), WF(OFF_SSQB), WB(OFF_WGU11), WB(OFF_ACT11));
    const bool pp1_ready = slack_pp(lds, 5632, WB(OFF_PB), WB(OFF_WPP1), WB(203 * MIB + MIB / 2));
    xcd_barrier(xb);
    gemm_res(lds, WB(OFF_ACT11), WB(OFF_WD11), 2816, HRef{nullptr, WB(OFF_H2), LO}, HDst{nullptr, WB(OFF_H3), LO2, WF(OFF_SSQA)}, 0.5f);
    xcd_barrier(xb);
    ple_phase(lds, WB(OFF_PB), WB(OFF_WPP1), WB(203 * MIB + MIB / 2), WB(OFF_H3), WF(OFF_SSQA), WB(OFF_WPG1), HRef{nullptr, WB(OFF_H3), LO2}, HDst{out, nullptr, nullptr, nullptr}, pp1_ready);
#undef WB
#undef WF
}

extern "C" void kernel_launch(void* const* d_in, const int* in_sizes, int n_in, void* d_out, int out_size, void* d_ws, size_t ws_size, hipStream_t stream) {
    static int grid = 0;
    if (!grid) {
        int dev = 0, cus = 0, per = 0;
        (void)hipGetDevice(&dev); (void)hipDeviceGetAttribute(&cus, hipDeviceAttributeMultiprocessorCount, dev);
        (void)hipFuncSetAttribute((const void*)mega, hipFuncAttributeMaxDynamicSharedMemorySize, LDS_BYTES);
        (void)hipOccupancyMaxActiveBlocksPerMultiprocessor(&per, (const void*)mega, 512, LDS_BYTES);
        if (per < 1) { fprintf(stderr, "occupancy query says %d blocks/CU\n", per); per = 1; }
        grid = cus;
    }
    if (n_in != 21 || ws_size < WS_NEED) { fprintf(stderr, "kernel_launch: unexpected inputs / workspace (%d, %zu)\n", n_in, ws_size); return; }
    Args a{};
    for (int i = 0; i < 21; ++i) a.in[i] = (const float*)d_in[i];
    a.out = (float*)d_out; a.ws = (unsigned char*)d_ws;
    int nd = 0;
    auto add = [&](int si, size_t soff, int gi, size_t goff, size_t dstoff, int ldsrc, int col0, int ncols, int K, int dstrow0, int mode) {
        WDesc& w = a.wd[nd++]; w.src_idx = si; w.src_off = (unsigned)soff; w.gain_idx = gi; w.gain_off = (unsigned)goff; w.dst_off = dstoff; w.ldsrc = ldsrc; w.col0 = col0; w.ncols = ncols; w.K = K; w.dstrow0 = dstrow0; w.mode = mode; };
    const size_t offgu[4] = {OFF_WGU00, OFF_WGU01, OFF_WGU10, OFF_WGU11}, offd[4] = {OFF_WD00, OFF_WD01, OFF_WD10, OFF_WD11};
    auto addgu = [&](int f) { add(3, (size_t)f * 1024 * 2816, 2, f * 1024, offgu[f], 2816, 0, 2816, 1024, 0, 1); add(4, (size_t)f * 1024 * 2816, 2, f * 1024, offgu[f], 2816, 0, 2816, 1024, 0, 2); };
    auto addd = [&](int f) { add(5, (size_t)f * 2816 * 1024, -1, 0, offd[f], 1024, 0, 1024, 2816, 0, 0); };
    addgu(0);
    addd(0); add(7, 0, 6, 0, OFF_WATTIN, 2304, 0, 2304, 1024, 0, 0); add(11, 0, -1, 0, OFF_WATTOUT, 1024, 0, 1024, 1024, 0, 0);
    addgu(1); addd(1); add(19, 0, 18, 0, OFF_WPG0, 1024, 0, 1024, 1024, 0, 0); add(20, 0, -1, 0, OFF_WPP0, 1024, 0, 1024, 256, 0, 0);
    addgu(2); addd(2);
    add(12, 0, 6, 1024, OFF_WQKVG, 6176, 0, 4096, 1024, 0, 0); add(12, 0, 6, 1024, OFF_WQKVG, 6176, 6144, 32, 1024, 4096, 0); add(12, 0, 6, 1024, OFF_WZ, 6176, 4096, 2048, 1024, 0, 0); add(17, 0, -1, 0, OFF_WGO, 1024, 0, 1024, 2048, 0, 0);
    addgu(3); addd(3); add(19, 1024 * 1024, 18, 1024, OFF_WPG1, 1024, 0, 1024, 1024, 0, 0); add(20, 256 * 1024, -1, 0, OFF_WPP1, 1024, 0, 1024, 256, 0, 0);
    (void)hipMemsetAsync((unsigned char*)d_ws + 246 * MIB, 0, XCD_BAR_WORDS * 4, stream);
    void* args[] = {&a};
    hipError_t e = hipLaunchCooperativeKernel((const void*)mega, dim3(grid), dim3(512), args, LDS_BYTES, stream);
    if (e != hipSuccess) fprintf(stderr, "cooperative launch failed: %s (grid %d)\n", hipGetErrorString(e), grid);
}
```

```cpp
#include <hip/hip_runtime.h>
#include <hip/hip_cooperative_groups.h>
#include <cstdio>
namespace cg = cooperative_groups;
__device__ __forceinline__ int tid_fresh() { int t = threadIdx.x; asm volatile("" : "+v"(t)); return t; }
namespace pg8 {
#define PG8_LAS __attribute__((address_space(3)))
typedef unsigned short bf16_t;
typedef short bf16x8 __attribute__((ext_vector_type(8)));
typedef float f32x4 __attribute__((ext_vector_type(4)));
typedef unsigned u32x4 __attribute__((ext_vector_type(4)));
constexpr int BM = 256, BK = 64, HALF = 128, HTB = HALF * BK * 2  , STAGE_BYTES = 8 * HTB, NXCD = 8, WGM = 8;

__host__ __device__ __forceinline__ int lds_byte(int r, int c) { const int st = (r >> 4) * 2 + (c >> 5), rr = r & 15, cc = c & 31, ob = rr * 64 + cc * 2; return st * 1024 + (ob ^ (((ob >> 9) & 1) << 5)); }
__host__ __device__ __forceinline__ void stage_rc(int b, int& R, int& C) { const int st = b / 1024, sb = b % 1024, swz = sb ^ (((sb >> 9) & 1) << 5); R = (st >> 1) * 16 + swz / 64; C = (st & 1) * 32 + (swz % 64) / 2; }
__host__ __device__ __forceinline__ int perm32(int rho) { const int n = rho >> 4, i = rho & 15; return 8 * (i >> 2) + 4 * n + (i & 3); }

struct Unit { int pm, pn; };
struct Gemm { const bf16_t* A; const bf16_t* Bt; int M, N, K; int atiled; int krot; };

struct StaticOrder {
    int nM, nN, nwg, G, c;
    __host__ __device__ void init(int M, int N, int G_, int c_) { nM = M / BM; nN = N / BM; nwg = nM * nN; G = G_; c = c_; }
    __host__ __device__ bool next(int i, Unit& u) const {
        const long L = (long)i * G + c; if (L >= nwg) return false;
        int wgid = (int)L; { const int q = nwg / NXCD, r = nwg % NXCD, xcd = wgid % NXCD, off = wgid / NXCD; wgid = (xcd < r ? xcd * (q + 1) : r * (q + 1) + (xcd - r) * q) + off; }
        const int nig = WGM * nN, gid = wgid / nig, fm = gid * WGM, gsz = (nM - fm) < WGM ? (nM - fm) : WGM;
        u.pm = fm + ((wgid % nig) % gsz); u.pn = (wgid % nig) / gsz; return true;
    }
    __device__ __forceinline__ void a_ready(const Unit&) const {}
    __device__ __forceinline__ void done(const Unit&) const {}
};
__device__ __forceinline__ unsigned cvt_pk_bf16(float lo, float hi) { unsigned r; asm volatile("v_cvt_pk_bf16_f32 %0, %1, %2" : "=v"(r) : "v"(lo), "v"(hi)); return r; }
template <class Epi, class Sched, bool STAMP = false>
__device__ __forceinline__ void gemm_phase(PG8_LAS unsigned char* lds, const Gemm g, const Sched& S, const Epi& E, unsigned long long* stamps) {
    const int tid = tid_fresh(), wid = __builtin_amdgcn_readfirstlane(tid >> 6), lane = tid & 63, wr = wid >> 2, wc = wid & 3, fr = lane & 15, fq = lane >> 4;
    const int K = g.K, nt = K / BK;
    int ts_lo = 0, ts_hi = 0, nts = 0; const unsigned long long rt_entry = STAMP ? (unsigned long long)wall_clock64() : 0ull;
#define PG8_STAMP() do { if (STAMP && wid == 0 && nts < 64) { const unsigned long long _c = (unsigned long long)clock64(); \
        ts_lo = (lane == nts) ? (int)(unsigned)_c : ts_lo; ts_hi = (lane == nts) ? (int)(unsigned)(_c >> 32) : ts_hi; ++nts; } } while (0)
    PG8_STAMP();
    unsigned voffA[2], voffB[2];
#pragma unroll
    for (int i = 0; i < 2; ++i) { int R, C; stage_rc(tid * 16 + i * 8192, R, C); const int Rb = Epi::PERM ? ((R & ~31) + perm32(R & 31)) : R;
        voffA[i] = (unsigned)(R * (g.atiled ? BK : K) + C) * 2u; voffB[i] = (unsigned)(Rb * K + C) * 2u; }
    const size_t kstep = (size_t)(BK * 2);
    const size_t hstep = (size_t)HALF * K * 2;
    const size_t tstep = 2 * hstep;
    const size_t kstepA = g.atiled ? (size_t)(BM * BK * 2) : kstep, hstepA = g.atiled ? (size_t)(HALF * BK * 2) : hstep;
    const unsigned ldsw = (unsigned)wid * 1024u;
    const int aoff = lds_byte(wr * 64 + fr, fq * 8), boff = lds_byte(wc * 32 + fr, fq * 8);
#define PG8_SA(b, h) (((b) * 2 + (h)) * HTB)
#define PG8_SB(b, h) ((4 + (b) * 2 + (h)) * HTB)
#define PG8_STAGE(bufoff, gbase, voff) do { _Pragma("unroll") for (int _i = 0; _i < 2; ++_i) \
        __builtin_amdgcn_global_load_lds((const unsigned*)((const char*)(gbase) + (voff)[_i]), (PG8_LAS unsigned*)(lds + (bufoff) + ldsw + _i * 8192), 16, 0, 0); } while (0)
#define PG8_LDA(dst, b, h) do { _Pragma("unroll") for (int m = 0; m < 4; ++m) _Pragma("unroll") for (int k = 0; k < 2; ++k) dst[m][k] = *(const PG8_LAS bf16x8*)(lds + PG8_SA(b, h) + aoff + m * 2048 + k * 1024); } while (0)
#define PG8_LDB(dst, b, h) do { _Pragma("unroll") for (int n = 0; n < 2; ++n) _Pragma("unroll") for (int k = 0; k < 2; ++k) dst[n][k] = *(const PG8_LAS bf16x8*)(lds + PG8_SB(b, h) + boff + n * 2048 + k * 1024); } while (0)
#define PG8_MMA(ai, bj, At, Bt) do { __builtin_amdgcn_s_setprio(1); _Pragma("unroll") for (int m = 0; m < 4; ++m) _Pragma("unroll") for (int n = 0; n < 2; ++n) _Pragma("unroll") for (int k = 0; k < 2; ++k) \
        acc[ai][bj][m][n] = __builtin_amdgcn_mfma_f32_16x16x32_bf16(Bt[n][k], At[m][k], acc[ai][bj][m][n], 0, 0, 0); __builtin_amdgcn_s_setprio(0); } while (0)
#define PG8_WAIT_V(n) asm volatile("s_waitcnt vmcnt(" #n ")" ::: "memory")
#define PG8_WAIT_L(n) asm volatile("s_waitcnt lgkmcnt(" #n ")" ::: "memory")
#define PG8_BAR __builtin_amdgcn_s_barrier()
#define PG8_SCHED __builtin_amdgcn_sched_barrier(0)
    Unit cur, nxt; int ui = 0;
    if (!S.next(0, cur)) return;
    f32x4 acc[2][2][4][2];
#pragma unroll
    for (int a = 0; a < 2; ++a)
#pragma unroll
        for (int b = 0; b < 2; ++b)
#pragma unroll
            for (int m = 0; m < 4; ++m)
#pragma unroll
                for (int n = 0; n < 2; ++n) acc[a][b][m][n] = (f32x4){0.f, 0.f, 0.f, 0.f};
    bf16x8 At[4][2], B0[2][2], B1[2][2];
    const char* cA = (const char*)g.A + (size_t)cur.pm * tstep; const char* cB = (const char*)g.Bt + (size_t)cur.pn * tstep;
    int rc = g.krot ? (2 * (cur.pm & 7)) % nt : 0;
    S.a_ready(cur);
    PG8_STAGE(PG8_SB(0, 0), cB + rc * kstep, voffB); PG8_STAGE(PG8_SA(0, 0), cA + rc * kstepA, voffA); PG8_STAGE(PG8_SB(0, 1), cB + hstep + rc * kstep, voffB); PG8_STAGE(PG8_SA(0, 1), cA + hstepA + rc * kstepA, voffA);
    if (wr == 1) PG8_BAR;
    PG8_WAIT_V(4); PG8_BAR;
    PG8_STAGE(PG8_SB(1, 0), cB + (rc + 1) * kstep, voffB); PG8_STAGE(PG8_SA(1, 0), cA + (rc + 1) * kstepA, voffA); PG8_STAGE(PG8_SB(1, 1), cB + hstep + (rc + 1) * kstep, voffB);
    PG8_WAIT_V(6); PG8_BAR;
    PG8_STAMP();
    for (;;) {
        const bool has_next = S.next(ui + 1, nxt);
        const char* nA = has_next ? (const char*)g.A + (size_t)nxt.pm * tstep : cA; const char* nB = has_next ? (const char*)g.Bt + (size_t)nxt.pn * tstep : cB;
        const int rn = has_next ? (g.krot ? (2 * (nxt.pm & 7)) % nt : 0) : rc;
        for (int t = 0; t < nt; t += 2) {
            const bool last = (t == nt - 2);
            int p0 = t + rc; if (p0 >= nt) p0 -= nt; int p2 = p0 + 2; if (p2 >= nt) p2 -= nt;
            const char* a1 = cA + (size_t)(p0 + 1) * kstepA;
            const char* a2 = last ? nA + (size_t)rn * kstepA : cA + (size_t)p2 * kstepA; const char* b2 = last ? nB + (size_t)rn * kstep : cB + (size_t)p2 * kstep;
            const char* a3 = a2 + kstepA; const char* b3 = b2 + kstep;
            if (last && has_next) S.a_ready(nxt);
            PG8_LDB(B0, 0, 0); PG8_SCHED; PG8_LDA(At, 0, 0); PG8_STAGE(PG8_SA(1, 1), a1 + hstepA, voffA);
            PG8_WAIT_L(8); PG8_BAR; PG8_WAIT_L(0); PG8_MMA(0, 0, At, B0); PG8_BAR; PG8_SCHED;
            PG8_LDB(B1, 0, 1); PG8_STAGE(PG8_SB(0, 0), b2, voffB);
            PG8_BAR; PG8_WAIT_L(0); PG8_MMA(0, 1, At, B1); PG8_BAR;
            PG8_LDA(At, 0, 1); PG8_STAGE(PG8_SA(0, 0), a2, voffA);
            PG8_BAR; PG8_WAIT_L(0); PG8_MMA(1, 0, At, B0); PG8_BAR; PG8_SCHED;
            PG8_STAGE(PG8_SB(0, 1), b2 + hstep, voffB);
            PG8_WAIT_V(6); PG8_BAR; PG8_MMA(1, 1, At, B1); PG8_BAR;
            PG8_LDB(B0, 1, 0); PG8_SCHED; PG8_LDA(At, 1, 0); PG8_STAGE(PG8_SA(0, 1), a2 + hstepA, voffA);
            PG8_WAIT_L(8); PG8_BAR; PG8_WAIT_L(0); PG8_MMA(0, 0, At, B0); PG8_BAR; PG8_SCHED;
            PG8_LDB(B1, 1, 1); PG8_STAGE(PG8_SB(1, 0), b3, voffB);
            PG8_BAR; PG8_WAIT_L(0); PG8_MMA(0, 1, At, B1); PG8_BAR;
            PG8_LDA(At, 1, 1); PG8_STAGE(PG8_SA(1, 0), a3, voffA);
            PG8_BAR; PG8_WAIT_L(0); PG8_MMA(1, 0, At, B0); PG8_BAR; PG8_SCHED;
            PG8_STAGE(PG8_SB(1, 1), b3 + hstep, voffB);
            PG8_WAIT_V(6); PG8_BAR; PG8_MMA(1, 1, At, B1); PG8_BAR;
        }
        PG8_STAMP();
        if constexpr (!Epi::AFTER_DRAIN) { E(acc, cur, wr, wc, fr, fq); S.done(cur); }
        PG8_STAMP();
        if (!has_next) break;
#pragma unroll
        for (int a = 0; a < 2; ++a)
#pragma unroll
            for (int b = 0; b < 2; ++b)
#pragma unroll
                for (int m = 0; m < 4; ++m)
#pragma unroll
                    for (int n = 0; n < 2; ++n) acc[a][b][m][n] = (f32x4){0.f, 0.f, 0.f, 0.f};
        cur = nxt; cA = nA; cB = nB; rc = rn; ++ui;
    }
    PG8_WAIT_V(0);
    if (wr == 0) PG8_BAR;
    PG8_BAR;
    if constexpr (Epi::AFTER_DRAIN) { E.fused(acc, cur, wr, wc, fr, fq, lds, wid, lane); S.done(cur); }
    PG8_STAMP();
    if (STAMP && wid == 0) { stamps[lane] = lane < nts ? (((unsigned long long)(unsigned)ts_hi << 32) | (unsigned)ts_lo) : 0ull;
        if (lane == 62) stamps[62] = rt_entry; if (lane == 63) stamps[63] = (unsigned long long)wall_clock64(); }
#undef PG8_STAMP
#undef PG8_SA
#undef PG8_SB
#undef PG8_STAGE
#undef PG8_LDA
#undef PG8_LDB
#undef PG8_MMA
#undef PG8_WAIT_V
#undef PG8_WAIT_L
#undef PG8_BAR
#undef PG8_SCHED
}
}

using pg8::bf16_t; using pg8::bf16x8; using pg8::f32x4; using pg8::u32x4; using pg8::Unit;
typedef unsigned u32x2 __attribute__((ext_vector_type(2)));
typedef __bf16 bf2_t __attribute__((ext_vector_type(2)));
#define LAS __attribute__((address_space(3)))

constexpr int MROWS = 16384;
#define VCU(lds) (*(LAS const int*)((lds) + 163788))
#define VB(lds) (*(LAS const int*)((lds) + 163776))
constexpr size_t MIB = 1048576;
constexpr size_t OFF_WZ = 0, OFF_WGO = 4 * MIB, OFF_WGU11 = 8 * MIB, OFF_WD11 = 19 * MIB, OFF_WPG1 = 24 * MIB + MIB / 2, OFF_WPP1 = 26 * MIB + MIB / 2,
    OFF_WQKVG = 27 * MIB, OFF_WE = 35 * MIB + MIB / 2,
    OFF_WGU00 = OFF_WE, OFF_WD00 = OFF_WGU00 + 11 * MIB, OFF_WGU01 = OFF_WD00 + 11 * MIB / 2, OFF_WD01 = OFF_WGU01 + 11 * MIB,
    OFF_WATTIN = OFF_WD01 + 11 * MIB / 2, OFF_WATTOUT = OFF_WATTIN + 9 * MIB / 2, OFF_WPG0 = OFF_WATTOUT + 2 * MIB, OFF_WPP0 = OFF_WPG0 + 2 * MIB,
    OFF_WGU10 = OFF_WPP0 + MIB / 2, OFF_WD10 = OFF_WGU10 + 11 * MIB,
    OFF_SB = 94 * MIB, OFF_BIG = 126 * MIB, OFF_SSQA = 235 * MIB + MIB / 2, OFF_SSQB = OFF_SSQA + MIB, OFF_PB = OFF_SSQB + MIB, OFF_SA = 263422976,
    WS_NEED = OFF_SA + 32 * MIB,
    OFF_QKV = OFF_WE, OFF_GATES = OFF_QKV + 128 * MIB, OFF_HALO = OFF_GATES + 2 * MIB, OFF_TINV = OFF_HALO + 6 * MIB, OFF_ATTN = OFF_TINV + 32 * MIB,
    OFF_GB = OFF_WQKVG, OFF_OB = OFF_TINV, OFF_H2 = OFF_WE, OFF_ACT11 = OFF_H2 + 32 * MIB, OFF_H3 = OFF_ACT11 + 88 * MIB, OFF_PP1 = OFF_WE;
static_assert(OFF_WD10 + 11 * MIB / 2 == OFF_SB, "weights map");
static_assert(OFF_ATTN + 32 * MIB == OFF_SSQA, "gdn map");
static_assert(OFF_PB + 8 * MIB <= OFF_SA && WS_NEED <= 296977568ull, "ws size");

struct WDesc { unsigned long long dst_off; unsigned src_off, gain_off; int src_idx, gain_idx, ldsrc, col0, ncols, K, dstrow0, mode; };
constexpr int NDESC = 22;
struct Args { const float* in[21]; float* out; unsigned char* ws; WDesc wd[NDESC]; };

typedef float f2v_t __attribute__((ext_vector_type(2)));
__device__ __forceinline__ unsigned pk2(float lo, float hi) { const f2v_t f = {lo, hi}; const bf2_t r = __builtin_convertvector(f, bf2_t); return __builtin_bit_cast(unsigned, r); }
__device__ __forceinline__ float bf_lo(unsigned u) { return __uint_as_float(u << 16); }
__device__ __forceinline__ float bf_hi(unsigned u) { return __uint_as_float(u & 0xffff0000u); }
__device__ __forceinline__ float bf2f(bf16_t b) { return __uint_as_float(((unsigned)b) << 16); }
__device__ __forceinline__ float sigm(float x) { return __builtin_amdgcn_rcpf(1.f + __expf(-x)); }
__device__ __forceinline__ float silu_(float x) { return x * __builtin_amdgcn_rcpf(1.f + __expf(-x)); }
__device__ __forceinline__ float wave_sum(float v) {
#pragma unroll
    for (int o = 1; o < 64; o <<= 1) v += __shfl_xor(v, o);
    return v;
}
__device__ __forceinline__ float row_rstd(const float* ssq, int row) {
    const f32x4* p = (const f32x4*)(ssq + (size_t)row * 16);
    const f32x4 a = p[0], b = p[1], c = p[2], d = p[3];
    const float s = (((a.x + a.y) + (a.z + a.w)) + ((b.x + b.y) + (b.z + b.w))) + (((c.x + c.y) + (c.z + c.w)) + ((d.x + d.y) + (d.z + d.w)));
    return rsqrtf(s * (1.f / 1024.f) + 1e-6f);
}
__device__ __forceinline__ float dot2bf(unsigned a, unsigned b, float c) {
    return __builtin_amdgcn_fdot2_f32_bf16(__builtin_bit_cast(bf2_t, a), __builtin_bit_cast(bf2_t, b), c, false);
}

constexpr int TABR_OFF = 131072, TABO_OFF = 131072 + 8192;
__device__ __forceinline__ int unit_ordinal(const pg8::StaticOrder& S, const Unit& u) {
    int r = 0;
    for (int i = 0; i < 8; ++i) { Unit t; if (S.next(i, t) && t.pm == u.pm && t.pn == u.pn) r = i; }
    return r;
}
struct EpiT {
    static constexpr bool PERM = true, AFTER_DRAIN = false;
    int mode;
    LAS const float* tabr; bf16_t* out; int ldo;
    bf16_t* halo; float* gates;
    const bf16_t* osrc; const float* ogain; LAS const float* tabo; pg8::StaticOrder S;
    __device__ __forceinline__ void operator()(const f32x4 (&acc)[2][2][4][2], const Unit& u, int wr, int wc, int fr_, int fq_) const {
        int fr = fr_, fq = fq_; asm volatile("" : "+v"(fr), "+v"(fq));
        const int ui = unit_ordinal(S, u);
        if (mode == 3) {
            const int cg = wc * 32 + 8 * fq;
            const f32x4 ga = *(const f32x4*)(ogain + cg), gb = *(const f32x4*)(ogain + cg + 4);
#pragma unroll
            for (int ai = 0; ai < 2; ++ai) {
                u32x4 o8[4][2];
#pragma unroll
                for (int m = 0; m < 4; ++m)
#pragma unroll
                    for (int bj = 0; bj < 2; ++bj) o8[m][bj] = *(const u32x4*)(osrc + (size_t)(u.pm * 256 + ai * 128 + wr * 64 + m * 16 + fr) * 4096 + 2048 + u.pn * 256 + bj * 128 + cg);
#pragma unroll
                for (int m = 0; m < 4; ++m) {
                    const int rl = ai * 128 + wr * 64 + m * 16 + fr, row = u.pm * 256 + rl;
                    const float rs = tabr[ui * 256 + rl];
#pragma unroll
                    for (int bj = 0; bj < 2; ++bj) {
                        const int c0 = u.pn * 256 + bj * 128 + cg;
                        const f32x4 v0 = acc[ai][bj][m][0] * rs, v1 = acc[ai][bj][m][1] * rs;
                        const float ro = tabo[ui * 512 + rl * 2 + bj];
                        const u32x4 o = o8[m][bj];
                        u32x4 w;
                        w.x = pk2(bf_lo(o.x) * ro * ga[0] * silu_(v0[0]), bf_hi(o.x) * ro * ga[1] * silu_(v0[1]));
                        w.y = pk2(bf_lo(o.y) * ro * ga[2] * silu_(v0[2]), bf_hi(o.y) * ro * ga[3] * silu_(v0[3]));
                        w.z = pk2(bf_lo(o.z) * ro * gb[0] * silu_(v1[0]), bf_hi(o.z) * ro * gb[1] * silu_(v1[1]));
                        w.w = pk2(bf_lo(o.w) * ro * gb[2] * silu_(v1[2]), bf_hi(o.w) * ro * gb[3] * silu_(v1[3]));
                        *(u32x4*)(out + (size_t)row * 2048 + c0) = w;
                    }
                }
            }
            return;
        }
#pragma unroll
        for (int ai = 0; ai < 2; ++ai)
#pragma unroll
            for (int m = 0; m < 4; ++m) {
                const int rl = ai * 128 + wr * 64 + m * 16 + fr, row = u.pm * 256 + rl;
                const float rs = tabr[ui * 256 + rl];
                if (mode == 0) {
                    const f32x4 g0 = acc[ai][0][m][0] * rs, g1 = acc[ai][0][m][1] * rs, u0 = acc[ai][1][m][0] * rs, u1 = acc[ai][1][m][1] * rs;
                    u32x4 w;
                    w.x = pk2(silu_(g0[0]) * u0[0], silu_(g0[1]) * u0[1]); w.y = pk2(silu_(g0[2]) * u0[2], silu_(g0[3]) * u0[3]);
                    w.z = pk2(silu_(g1[0]) * u1[0], silu_(g1[1]) * u1[1]); w.w = pk2(silu_(g1[2]) * u1[2], silu_(g1[3]) * u1[3]);
                    {
                      bf16_t* au = out + ((size_t)(u.pm * 44 + u.pn * 2 + (wc >> 1)) * 256 + wr * 64) * 64 + (wc & 1) * 32;
                      *(u32x4*)((char*)au + 2u * ((unsigned)fr * 64u + 8u * (unsigned)fq + (unsigned)((ai * 128 + m * 16) * 64))) = w; }
                } else {
#pragma unroll
                    for (int bj = 0; bj < 2; ++bj) {
                        const int c0 = u.pn * 256 + bj * 128 + wc * 32 + 8 * fq;
                        const f32x4 v0 = acc[ai][bj][m][0] * rs, v1 = acc[ai][bj][m][1] * rs;
                        u32x4 w; w.x = pk2(v0[0], v0[1]); w.y = pk2(v0[2], v0[3]); w.z = pk2(v1[0], v1[1]); w.w = pk2(v1[2], v1[3]);
                        if (mode == 1) { *(u32x4*)(out + (size_t)row * ldo + c0) = w; }
                        else if (c0 < 4096) {
                            *(u32x4*)(out + (size_t)row * 4096 + c0) = w;
                            const int t = row & 4095;
                            if ((t & 63) >= 61) *(u32x4*)(halo + ((size_t)((row >> 12) * 64 + (t >> 6)) * 3 + ((t & 63) - 61)) * 4096 + c0) = w;
                        } else if (c0 < 4128) {
                            float* gp = gates + (size_t)row * 32 + (c0 - 4096);
                            *(f32x4*)gp = v0; *(f32x4*)(gp + 4) = v1;
                        }
                    }
                }
            }
    }
};
__device__ __forceinline__ float lo_scale(float hif) { return __uint_as_float(__float_as_uint(hif) & 0x7f800000u) * 3.0517578125e-5f; }
struct EpiF {
    static constexpr bool PERM = true, AFTER_DRAIN = false;
    int mode;
    const float* xin; const bf16_t* hbin; const signed char* loin;
    float* fout; bf16_t* hb; signed char* loout;
    float* ssqo; float scale; LAS const float* tabr; bf16_t* pp; pg8::StaticOrder S;
    __device__ __forceinline__ void operator()(const f32x4 (&acc)[2][2][4][2], const Unit& u, int wr, int wc, int fr_, int fq_) const {
        int fr = fr_, fq = fq_; asm volatile("" : "+v"(fr), "+v"(fq));
        const int ui = mode == 2 ? unit_ordinal(S, u) : 0;
        const unsigned ubase = ((unsigned)u.pm * 256u + (unsigned)wr * 64u) * 1024u + (unsigned)u.pn * 256u + (unsigned)wc * 32u;
        const unsigned loff = (unsigned)fr * 1024u + 8u * (unsigned)fq;
        const float* xin_u = xin ? xin + ubase : nullptr; const bf16_t* hbin_u = hbin + ubase; const signed char* loin_u = loin + ubase; bf16_t* pp_u = pp + ubase;
        float* fout_u = fout ? fout + ubase : nullptr; bf16_t* hb_u = hb + ubase; signed char* loout_u = loout + ubase;
#define EOFF(ai_, m_, bj_) (loff + (unsigned)(((ai_) * 128 + (m_) * 16) * 1024 + (bj_) * 128))
#pragma unroll
        for (int ai = 0; ai < 2; ++ai)
#pragma unroll
            for (int mp = 0; mp < 2; ++mp) {
                if (mode == 1) {
#pragma unroll
                    for (int m2 = 0; m2 < 2; ++m2)
#pragma unroll
                        for (int bj = 0; bj < 2; ++bj) { const f32x4 v0 = acc[ai][bj][2 * mp + m2][0], v1 = acc[ai][bj][2 * mp + m2][1];
                            u32x4 w; w.x = pk2(v0[0], v0[1]); w.y = pk2(v0[2], v0[3]); w.z = pk2(v1[0], v1[1]); w.w = pk2(v1[2], v1[3]);
                            *(u32x4*)((char*)pp_u + 2u * EOFF(ai, 2 * mp + m2, bj)) = w; }
                    continue;
                }
                f32x4 hv[2][2][2]; u32x4 qv[2][2];
                if (xin) {
#pragma unroll
                    for (int m2 = 0; m2 < 2; ++m2)
#pragma unroll
                        for (int bj = 0; bj < 2; ++bj)
#pragma unroll
                            for (int n = 0; n < 2; ++n) hv[m2][bj][n] = *(const f32x4*)((const char*)xin_u + 4u * (EOFF(ai, 2 * mp + m2, bj) + 4u * n));
                } else {
                    u32x4 hi4[2][2]; u32x2 lo8[2][2];
#pragma unroll
                    for (int m2 = 0; m2 < 2; ++m2)
#pragma unroll
                        for (int bj = 0; bj < 2; ++bj) { const unsigned eo = EOFF(ai, 2 * mp + m2, bj);
                            hi4[m2][bj] = *(const u32x4*)((const char*)hbin_u + 2u * eo); lo8[m2][bj] = *(const u32x2*)((const char*)loin_u + eo); }
#pragma unroll
                    for (int m2 = 0; m2 < 2; ++m2)
#pragma unroll
                        for (int bj = 0; bj < 2; ++bj)
#pragma unroll
                            for (int n = 0; n < 2; ++n) { const unsigned ha = n ? hi4[m2][bj].z : hi4[m2][bj].x, hb_ = n ? hi4[m2][bj].w : hi4[m2][bj].y, ll = n ? lo8[m2][bj].y : lo8[m2][bj].x;
                                const float h0 = bf_lo(ha), h1 = bf_hi(ha), h2 = bf_lo(hb_), h3 = bf_hi(hb_);
                                f32x4 r;
                                r[0] = h0 + (float)(int)(signed char)(ll & 0xffu) * lo_scale(h0); r[1] = h1 + (float)(int)(signed char)((ll >> 8) & 0xffu) * lo_scale(h1);
                                r[2] = h2 + (float)(int)(signed char)((ll >> 16) & 0xffu) * lo_scale(h2); r[3] = h3 + (float)(int)(signed char)(ll >> 24) * lo_scale(h3);
                                hv[m2][bj][n] = r; }
                }
                if (mode == 2) {
#pragma unroll
                    for (int m2 = 0; m2 < 2; ++m2)
#pragma unroll
                        for (int bj = 0; bj < 2; ++bj) qv[m2][bj] = *(const u32x4*)((const char*)pp_u + 2u * EOFF(ai, 2 * mp + m2, bj));
                }
#pragma unroll
                for (int m2 = 0; m2 < 2; ++m2) {
                    const int m = 2 * mp + m2, rl = ai * 128 + wr * 64 + m * 16 + fr, row = u.pm * 256 + rl;
                    const float rs = mode == 2 ? tabr[ui * 256 + rl] : 0.f;
                    float sq = 0.f;
#pragma unroll
                    for (int bj = 0; bj < 2; ++bj) {
                        const unsigned eo = EOFF(ai, m, bj);
                        unsigned hw[4], lw[2];
#pragma unroll
                        for (int n = 0; n < 2; ++n) {
                            const f32x4 v = acc[ai][bj][m][n];
                            f32x4 h = hv[m2][bj][n];
                            if (mode == 0) h = h + v * scale;
                            else { const unsigned qa = n ? qv[m2][bj].z : qv[m2][bj].x, qb = n ? qv[m2][bj].w : qv[m2][bj].y;
                                h[0] += sigm(v[0] * rs) * bf_lo(qa); h[1] += sigm(v[1] * rs) * bf_hi(qa); h[2] += sigm(v[2] * rs) * bf_lo(qb); h[3] += sigm(v[3] * rs) * bf_hi(qb); }
                            if (fout) *(f32x4*)((char*)fout_u + 4u * (eo + 4u * n)) = h;
                            else {
                                const unsigned w0 = pk2(h[0], h[1]), w1 = pk2(h[2], h[3]); hw[2 * n] = w0; hw[2 * n + 1] = w1;
                                const float g0 = bf_lo(w0), g1 = bf_hi(w0), g2 = bf_lo(w1), g3 = bf_hi(w1);
                                const float q0 = __builtin_amdgcn_fmed3f(rintf((h[0] - g0) * __uint_as_float(0x86800000u - (__float_as_uint(g0) & 0x7f800000u))), -128.f, 127.f);
                                const float q1 = __builtin_amdgcn_fmed3f(rintf((h[1] - g1) * __uint_as_float(0x86800000u - (__float_as_uint(g1) & 0x7f800000u))), -128.f, 127.f);
                                const float q2 = __builtin_amdgcn_fmed3f(rintf((h[2] - g2) * __uint_as_float(0x86800000u - (__float_as_uint(g2) & 0x7f800000u))), -128.f, 127.f);
                                const float q3 = __builtin_amdgcn_fmed3f(rintf((h[3] - g3) * __uint_as_float(0x86800000u - (__float_as_uint(g3) & 0x7f800000u))), -128.f, 127.f);
                                lw[n] = ((unsigned)(int)q0 & 0xffu) | (((unsigned)(int)q1 & 0xffu) << 8) | (((unsigned)(int)q2 & 0xffu) << 16) | (((unsigned)(int)q3 & 0xffu) << 24);
                            }
                            sq += (h[0] * h[0] + h[1] * h[1]) + (h[2] * h[2] + h[3] * h[3]);
                        }
                        if (!fout) { const u32x4 hs = {hw[0], hw[1], hw[2], hw[3]}; const u32x2 ls = {lw[0], lw[1]}; *(u32x4*)((char*)hb_u + 2u * eo) = hs; *(u32x2*)((char*)loout_u + eo) = ls; }
                    }
                    if (ssqo) { sq += __shfl_xor(sq, 16); sq += __shfl_xor(sq, 32); if (fq == 0) ssqo[(size_t)row * 16 + u.pn * 4 + wc] = sq; }
                }
            }
#undef EOFF
    }
};
__device__ __forceinline__ void fill_rstd_tab(LAS unsigned char* lds, const float* ssq, int N) {
    const int tid = tid_fresh(), rl = tid & 255, hi = tid >> 8;
    LAS float* tab = (LAS float*)(lds + TABR_OFF);
    pg8::StaticOrder S; S.init(MROWS, N, gridDim.x, VB(lds));
    f32x4 v[4][4]; bool ok[4];
#pragma unroll
    for (int ps = 0; ps < 4; ++ps) { Unit u; ok[ps] = S.next(2 * ps + hi, u);
        if (ok[ps]) { const f32x4* p = (const f32x4*)(ssq + (size_t)(u.pm * 256 + rl) * 16); v[ps][0] = p[0]; v[ps][1] = p[1]; v[ps][2] = p[2]; v[ps][3] = p[3]; } }
#pragma unroll
    for (int ps = 0; ps < 4; ++ps) if (ok[ps]) {
        const f32x4 a = v[ps][0], b = v[ps][1], c = v[ps][2], d = v[ps][3];
        const float s = (((a.x + a.y) + (a.z + a.w)) + ((b.x + b.y) + (b.z + b.w))) + (((c.x + c.y) + (c.z + c.w)) + ((d.x + d.y) + (d.z + d.w)));
        tab[(2 * ps + hi) * 256 + rl] = rsqrtf(s * (1.f / 1024.f) + 1e-6f); }
    __syncthreads();
}
template <class Epi> __device__ __forceinline__ void run_gemm(LAS unsigned char* lds, const bf16_t* A, const bf16_t* Bt, int N, int K, const Epi& E, int atiled = 0, int krot = 0) {
    pg8::StaticOrder S; S.init(MROWS, N, gridDim.x, VB(lds));
    const pg8::Gemm g{A, Bt, MROWS, N, K, atiled, krot};
    pg8::gemm_phase<Epi, pg8::StaticOrder, false>(lds, g, S, E, nullptr);
}
__device__ __forceinline__ void gemm_gu(LAS unsigned char* lds, const bf16_t* A, const float* ssq, const bf16_t* W, bf16_t* act) {
    fill_rstd_tab(lds, ssq, 5632);
    EpiT e{}; e.mode = 0; e.tabr = (LAS const float*)(lds + TABR_OFF); e.out = act; e.S.init(MROWS, 5632, gridDim.x, VB(lds)); run_gemm(lds, A, W, 5632, 1024, e);
}
struct HRef { const float* x; const bf16_t* hi; const signed char* lo; };
struct HDst { float* f; bf16_t* hi; signed char* lo; float* ssq; };
__device__ __forceinline__ void gemm_res(LAS unsigned char* lds, const bf16_t* A, const bf16_t* W, int K, HRef in, HDst out, float scale) {
    EpiF e{}; e.mode = 0; e.xin = in.x; e.hbin = in.hi; e.loin = in.lo; e.fout = out.f; e.hb = out.hi; e.loout = out.lo; e.ssqo = out.ssq; e.scale = scale;
    run_gemm(lds, A, W, 1024, K, e, K == 2816 ? 1 : 0, 0);
}
__device__ __forceinline__ void ple_phase(LAS unsigned char* lds, const bf16_t* pb, const bf16_t* Wpp, bf16_t* pp, const bf16_t* A, const float* ssqi, const bf16_t* Wpg, HRef in, HDst out, bool pp_ready = false) {
    fill_rstd_tab(lds, ssqi, 1024);
    pg8::StaticOrder S; S.init(MROWS, 1024, gridDim.x, VB(lds));
    if (!pp_ready) {
        run_gemm(lds, pb, Wpp, 1024, 256, EpiF{1, nullptr, nullptr, nullptr, nullptr, nullptr, nullptr, nullptr, 0.f, nullptr, pp, S});
        __threadfence(); __syncthreads(); __builtin_amdgcn_fence(__ATOMIC_ACQUIRE, "agent"); }
    run_gemm(lds, A, Wpg, 1024, 1024, EpiF{2, in.x, in.hi, in.lo, out.f, out.hi, out.lo, out.ssq, 0.f, (LAS const float*)(lds + TABR_OFF), pp, S});
}

__device__ __forceinline__ void cvt_rows_bf16(const float* src, bf16_t* dst, int ncol4  , int lane, int gw, int NGW) {
    for (int row = gw; row < MROWS; row += NGW) {
        const f32x4 v = *(const f32x4*)(src + (size_t)row * 256 + 4 * lane);
        u32x2 w; w.x = pk2(v[0], v[1]); w.y = pk2(v[2], v[3]);
        *(u32x2*)(dst + (size_t)row * 256 + 4 * lane) = w;
    }
}
__device__ __forceinline__ void convert_descs(const Args& a, int d_lo, int d_hi, int rank, int n) {
    const int lane = tid_fresh() & 63, wave = tid_fresh() >> 6;
    int total = 0;
    for (int d = d_lo; d < d_hi; ++d) total += (a.wd[d].K >> 6) * (a.wd[d].ncols >> 5);
    const int kc = lane & 7, ng = lane >> 3;
    for (int it = rank * 8 + wave; it < total; it += n * 8) {
        int r = it, d = d_lo;
        for (;;) { const int c = (a.wd[d].K >> 6) * (a.wd[d].ncols >> 5); if (r < c) break; r -= c; ++d; }
        const float* src = a.in[a.wd[d].src_idx] + a.wd[d].src_off; const float* gain = a.wd[d].gain_idx >= 0 ? a.in[a.wd[d].gain_idx] + a.wd[d].gain_off : nullptr; bf16_t* dst = (bf16_t*)(a.ws + a.wd[d].dst_off);
        const int ldsrc = a.wd[d].ldsrc, col0 = a.wd[d].col0, K = a.wd[d].K, dstrow0 = a.wd[d].dstrow0, mode = a.wd[d].mode;
        const int nblk = a.wd[d].ncols >> 5, kb = r / nblk, nb = r % nblk, k0 = 64 * kb + 8 * kc, n0 = 32 * nb + 4 * ng;
        f32x4 v[8];
#pragma unroll
        for (int i = 0; i < 8; ++i) v[i] = *(const f32x4*)(src + (size_t)(k0 + i) * ldsrc + col0 + n0);
        if (gain) { const f32x4 g0 = *(const f32x4*)(gain + k0), g1 = *(const f32x4*)(gain + k0 + 4);
#pragma unroll
            for (int i = 0; i < 4; ++i) { v[i] = v[i] * g0[i]; v[4 + i] = v[4 + i] * g1[i]; } }
#pragma unroll
        for (int j = 0; j < 4; ++j) { const int f = n0 + j;
            const int drow = mode == 0 ? dstrow0 + f : (256 * (f >> 7) + (f & 127) + (mode == 2 ? 128 : 0));
            u32x4 o; o.x = pk2(v[0][j], v[1][j]); o.y = pk2(v[2][j], v[3][j]); o.z = pk2(v[4][j], v[5][j]); o.w = pk2(v[6][j], v[7][j]);
            *(u32x4*)(dst + (size_t)drow * K + k0) = o; }
    }
}
__device__ __forceinline__ bool slack_pp(LAS unsigned char* lds, int N, const bf16_t* pb, const bf16_t* Wpp, bf16_t* pp) {
    const int G = (int)gridDim.x, nwg = 64 * (N >> 8), busy_last = nwg - ((nwg + G - 1) / G - 1) * G, c = VB(lds);
    if (busy_last >= G) return false;
    if (c >= busy_last) { pg8::StaticOrder S; S.init(MROWS, 1024, G - busy_last, c - busy_last); const pg8::Gemm g{pb, Wpp, MROWS, 1024, 256, 0, 0};
        const EpiF e{1, nullptr, nullptr, nullptr, nullptr, nullptr, nullptr, nullptr, 0.f, nullptr, pp, S}; pg8::gemm_phase<EpiF, pg8::StaticOrder, false>(lds, g, S, e, nullptr); }
    return true;
}
__device__ __forceinline__ void slack_convert(const Args& a, LAS unsigned char* lds, int N, int d_lo, int d_hi) {
    const int G = (int)gridDim.x, nwg = 64 * (N >> 8), busy_last = nwg - ((nwg + G - 1) / G - 1) * G, c = VB(lds);
    if (busy_last >= G) convert_descs(a, d_lo, d_hi, c, G);
    else if (c >= busy_last) convert_descs(a, d_lo, d_hi, c - busy_last, G - busy_last);
}
__device__ __forceinline__ void p0_phase(const Args& a, LAS unsigned char* lds) {
    const int lane = tid_fresh() & 63, wave = tid_fresh() >> 6;
    const int gw = blockIdx.x * 8 + wave, NGW = gridDim.x * 8;
    convert_descs(a, 0, 2, blockIdx.x, gridDim.x);
    const float* x = a.in[0]; bf16_t* xb = (bf16_t*)(a.ws + OFF_SA); float* ssq = (float*)(a.ws + OFF_SSQA);
    for (int row = gw; row < MROWS; row += NGW) {
        float s = 0.f;
#pragma unroll
        for (int j = 0; j < 4; ++j) { const f32x4 v = *(const f32x4*)(x + (size_t)row * 1024 + 256 * j + 4 * lane);
            s += (v[0] * v[0] + v[1] * v[1]) + (v[2] * v[2] + v[3] * v[3]);
            u32x2 w; w.x = pk2(v[0], v[1]); w.y = pk2(v[2], v[3]); *(u32x2*)(xb + (size_t)row * 1024 + 256 * j + 4 * lane) = w; }
        s = wave_sum(s);
        if (lane < 16) ssq[(size_t)row * 16 + lane] = lane == 0 ? s : 0.f;
    }
    cvt_rows_bf16(a.in[1], (bf16_t*)(a.ws + OFF_PB), 64, lane, gw, NGW);
}
#define XB_TMO      128
#define XB_XCNT(j)  (256  + 64 * (j))
#define XB_XSUB(j)  (1280 + 64 * (j))
#define XB_XGEN(j)  (2304 + 64 * (j))
#define XB_TOP      3328
#define XB_TOPGEN   3392
#define XCD_BAR_WORDS 3456
#define XB_SPIN_CAP (1u << 18)
__device__ __forceinline__ unsigned xb_ld(unsigned* p)              { return __hip_atomic_load(p, __ATOMIC_RELAXED, __HIP_MEMORY_SCOPE_AGENT); }
__device__ __forceinline__ unsigned xb_add(unsigned* p, unsigned v) { return __hip_atomic_fetch_add(p, v, __ATOMIC_RELAXED, __HIP_MEMORY_SCOPE_AGENT); }
__device__ __forceinline__ unsigned xb_xcc_id() { return (unsigned)__builtin_amdgcn_s_getreg((3 << 11) | 20) & 0xFu; }
#define XB_SPIN(cond, bar) do { unsigned _sp = 0; while (cond) { __builtin_amdgcn_s_sleep(1); \
    if ((++_sp & 255u) == 0u) { if (xb_ld(&(bar)[XB_TMO])) break; if (_sp > XB_SPIN_CAP) { atomicAdd(&(bar)[XB_TMO], 1u); break; } } } } while (0)

struct XcdBarrier {
    unsigned* bar; unsigned x;
    volatile LAS unsigned* st;
};

__device__ __forceinline__ XcdBarrier xcd_barrier_post(unsigned* bar, volatile LAS unsigned* st) {
    XcdBarrier b; b.bar = bar; b.x = xb_xcc_id(); b.st = st;
    if (tid_fresh() == 0) (void)xb_add(&bar[XB_XCNT(b.x)], 1u);
    return b;
}
__device__ __forceinline__ void xcd_barrier_complete(unsigned* bar, unsigned x, unsigned& nloc, unsigned& nx) {
    const unsigned G = gridDim.x * gridDim.y * gridDim.z;
    unsigned sum, cnt, mine, sp = 0u;
    for (;;) {
        sum = 0u; cnt = 0u; mine = 0u;
#pragma unroll
        for (unsigned j = 0; j < 16; ++j) { const unsigned c = xb_ld(&bar[XB_XCNT(j)]); sum += c; cnt += (c > 0u) ? 1u : 0u; mine = (j == x) ? c : mine; }
        if (sum == G) break;
        __builtin_amdgcn_s_sleep(1);
        if ((++sp & 255u) == 0u) { if (xb_ld(&bar[XB_TMO])) break; if (sp > XB_SPIN_CAP) { atomicAdd(&bar[XB_TMO], 1u); break; } }
    }
    nloc = mine > 0u ? mine : 1u; nx = cnt > 0u ? cnt : 1u;
}

__device__ __forceinline__ void xcd_barrier(const XcdBarrier& b) {
    asm volatile("s_waitcnt vmcnt(0)" ::: "memory");
    __syncthreads();
    if (tid_fresh() == 0) {
        unsigned* bar = b.bar;
        __builtin_amdgcn_s_waitcnt(0);
        unsigned nloc = b.st[0], nx = b.st[1];
        if (nloc == 0u) { xcd_barrier_complete(bar, b.x, nloc, nx); b.st[0] = nloc; b.st[1] = nx; }
        const unsigned old = xb_add(&bar[XB_XSUB(b.x)], 1u);
        const unsigned gen = old / nloc;
        if (old + 1u == (gen + 1u) * nloc) {
            __builtin_amdgcn_fence(__ATOMIC_RELEASE, "agent");
            asm volatile("s_waitcnt vmcnt(0)" ::: "memory");
            const unsigned og = xb_add(&bar[XB_TOP], 1u);
            const unsigned tg = og / nx;
            if (og + 1u == (tg + 1u) * nx) xb_add(&bar[XB_TOPGEN], 1u);
            else XB_SPIN(xb_ld(&bar[XB_TOPGEN]) == tg, bar);
            __builtin_amdgcn_fence(__ATOMIC_ACQUIRE, "agent");
            xb_add(&bar[XB_XGEN(b.x)], 1u);
            asm volatile("s_waitcnt vmcnt(0)" ::: "memory");
        } else {
            XB_SPIN(xb_ld(&bar[XB_XGEN(b.x)]) == gen, bar);
            __builtin_amdgcn_fence(__ATOMIC_ACQUIRE, "agent");
            asm volatile("s_waitcnt vmcnt(0)" ::: "memory");
        }
    }
    __syncthreads();
}

__device__ __forceinline__ void stage_k(const bf16_t* src, LAS unsigned char* Kt, int lane) {
#pragma unroll
    for (int i = 0; i < 8; ++i) { const int r = (lane >> 3) + 8 * i;
        const u32x4 v = *(const u32x4*)(src + (size_t)r * 2304 + (lane & 7) * 8);
        *(LAS u32x4*)(Kt + r * 144 + (lane & 7) * 16) = v; }
}
__device__ __forceinline__ void stage_k_norm(const bf16_t* src, const float* kg, LAS unsigned char* Kt, int lane) {
    const f32x4 g0 = *(const f32x4*)(kg + (lane & 7) * 8), g1 = *(const f32x4*)(kg + (lane & 7) * 8 + 4);
#pragma unroll
    for (int i = 0; i < 8; ++i) { const int r = (lane >> 3) + 8 * i;
        const u32x4 v = *(const u32x4*)(src + (size_t)r * 2304 + (lane & 7) * 8);
        float f[8] = {bf_lo(v.x), bf_hi(v.x), bf_lo(v.y), bf_hi(v.y), bf_lo(v.z), bf_hi(v.z), bf_lo(v.w), bf_hi(v.w)};
        float s = 0.f;
#pragma unroll
        for (int e = 0; e < 8; ++e) s += f[e] * f[e];
        s += __shfl_xor(s, 1); s += __shfl_xor(s, 2); s += __shfl_xor(s, 4);
        const float inv = rsqrtf(s * (1.f / 64.f) + 1e-6f);
        u32x4 w; w.x = pk2(f[0] * inv * g0[0], f[1] * inv * g0[1]); w.y = pk2(f[2] * inv * g0[2], f[3] * inv * g0[3]);
        w.z = pk2(f[4] * inv * g1[0], f[5] * inv * g1[1]); w.w = pk2(f[6] * inv * g1[2], f[7] * inv * g1[3]);
        *(LAS u32x4*)(Kt + r * 144 + (lane & 7) * 16) = w; }
}
__device__ __forceinline__ void stage_vt(const bf16_t* src, LAS unsigned char* Vt, int lane) {
#pragma unroll
    for (int c = 0; c < 8; ++c) {
        const u32x4 v = *(const u32x4*)(src + (size_t)lane * 2304 + c * 8);
        LAS unsigned short* p = (LAS unsigned short*)(Vt + (8 * c) * 144 + lane * 2);
        p[0 * 72] = (unsigned short)(v.x & 0xffffu); p[1 * 72] = (unsigned short)(v.x >> 16);
        p[2 * 72] = (unsigned short)(v.y & 0xffffu); p[3 * 72] = (unsigned short)(v.y >> 16);
        p[4 * 72] = (unsigned short)(v.z & 0xffffu); p[5 * 72] = (unsigned short)(v.z >> 16);
        p[6 * 72] = (unsigned short)(v.w & 0xffffu); p[7 * 72] = (unsigned short)(v.w >> 16);
    }
}
typedef short s16x4 __attribute__((ext_vector_type(4)));
__device__ __forceinline__ s16x4 lds_tr4(LAS const unsigned char* p) { return __builtin_amdgcn_ds_read_tr16_b64_v4i16((LAS s16x4*)p); }
__device__ __forceinline__ void tile_fetch(u32x4 (&r)[8], const bf16_t* src, int lane) {
#pragma unroll
    for (int i = 0; i < 8; ++i) r[i] = *(const u32x4*)(src + (size_t)((lane >> 3) + 8 * i) * 2304 + (lane & 7) * 8);
}
__device__ __forceinline__ void tile_park(const u32x4 (&r)[8], LAS unsigned char* T, int lane) {
#pragma unroll
    for (int i = 0; i < 8; ++i) *(LAS u32x4*)(T + ((lane >> 3) + 8 * i) * 144 + (lane & 7) * 16) = r[i];
}
template <int I0, int N> __device__ __forceinline__ void tile_fetch_part(u32x4 (&r)[N], const bf16_t* src, int lane) {
#pragma unroll
    for (int i = 0; i < N; ++i) r[i] = *(const u32x4*)(src + (size_t)((lane >> 3) + 8 * (I0 + i)) * 2304 + (lane & 7) * 8);
}
template <int I0, int N> __device__ __forceinline__ void tile_park_part(const u32x4 (&r)[N], LAS unsigned char* T, int lane) {
#pragma unroll
    for (int i = 0; i < N; ++i) *(LAS u32x4*)(T + ((lane >> 3) + 8 * (I0 + i)) * 144 + (lane & 7) * 16) = r[i];
}
__device__ __forceinline__ void tile_park_norm(const u32x4 (&r)[8], const float* kg, LAS unsigned char* T, int lane) {
    const f32x4 g0 = *(const f32x4*)(kg + (lane & 7) * 8), g1 = *(const f32x4*)(kg + (lane & 7) * 8 + 4);
#pragma unroll
    for (int i = 0; i < 8; ++i) { const u32x4 v = r[i];
        float f[8] = {bf_lo(v.x), bf_hi(v.x), bf_lo(v.y), bf_hi(v.y), bf_lo(v.z), bf_hi(v.z), bf_lo(v.w), bf_hi(v.w)};
        float s = 0.f;
#pragma unroll
        for (int e = 0; e < 8; ++e) s += f[e] * f[e];
        s += __shfl_xor(s, 1); s += __shfl_xor(s, 2); s += __shfl_xor(s, 4);
        const float inv = rsqrtf(s * (1.f / 64.f) + 1e-6f);
        u32x4 w; w.x = pk2(f[0] * inv * g0[0], f[1] * inv * g0[1]); w.y = pk2(f[2] * inv * g0[2], f[3] * inv * g0[3]);
        w.z = pk2(f[4] * inv * g1[0], f[5] * inv * g1[1]); w.w = pk2(f[6] * inv * g1[2], f[7] * inv * g1[3]);
        *(LAS u32x4*)(T + ((lane >> 3) + 8 * i) * 144 + (lane & 7) * 16) = w; }
}
__device__ __forceinline__ void wave_lds_fence() { asm volatile("s_waitcnt lgkmcnt(0)" ::: "memory"); }
__device__ __forceinline__ f32x4 amfma(bf16x8 x, bf16x8 y, f32x4 c) { return __builtin_amdgcn_mfma_f32_16x16x32_bf16(x, y, c, 0, 0, 0); }
__device__ __forceinline__ bf16x8 mk8(unsigned a, unsigned b, unsigned c, unsigned d) { const u32x4 t = {a, b, c, d}; return __builtin_bit_cast(bf16x8, t); }

template <int KIND, int NQS>
__device__ __forceinline__ void att_item(const bf16_t* proj, bf16_t* oatt, const float* qg, const float* kg, const float* sinks, LAS unsigned char* wl, int b, int h, int qbi, int lane) {
    const int t0 = qbi * (16 * NQS);
    LAS unsigned char* Kt = wl; LAS unsigned char* Vt = wl + 9216;
    const int l15 = lane & 15, l4 = lane >> 4;
    const int kvh = KIND ? (h >> 2) : h;
    const int qcol = KIND ? 1536 + h * 64 : h * 64, kcol = KIND ? 2048 + kvh * 64 : 512 + h * 64, vcol = KIND ? 2176 + kvh * 64 : 1024 + h * 64, ocol = KIND ? 512 + h * 64 : h * 64;
    const float slope = exp2f(-(float)(h + 1));
    const size_t rowb = (size_t)b * 4096 + t0;
    bf16x8 qf[NQS][2];
#pragma unroll
    for (int qs = 0; qs < NQS; ++qs) {
        const u32x4 r0 = *(const u32x4*)(proj + (rowb + 16 * qs + l15) * 2304 + qcol + 8 * l4), r1 = *(const u32x4*)(proj + (rowb + 16 * qs + l15) * 2304 + qcol + 32 + 8 * l4);
        if (KIND == 0) { qf[qs][0] = __builtin_bit_cast(bf16x8, r0); qf[qs][1] = __builtin_bit_cast(bf16x8, r1); }
        else {
            float f[16] = {bf_lo(r0.x), bf_hi(r0.x), bf_lo(r0.y), bf_hi(r0.y), bf_lo(r0.z), bf_hi(r0.z), bf_lo(r0.w), bf_hi(r0.w),
                           bf_lo(r1.x), bf_hi(r1.x), bf_lo(r1.y), bf_hi(r1.y), bf_lo(r1.z), bf_hi(r1.z), bf_lo(r1.w), bf_hi(r1.w)};
            float ss = 0.f;
#pragma unroll
            for (int e = 0; e < 16; ++e) ss += f[e] * f[e];
            ss += __shfl_xor(ss, 16); ss += __shfl_xor(ss, 32);
            const float inv = rsqrtf(ss * (1.f / 64.f) + 1e-6f) * 0.125f;
            const f32x4 g0 = *(const f32x4*)(qg + 8 * l4), g1 = *(const f32x4*)(qg + 8 * l4 + 4), g2 = *(const f32x4*)(qg + 32 + 8 * l4), g3 = *(const f32x4*)(qg + 36 + 8 * l4);
            qf[qs][0] = mk8(pk2(f[0] * inv * g0[0], f[1] * inv * g0[1]), pk2(f[2] * inv * g0[2], f[3] * inv * g0[3]), pk2(f[4] * inv * g1[0], f[5] * inv * g1[1]), pk2(f[6] * inv * g1[2], f[7] * inv * g1[3]));
            qf[qs][1] = mk8(pk2(f[8] * inv * g2[0], f[9] * inv * g2[1]), pk2(f[10] * inv * g2[2], f[11] * inv * g2[3]), pk2(f[12] * inv * g3[0], f[13] * inv * g3[1]), pk2(f[14] * inv * g3[2], f[15] * inv * g3[3]));
        }
    }
    f32x4 O[NQS][4];
#pragma unroll
    for (int qs = 0; qs < NQS; ++qs)
#pragma unroll
        for (int dt = 0; dt < 4; ++dt) O[qs][dt] = (f32x4){0.f, 0.f, 0.f, 0.f};
    float st0[NQS], st1[NQS];
#pragma unroll
    for (int qs = 0; qs < NQS; ++qs) { st0[qs] = KIND ? sinks[h] : 0.f; st1[qs] = (KIND && l4 == 0) ? 1.f : 0.f; }
    const int kb_hi = (t0 + 16 * NQS - 1) >> 6, kb_lo = t0 >= 127 ? ((t0 - 127) >> 6) : 0;
    const int kb_first = KIND ? kb_lo : kb_hi, kb_last = KIND ? kb_hi : 0, kb_step = KIND ? 1 : -1;
    u32x4 kr[8], vlo[4];
    { const bf16_t* kbase = proj + ((size_t)b * 4096 + kb_first * 64) * 2304; tile_fetch(kr, kbase + kcol, lane); tile_fetch_part<0, 4>(vlo, kbase + vcol, lane); }
    for (int kb = kb_first; KIND ? (kb <= kb_last) : (kb >= kb_last); kb += kb_step) {
        wave_lds_fence();
        { u32x4 vhi[4]; tile_fetch_part<4, 4>(vhi, proj + ((size_t)b * 4096 + kb * 64) * 2304 + vcol, lane);
          if (KIND) tile_park_norm(kr, kg, Kt, lane); else tile_park(kr, Kt, lane);
          tile_park_part<0, 4>(vlo, Vt, lane); tile_park_part<4, 4>(vhi, Vt, lane); }
        { const int kn = kb + kb_step;
          if (KIND ? (kn <= kb_last) : (kn >= kb_last)) { const bf16_t* kbase = proj + ((size_t)b * 4096 + kn * 64) * 2304; tile_fetch(kr, kbase + kcol, lane); tile_fetch_part<0, 4>(vlo, kbase + vcol, lane); } }
        wave_lds_fence();
#pragma unroll
        for (int qs = 0; qs < NQS; ++qs) {
            f32x4 S[4];
#pragma unroll
            for (int kt = 0; kt < 4; ++kt) { const bf16x8 k0 = *(LAS const bf16x8*)(Kt + (16 * kt + l15) * 144 + (8 * l4) * 2), k1 = *(LAS const bf16x8*)(Kt + (16 * kt + l15) * 144 + (32 + 8 * l4) * 2);
                S[kt] = amfma(k0, qf[qs][0], (f32x4){0.f, 0.f, 0.f, 0.f}); S[kt] = amfma(k1, qf[qs][1], S[kt]); }
            const int t = t0 + 16 * qs + l15, key0 = kb * 64 + 4 * l4;
            float w[4][4];
            if (KIND == 0) {
                float sp[4][4], q4[4], hi[4], tot[4];
#pragma unroll
                for (int kt = 0; kt < 4; ++kt) { q4[kt] = 0.f;
#pragma unroll
                    for (int r = 0; r < 4; ++r) { const float z = S[kt][r] * 0.125f; S[kt][r] = z;
                        const float v = fmaxf(z, 0.f) + __logf(1.f + __expf(-fabsf(z)));
                        sp[kt][r] = (key0 + 16 * kt + r < t) ? v : 0.f; q4[kt] += sp[kt][r]; } }
#pragma unroll
                for (int kt = 0; kt < 4; ++kt) {
                    const float a1 = __shfl(q4[kt], (lane + 16) & 63), a2 = __shfl(q4[kt], (lane + 32) & 63), a3 = __shfl(q4[kt], (lane + 48) & 63);
                    hi[kt] = (l4 < 3 ? a1 : 0.f) + (l4 < 2 ? a2 : 0.f) + (l4 < 1 ? a3 : 0.f);
                    tot[kt] = __shfl(hi[kt] + q4[kt], l15); }
                float above = st0[qs];
#pragma unroll
                for (int kt = 3; kt >= 0; --kt) { float run = above + hi[kt];
#pragma unroll
                    for (int r = 3; r >= 0; --r) { w[kt][r] = (key0 + 16 * kt + r < t) ? __expf(S[kt][r] - sp[kt][r] - run) : 0.f; run += sp[kt][r]; }
                    above += tot[kt]; }
                st0[qs] = above;
            } else {
                float mx = st0[qs];
#pragma unroll
                for (int kt = 0; kt < 4; ++kt)
#pragma unroll
                    for (int r = 0; r < 4; ++r) { const int dist = t - (key0 + 16 * kt + r); const bool valid = dist >= 0 && dist < 128;
                        const float sc = valid ? S[kt][r] - slope * (float)dist : -1e30f; S[kt][r] = sc; mx = fmaxf(mx, sc); }
                mx = fmaxf(mx, __shfl_xor(mx, 16)); mx = fmaxf(mx, __shfl_xor(mx, 32));
                const float corr = __expf(st0[qs] - mx); st0[qs] = mx;
                float ls = 0.f;
#pragma unroll
                for (int kt = 0; kt < 4; ++kt)
#pragma unroll
                    for (int r = 0; r < 4; ++r) { w[kt][r] = S[kt][r] > -1e29f ? __expf(S[kt][r] - mx) : 0.f; ls += w[kt][r]; }
                st1[qs] = st1[qs] * corr + ls;
#pragma unroll
                for (int dt = 0; dt < 4; ++dt) O[qs][dt] = O[qs][dt] * corr;
            }
            const bf16x8 pf0 = mk8(pk2(w[0][0], w[0][1]), pk2(w[0][2], w[0][3]), pk2(w[1][0], w[1][1]), pk2(w[1][2], w[1][3]));
            const bf16x8 pf1 = mk8(pk2(w[2][0], w[2][1]), pk2(w[2][2], w[2][3]), pk2(w[3][0], w[3][1]), pk2(w[3][2], w[3][3]));
            {
                LAS const unsigned char* vb = Vt + (4 * l4 + (l15 >> 2)) * 144 + 8 * (l15 & 3);
#pragma unroll
                for (int dt = 0; dt < 4; ++dt) {
                    const s16x4 a0 = lds_tr4(vb + 32 * dt), b0 = lds_tr4(vb + 16 * 144 + 32 * dt), a1 = lds_tr4(vb + 32 * 144 + 32 * dt), b1 = lds_tr4(vb + 48 * 144 + 32 * dt);
                    const bf16x8 v0 = {a0[0], a0[1], a0[2], a0[3], b0[0], b0[1], b0[2], b0[3]}, v1 = {a1[0], a1[1], a1[2], a1[3], b1[0], b1[1], b1[2], b1[3]};
                    O[qs][dt] = amfma(v0, pf0, O[qs][dt]);
                    O[qs][dt] = amfma(v1, pf1, O[qs][dt]);
                }
            }
        }
        if (KIND == 0) { float rmin = st0[0];
#pragma unroll
            for (int qs = 1; qs < NQS; ++qs) rmin = fminf(rmin, st0[qs]);
            if (__all(rmin > 104.f)) break; }
    }
#pragma unroll
    for (int qs = 0; qs < NQS; ++qs) {
        float sc = 1.f;
        if (KIND) { float l = st1[qs]; l += __shfl_xor(l, 16); l += __shfl_xor(l, 32); sc = 1.f / l; }
#pragma unroll
        for (int dt = 0; dt < 4; ++dt) { u32x2 o; o.x = pk2(O[qs][dt][0] * sc, O[qs][dt][1] * sc); o.y = pk2(O[qs][dt][2] * sc, O[qs][dt][3] * sc);
            *(u32x2*)(oatt + (rowb + 16 * qs + l15) * 1024 + ocol + 16 * dt + 4 * l4) = o; }
    }
}
__device__ __forceinline__ void att_phase(const Args& a, LAS unsigned char* lds, const bf16_t* proj, bf16_t* oatt) {
    const int lane = tid_fresh() & 63, wave = tid_fresh() >> 6;
    LAS unsigned char* wl = lds + wave * 18432;
    const int NGW = gridDim.x * 8;
    for (int it = blockIdx.x * 8 + wave; it < 8192; it += NGW) {
        const int kind = it >> 12, r = it & 4095;
        const int qbi = 127 - (r & 127), h = (r >> 7) & 7, b = r >> 10;
        if (kind == 0) att_item<0, 2>(proj, oatt, a.in[8], a.in[9], a.in[10], wl, b, h, qbi, lane);
        else att_item<1, 2>(proj, oatt, a.in[8], a.in[9], a.in[10], wl, b, h, qbi, lane);
    }
}
__device__ __forceinline__ f32x4 mfma16(bf16x8 x, bf16x8 y, f32x4 c) { return __builtin_amdgcn_mfma_f32_16x16x32_bf16(x, y, c, 0, 0, 0); }
__device__ __forceinline__ bf16_t f2bf(float x) { return (bf16_t)(pk2(x, 0.f) & 0xffffu); }

__device__ __forceinline__ void gdn_prep_phase(const Args& a, LAS unsigned char* lds, const bool dry = false) {
    const int tid = tid_fresh(), lane = tid & 63, wave = tid >> 6;
    unsigned char* ws = a.ws;
    bf16_t* QKV = (bf16_t*)(ws + OFF_QKV); const bf16_t* halo = (const bf16_t*)(ws + OFF_HALO); const float* gates = (const float*)(ws + OFF_GATES);
    float* gb = (float*)(ws + OFF_GB); bf16_t* Tinv = (bf16_t*)(ws + OFF_TINV); bf16_t* attn = (bf16_t*)(ws + OFF_ATTN);
    const float* convw = a.in[13]; const float* a_log = a.in[14]; const float* dtb = a.in[15];
    constexpr int CSP = 1040;
    LAS unsigned char* cs = lds;
    LAS float* kkf = (LAS float*)(lds + 69888);
    LAS float* qkf = (LAS float*)(lds + 69888 + 17408);
    LAS float* Lm = (LAS float*)(lds + 104704);
    LAS float* betas = (LAS float*)(lds + 137472);
    LAS float* gcs = betas + 128;
    auto fetch_raw = [&](int item, u32x4 (&raw)[9]) {
        const int n = item & 63, hk = (item >> 6) & 7, b = item >> 9;
        const size_t row0 = (size_t)b * 4096 + 64 * n;
#pragma unroll
        for (int i = 0; i < 9; ++i) { const int v = tid + 512 * i; raw[i] = (u32x4){0u, 0u, 0u, 0u};
            if (v < 67 * 64) { const int r = v >> 6, ch = 8 * (v & 63);
                const int gcol = ch < 128 ? hk * 128 + ch : (ch < 256 ? 1024 + hk * 128 + (ch - 128) : 2048 + hk * 256 + (ch - 256));
                if (r >= 3) raw[i] = *(const u32x4*)(QKV + (row0 + r - 3) * 4096 + gcol);
                else if (n > 0) raw[i] = *(const u32x4*)(halo + ((size_t)(b * 64 + n - 1) * 3 + r) * 4096 + gcol); } }
    };
    u32x4 raw[9];
    if ((int)blockIdx.x < 2048) fetch_raw(blockIdx.x, raw);
    for (int item = blockIdx.x; item < 2048; item += gridDim.x) {
        const int n = item & 63, hk = (item >> 6) & 7, b = item >> 9;
        const size_t row0 = (size_t)b * 4096 + 64 * n;
        __syncthreads();
#pragma unroll
        for (int i = 0; i < 9; ++i) { const int v = tid + 512 * i; if (v < 67 * 64) *(LAS u32x4*)(cs + (v >> 6) * CSP + 16 * (v & 63)) = raw[i]; }
        if (item + (int)gridDim.x < 2048) fetch_raw(item + gridDim.x, raw);
        __syncthreads();
        {
            const int ch = tid;
            const int gcol = ch < 128 ? hk * 128 + ch : (ch < 256 ? 1024 + hk * 128 + (ch - 128) : 2048 + hk * 256 + (ch - 256));
            const float w0 = convw[gcol], w1 = convw[4096 + gcol], w2 = convw[8192 + gcol], w3 = convw[12288 + gcol];
            LAS bf16_t* col = (LAS bf16_t*)(cs + ch * 2);
            float x0 = bf2f(col[0]), x1 = bf2f(col[520]), x2 = bf2f(col[1040]);
#pragma unroll 8
            for (int t = 0; t < 64; ++t) { const float x3 = bf2f(col[(t + 3) * 520]);
                const float y = (w0 * x0 + w1 * x1) + (w2 * x2 + w3 * x3);
                col[(t + 3) * 520] = f2bf(silu_(y)); x0 = x1; x1 = x2; x2 = x3; }
        }
        __syncthreads();
        {
            const int pair = tid >> 2, t = pair >> 1, part = pair & 1, qd = tid & 3;
            LAS u32x4* p = (LAS u32x4*)(cs + (t + 3) * CSP + part * 256 + qd * 64);
            u32x4 u[4]; float ss = 0.f;
#pragma unroll
            for (int i = 0; i < 4; ++i) { u[i] = p[i];
                ss += (bf_lo(u[i].x) * bf_lo(u[i].x) + bf_hi(u[i].x) * bf_hi(u[i].x)) + (bf_lo(u[i].y) * bf_lo(u[i].y) + bf_hi(u[i].y) * bf_hi(u[i].y))
                    + (bf_lo(u[i].z) * bf_lo(u[i].z) + bf_hi(u[i].z) * bf_hi(u[i].z)) + (bf_lo(u[i].w) * bf_lo(u[i].w) + bf_hi(u[i].w) * bf_hi(u[i].w)); }
            ss += __shfl_xor(ss, 1); ss += __shfl_xor(ss, 2);
            const float inv = rsqrtf(ss + 1e-6f) * (part == 0 ? 0.08838834764831845f : 1.f);
            bf16_t* gp = QKV + (row0 + t) * 4096 + part * 1024 + hk * 128 + qd * 32;
#pragma unroll
            for (int i = 0; i < 4; ++i) { u32x4 w;
                w.x = pk2(bf_lo(u[i].x) * inv, bf_hi(u[i].x) * inv); w.y = pk2(bf_lo(u[i].y) * inv, bf_hi(u[i].y) * inv);
                w.z = pk2(bf_lo(u[i].z) * inv, bf_hi(u[i].z) * inv); w.w = pk2(bf_lo(u[i].w) * inv, bf_hi(u[i].w) * inv);
                p[i] = w; if (!dry) *(u32x4*)(gp + 8 * i) = w; }
        }
        for (int v = tid; v < 2048; v += 512) { const int t = v >> 5, c8 = v & 31;
            if (!dry) *(u32x4*)(QKV + (row0 + t) * 4096 + 2048 + hk * 256 + 8 * c8) = *(LAS const u32x4*)(cs + (t + 3) * CSP + 512 + 16 * c8); }
        if (tid < 128) {
            const int hvl = tid >> 6, hv = 2 * hk + hvl; const size_t row = row0 + lane;
            const float bl = gates[row * 32 + hv], av = gates[row * 32 + 16 + hv];
            const float beta = sigm(bl); const float xx = av + dtb[hv];
            const float ex = __expf(-fabsf(xx));
            const float sp = fmaxf(xx, 0.f) + (ex < 1e-4f ? ex * (1.f - 0.5f * ex) : __logf(1.f + ex));
            float g = -__expf(a_log[hv]) * sp;
#pragma unroll
            for (int o = 1; o < 64; o <<= 1) { const float y = __shfl_up(g, o); if (lane >= o) g += y; }
            betas[hvl * 64 + lane] = beta; gcs[hvl * 64 + lane] = g;
            float2 bg; bg.x = beta; bg.y = g; if (!dry) *(float2*)(gb + (row * 16 + hv) * 2) = bg;
        }
        __syncthreads();
        {
            const int ct = wave & 3, which = wave >> 2, l15 = lane & 15, l4 = lane >> 4;
            LAS float* dstm = which ? qkf : kkf;
            bf16x8 ya[4];
#pragma unroll
            for (int ks = 0; ks < 4; ++ks) ya[ks] = *(LAS const bf16x8*)(cs + (3 + 16 * ct + l15) * CSP + (which ? 0 : 256) + (32 * ks + 8 * l4) * 2);
#pragma unroll
            for (int st = 0; st < 4; ++st) { f32x4 acc = {0.f, 0.f, 0.f, 0.f};
#pragma unroll
                for (int ks = 0; ks < 4; ++ks) { const bf16x8 xs = *(LAS const bf16x8*)(cs + (3 + 16 * st + l15) * CSP + 256 + (32 * ks + 8 * l4) * 2); acc = mfma16(xs, ya[ks], acc); }
                *(LAS f32x4*)(dstm + (16 * ct + l15) * 68 + 16 * st + 4 * l4) = acc; }
        }
        __syncthreads();
        {
            const int hvl = tid >> 8, c = (tid >> 2) & 63, s0 = 16 * (tid & 3), hv = 2 * hk + hvl;
            const float gcc = gcs[hvl * 64 + c], bc = betas[hvl * 64 + c];
            unsigned aw[8];
#pragma unroll
            for (int i = 0; i < 16; i += 2) {
                float lv[2], av[2];
#pragma unroll
                for (int e = 0; e < 2; ++e) { const int s_ = s0 + i + e; const float dec = c >= s_ ? __expf(gcc - gcs[hvl * 64 + s_]) : 0.f;
                    lv[e] = c > s_ ? bc * kkf[c * 68 + s_] * dec : 0.f; av[e] = qkf[c * 68 + s_] * dec; }
                Lm[hvl * 4096 + c * 64 + s0 + i] = lv[0]; Lm[hvl * 4096 + c * 64 + s0 + i + 1] = lv[1];
                aw[i >> 1] = pk2(av[0], av[1]); }
            if (!dry) { bf16_t* ap = attn + ((size_t)((b * 16 + hv) * 64 + n)) * 4096 + c * 64 + s0;
                u32x4 w0 = {aw[0], aw[1], aw[2], aw[3]}, w1 = {aw[4], aw[5], aw[6], aw[7]}; *(u32x4*)ap = w0; *(u32x4*)(ap + 8) = w1; }
        }
        __syncthreads();
        LAS float* X = kkf;
        LAS float* Mb = (LAS float*)cs;
        if (tid < 128) {
            const int hvl = tid >> 6, half = lane >> 5, jj = lane & 31, base = 32 * half;
            LAS const float* Lh = Lm + hvl * 4096 + base * 64 + base;
            LAS float* Xh = X + hvl * 4096;
            float x[32];
#pragma unroll
            for (int c = 0; c < 32; ++c) x[c] = 0.f;
#pragma unroll
            for (int c = 0; c < 32; ++c) { float a0 = (c == jj) ? 1.f : 0.f, a1 = 0.f, a2 = 0.f, a3 = 0.f;
#pragma unroll
                for (int s4 = 0; s4 < (c + 3) / 4; ++s4) { const f32x4 Lv = *(LAS const f32x4*)(Lh + c * 64 + 4 * s4);
                    a0 -= Lv[0] * x[4 * s4]; a1 -= Lv[1] * x[4 * s4 + 1]; a2 -= Lv[2] * x[4 * s4 + 2]; a3 -= Lv[3] * x[4 * s4 + 3]; }
                x[c] = (a0 + a1) + (a2 + a3);
                Xh[(base + c) * 64 + base + jj] = x[c];
                if (half == 0) Xh[c * 64 + 32 + jj] = 0.f; }
        }
        __syncthreads();
        {
            const int hvl = tid >> 8, r = (tid >> 3) & 31, q0 = 4 * (tid & 7);
            LAS const float* Lh = Lm + hvl * 4096; LAS float* Xh = X + hvl * 4096;
            f32x4 m = {0.f, 0.f, 0.f, 0.f};
#pragma unroll 8
            for (int t = 0; t < 32; ++t) m = m + *(LAS const f32x4*)(Xh + t * 64 + q0) * Lh[(32 + r) * 64 + t];
            *(LAS f32x4*)(Mb + hvl * 1024 + r * 32 + q0) = m;
            __syncthreads();
            f32x4 e = {0.f, 0.f, 0.f, 0.f};
#pragma unroll 8
            for (int t = 0; t < 32; ++t) e = e - *(LAS const f32x4*)(Mb + hvl * 1024 + t * 32 + q0) * Xh[(32 + r) * 64 + 32 + t];
            *(LAS f32x4*)(Xh + (32 + r) * 64 + q0) = e;
        }
        __syncthreads();
        if (!dry) {
            const int hvl = tid >> 8, c = (tid >> 2) & 63, s0 = 16 * (tid & 3), hv = 2 * hk + hvl;
            LAS const float* xr = X + hvl * 4096 + c * 64 + s0;
            const f32x4 a0 = *(LAS const f32x4*)xr, a1 = *(LAS const f32x4*)(xr + 4), a2 = *(LAS const f32x4*)(xr + 8), a3 = *(LAS const f32x4*)(xr + 12);
            bf16_t* tp = Tinv + ((size_t)((b * 16 + hv) * 64 + n)) * 4096 + c * 64 + s0;
            u32x4 w0 = {pk2(a0[0], a0[1]), pk2(a0[2], a0[3]), pk2(a1[0], a1[1]), pk2(a1[2], a1[3])}, w1 = {pk2(a2[0], a2[1]), pk2(a2[2], a2[3]), pk2(a3[0], a3[1]), pk2(a3[2], a3[3])};
            *(u32x4*)tp = w0; *(u32x4*)(tp + 8) = w1;
        }
    }
}

constexpr int SC_KT = 0, SC_QT = 17408, SC_TT = 34816, SC_AT = 44032, SC_VT = 53248, SC_GB = 58368, SC_STRIDE = 58880, SC_BASE = 22528;
struct ScanStage { u32x4 k[2], q[2], t, a, v; f2v_t g; };
__device__ __forceinline__ void scan_fetch(ScanStage& o, const bf16_t* QKV, const float* gb, const bf16_t* Tinv, const bf16_t* attn, int b, int hv, int hk, int j, int n, int tid) {
    const size_t row0 = (size_t)b * 4096 + 64 * n;
    const size_t itm = (size_t)((b * 16 + hv) * 64 + n) * 4096;
#pragma unroll
    for (int i = 0; i < 2; ++i) { const int idx = tid + 512 * i, row = idx >> 4, c16 = idx & 15;
        o.q[i] = *(const u32x4*)(QKV + (row0 + row) * 4096 + hk * 128 + 8 * c16);
        o.k[i] = *(const u32x4*)(QKV + (row0 + row) * 4096 + 1024 + hk * 128 + 8 * c16); }
    o.t = *(const u32x4*)(Tinv + itm + (tid >> 3) * 64 + 8 * (tid & 7));
    o.a = *(const u32x4*)(attn + itm + (tid >> 3) * 64 + 8 * (tid & 7));
    if (tid < 256) o.v = *(const u32x4*)(QKV + (row0 + (tid >> 2)) * 4096 + 2048 + hv * 128 + 32 * j + 8 * (tid & 3));
    else if (tid < 320) o.g = *(const f2v_t*)(gb + ((row0 + (tid - 256)) * 16 + hv) * 2);
}
__device__ __forceinline__ void scan_park(const ScanStage& o, LAS unsigned char* img, int tid) {
#pragma unroll
    for (int i = 0; i < 2; ++i) { const int idx = tid + 512 * i, row = idx >> 4, c16 = idx & 15;
        *(LAS u32x4*)(img + SC_QT + row * 272 + c16 * 16) = o.q[i]; *(LAS u32x4*)(img + SC_KT + row * 272 + c16 * 16) = o.k[i]; }
    *(LAS u32x4*)(img + SC_TT + (tid >> 3) * 144 + (tid & 7) * 16) = o.t;
    *(LAS u32x4*)(img + SC_AT + (tid >> 3) * 144 + (tid & 7) * 16) = o.a;
    if (tid < 256) *(LAS u32x4*)(img + SC_VT + (tid >> 2) * 80 + (tid & 3) * 16) = o.v;
    else if (tid < 320) *(LAS f2v_t*)(img + SC_GB + (tid - 256) * 8) = o.g;
}
__device__ __forceinline__ void gdn_scan_phase(const Args& a, LAS unsigned char* lds, const bool dry = false) {
    const int tid = tid_fresh(), lane = tid & 63, wave = tid >> 6, l15 = lane & 15, l4 = lane >> 4, ct = wave >> 1, dt = wave & 1;
    unsigned char* ws = a.ws;
    bf16_t* QKV = (bf16_t*)(ws + OFF_QKV); const float* gb = (const float*)(ws + OFF_GB);
    const bf16_t* Tinv = (const bf16_t*)(ws + OFF_TINV); const bf16_t* attn = (const bf16_t*)(ws + OFF_ATTN);
    LAS unsigned char* Sb = lds; LAS unsigned char* RT = lds + 8704; LAS unsigned char* vnT = lds + 13312; LAS unsigned char* vnsT = lds + 17920;
    for (int item = VCU(lds); item < 256; item += gridDim.x) {
        const int j = item & 3, hv = (item >> 2) & 15, b = item >> 6, hk = hv >> 1;
        __syncthreads();
        for (int i = tid; i < 8704 / 4; i += 512) ((LAS unsigned*)Sb)[i] = 0u;
        f32x4 S0 = {0.f, 0.f, 0.f, 0.f}, S1 = {0.f, 0.f, 0.f, 0.f};
        { ScanStage s0; scan_fetch(s0, QKV, gb, Tinv, attn, b, hv, hk, j, 0, tid); scan_park(s0, lds + SC_BASE, tid); }
        __syncthreads();
        for (int n = 0; n < 64; ++n) {
            LAS const unsigned char* img = lds + SC_BASE + (n & 1) * SC_STRIDE;
            ScanStage nx; scan_fetch(nx, QKV, gb, Tinv, attn, b, hv, hk, j, n < 63 ? n + 1 : 63, tid);
            bf16_t* vcol = QKV + ((size_t)b * 4096 + 64 * n + 16 * ct + 4 * l4) * 4096 + 2048 + hv * 128 + 32 * j + 16 * dt + l15;
            float vv[4], be[4], gcr[4];
#pragma unroll
            for (int r = 0; r < 4; ++r) { vv[r] = bf2f(*(LAS const bf16_t*)(img + SC_VT + (16 * ct + 4 * l4 + r) * 80 + (16 * dt + l15) * 2));
                const f2v_t bg = *(LAS const f2v_t*)(img + SC_GB + (16 * ct + 4 * l4 + r) * 8); be[r] = bg.x; gcr[r] = bg.y; }
            const float gcl = *(LAS const float*)(img + SC_GB + 63 * 8 + 4);
            f32x4 KS = {0.f, 0.f, 0.f, 0.f}, QS = {0.f, 0.f, 0.f, 0.f};
#pragma unroll
            for (int ks = 0; ks < 4; ++ks) { const bf16x8 sf = *(LAS const bf16x8*)(Sb + (16 * dt + l15) * 272 + (32 * ks + 8 * l4) * 2);
                const bf16x8 kf = *(LAS const bf16x8*)(img + SC_KT + (16 * ct + l15) * 272 + (32 * ks + 8 * l4) * 2), qf = *(LAS const bf16x8*)(img + SC_QT + (16 * ct + l15) * 272 + (32 * ks + 8 * l4) * 2);
                KS = mfma16(kf, sf, KS); QS = mfma16(qf, sf, QS); }
            float Oacc[4], Rr[4];
#pragma unroll
            for (int r = 0; r < 4; ++r) { const float eg = __expf(gcr[r]); Rr[r] = be[r] * (vv[r] - eg * KS[r]); Oacc[r] = eg * QS[r]; }
            { u32x2 w; w.x = pk2(Rr[0], Rr[1]); w.y = pk2(Rr[2], Rr[3]); *(LAS u32x2*)(RT + (16 * dt + l15) * 144 + (16 * ct + 4 * l4) * 2) = w; }
            __syncthreads();
            f32x4 VN = {0.f, 0.f, 0.f, 0.f};
#pragma unroll
            for (int k2 = 0; k2 < 2; ++k2) { const bf16x8 rf = *(LAS const bf16x8*)(RT + (16 * dt + l15) * 144 + (32 * k2 + 8 * l4) * 2);
                const bf16x8 tf = *(LAS const bf16x8*)(img + SC_TT + (16 * ct + l15) * 144 + (32 * k2 + 8 * l4) * 2); VN = mfma16(tf, rf, VN); }
            { u32x2 w; w.x = pk2(VN[0], VN[1]); w.y = pk2(VN[2], VN[3]); *(LAS u32x2*)(vnT + (16 * dt + l15) * 144 + (16 * ct + 4 * l4) * 2) = w;
              u32x2 x; x.x = pk2(VN[0] * __expf(gcl - gcr[0]), VN[1] * __expf(gcl - gcr[1])); x.y = pk2(VN[2] * __expf(gcl - gcr[2]), VN[3] * __expf(gcl - gcr[3]));
              *(LAS u32x2*)(vnsT + (16 * dt + l15) * 144 + (16 * ct + 4 * l4) * 2) = x; }
            __syncthreads();
            f32x4 O = {Oacc[0], Oacc[1], Oacc[2], Oacc[3]};
#pragma unroll
            for (int k2 = 0; k2 < 2; ++k2) { const bf16x8 vf = *(LAS const bf16x8*)(vnT + (16 * dt + l15) * 144 + (32 * k2 + 8 * l4) * 2);
                const bf16x8 af = *(LAS const bf16x8*)(img + SC_AT + (16 * ct + l15) * 144 + (32 * k2 + 8 * l4) * 2); O = mfma16(af, vf, O); }
#pragma unroll
            for (int r = 0; r < 4; ++r) { if (!dry) vcol[(size_t)r * 4096] = f2bf(O[r]); }
            const float dec = __expf(gcl);
            S0 = S0 * dec; S1 = S1 * dec;
#pragma unroll
            for (int k2 = 0; k2 < 2; ++k2) {
                LAS const unsigned char* kb_ = img + SC_KT + (32 * k2 + 8 * l4 + (l15 >> 2)) * 272 + 32 * wave + 8 * (l15 & 3);
                const s16x4 ka = lds_tr4(kb_), kc = lds_tr4(kb_ + 4 * 272);
                const bf16x8 ktf = {ka[0], ka[1], ka[2], ka[3], kc[0], kc[1], kc[2], kc[3]};
                const bf16x8 v0 = *(LAS const bf16x8*)(vnsT + l15 * 144 + (32 * k2 + 8 * l4) * 2), v1 = *(LAS const bf16x8*)(vnsT + (16 + l15) * 144 + (32 * k2 + 8 * l4) * 2);
                S0 = mfma16(ktf, v0, S0); S1 = mfma16(ktf, v1, S1); }
            { u32x2 w; w.x = pk2(S0[0], S0[1]); w.y = pk2(S0[2], S0[3]); *(LAS u32x2*)(Sb + l15 * 272 + (16 * wave + 4 * l4) * 2) = w;
              u32x2 x; x.x = pk2(S1[0], S1[1]); x.y = pk2(S1[2], S1[3]); *(LAS u32x2*)(Sb + (16 + l15) * 272 + (16 * wave + 4 * l4) * 2) = x; }
            scan_park(nx, lds + SC_BASE + ((n + 1) & 1) * SC_STRIDE, tid);
            __syncthreads();
        }
    }
}

__device__ __forceinline__ void gdn_z_phase(const Args& a, LAS unsigned char* lds) {
    const int tid = tid_fresh();
    unsigned char* ws = a.ws;
    const bf16_t* QKV = (const bf16_t*)(ws + OFF_QKV);
    LAS float* tab = (LAS float*)(lds + TABO_OFF);
    pg8::StaticOrder S; S.init(MROWS, 2048, gridDim.x, VB(lds));
    Unit u;
    for (int i = 0; i < 8 && S.next(i, u); ++i) {
        const int rl = tid >> 1, bj = tid & 1;
        const bf16_t* op = QKV + (size_t)(u.pm * 256 + rl) * 4096 + 2048 + (2 * u.pn + bj) * 128;
        float ss = 0.f;
#pragma unroll
        for (int c = 0; c < 16; ++c) { const u32x4 v = *(const u32x4*)(op + 8 * c);
            ss += (bf_lo(v.x) * bf_lo(v.x) + bf_hi(v.x) * bf_hi(v.x)) + (bf_lo(v.y) * bf_lo(v.y) + bf_hi(v.y) * bf_hi(v.y)) + (bf_lo(v.z) * bf_lo(v.z) + bf_hi(v.z) * bf_hi(v.z)) + (bf_lo(v.w) * bf_lo(v.w) + bf_hi(v.w) * bf_hi(v.w)); }
        tab[i * 512 + rl * 2 + bj] = rsqrtf(ss * (1.f / 128.f) + 1e-6f);
    }
    fill_rstd_tab(lds, (const float*)(ws + OFF_SSQA), 2048);
    EpiT e{}; e.mode = 3; e.tabr = (LAS const float*)(lds + TABR_OFF); e.out = (bf16_t*)(ws + OFF_OB); e.osrc = QKV; e.ogain = a.in[16]; e.tabo = tab; e.S.init(MROWS, 2048, gridDim.x, VB(lds));
    run_gemm(lds, (const bf16_t*)(ws + OFF_SA), (const bf16_t*)(ws + OFF_WZ), 2048, 1024, e);
}
extern __shared__ __attribute__((aligned(16))) unsigned char dyn_lds[];
constexpr int LDS_BYTES = 160 * 1024;
__global__ void __launch_bounds__(512, 2) mega(Args a) {
    cg::grid_group grid = cg::this_grid();
    LAS unsigned char* lds = (LAS unsigned char*)dyn_lds;
    unsigned char* ws = a.ws;
#define WB(off) ((bf16_t*)(ws + (off)))
#define WF(off) ((float*)(ws + (off)))
    float* out = a.out;
    signed char* LO = (signed char*)a.out;
    signed char* LO2 = (signed char*)(ws + 187 * MIB + MIB / 2);
    unsigned* bar = (unsigned*)(ws + 246 * MIB);
    XcdBarrier xb; xb.bar = bar; xb.x = xb_xcc_id(); xb.st = (volatile LAS unsigned*)(lds + 163792);
    if (tid_fresh() == 0) {
        const unsigned rank = xb_add(&bar[XB_XCNT(xb.x)], 1u);
        *(LAS int*)(lds + 163780) = (int)xb.x; *(LAS int*)(lds + 163784) = (int)rank; xb.st[0] = 0u; xb.st[1] = 0u; }
    __syncthreads();
    p0_phase(a, lds);
    if (ws == nullptr) grid.sync();
    xcd_barrier(xb);
    if (tid_fresh() == 0) {
        const int xcc = *(LAS const int*)(lds + 163780), rank = *(LAS const int*)(lds + 163784), G = (int)gridDim.x;
        int pre = 0; for (int x = 0; x < 8; ++x) { const unsigned cx = xb_ld(&bar[XB_XCNT(x)]); if (x < xcc) pre += (int)cx; }
        const int vcu = pre + rank;
        *(LAS int*)(lds + 163776) = (G % 8 == 0) ? (vcu % (G / 8)) * 8 + vcu / (G / 8) : vcu; *(LAS int*)(lds + 163788) = vcu; }
    __syncthreads();
    gemm_gu(lds, WB(OFF_SA), WF(OFF_SSQA), WB(OFF_WGU00), WB(OFF_BIG));
    slack_convert(a, lds, 5632, 2, 5);
    xcd_barrier(xb);
    gemm_res(lds, WB(OFF_BIG), WB(OFF_WD00), 2816, HRef{a.in[0], nullptr, nullptr}, HDst{nullptr, WB(OFF_SB), LO, WF(OFF_SSQB)}, 0.5f);
    xcd_barrier(xb);
    fill_rstd_tab(lds, WF(OFF_SSQB), 2304);
    { EpiT e{}; e.mode = 1; e.tabr = (LAS const float*)(lds + TABR_OFF); e.out = WB(OFF_BIG); e.ldo = 2304; e.S.init(MROWS, 2304, gridDim.x, VB(lds)); run_gemm(lds, WB(OFF_SB), WB(OFF_WATTIN), 2304, 1024, e); }
    slack_convert(a, lds, 2304, 5, 10);
    xcd_barrier(xb);
    att_phase(a, lds, WB(OFF_BIG), WB(OFF_SA));
    xcd_barrier(xb);
    gemm_res(lds, WB(OFF_SA), WB(OFF_WATTOUT), 1024, HRef{nullptr, WB(OFF_SB), LO}, HDst{nullptr, WB(OFF_SB), LO, WF(OFF_SSQB)}, 1.0f);
    xcd_barrier(xb);
    gemm_gu(lds, WB(OFF_SB), WF(OFF_SSQB), WB(OFF_WGU01), WB(OFF_BIG));
    slack_convert(a, lds, 5632, 10, 13);
    xcd_barrier(xb);
    gemm_res(lds, WB(OFF_BIG), WB(OFF_WD01), 2816, HRef{nullptr, WB(OFF_SB), LO}, HDst{nullptr, WB(OFF_SA), LO, WF(OFF_SSQA)}, 0.5f);
    xcd_barrier(xb);
    ple_phase(lds, WB(OFF_PB), WB(OFF_WPP0), WB(OFF_BIG), WB(OFF_SA), WF(OFF_SSQA), WB(OFF_WPG0), HRef{nullptr, WB(OFF_SA), LO}, HDst{nullptr, WB(OFF_SB), LO, WF(OFF_SSQB)});
    xcd_barrier(xb);
    cvt_rows_bf16(a.in[1] + (size_t)MROWS * 256, WB(OFF_PB), 64, tid_fresh() & 63, blockIdx.x * 8 + (tid_fresh() >> 6), gridDim.x * 8);
    gemm_gu(lds, WB(OFF_SB), WF(OFF_SSQB), WB(OFF_WGU10), WB(OFF_BIG));
    slack_convert(a, lds, 5632, 13, 17);
    xcd_barrier(xb);
    gemm_res(lds, WB(OFF_BIG), WB(OFF_WD10), 2816, HRef{nullptr, WB(OFF_SB), LO}, HDst{nullptr, WB(OFF_SA), LO, WF(OFF_SSQA)}, 0.5f);
    xcd_barrier(xb);
    fill_rstd_tab(lds, WF(OFF_SSQA), 4352);
    { EpiT e{}; e.mode = 2; e.tabr = (LAS const float*)(lds + TABR_OFF); e.out = WB(OFF_QKV); e.halo = WB(OFF_HALO); e.gates = WF(OFF_GATES); e.S.init(MROWS, 4352, gridDim.x, VB(lds)); run_gemm(lds, WB(OFF_SA), WB(OFF_WQKVG), 4352, 1024, e); }
    slack_convert(a, lds, 4352, 17, 22);
    xcd_barrier(xb);
    gdn_prep_phase(a, lds);
    xcd_barrier(xb);
    gdn_scan_phase(a, lds);
    xcd_barrier(xb);
    gdn_z_phase(a, lds);
    xcd_barrier(xb);
    gemm_res(lds, WB(OFF_OB), WB(OFF_WGO), 2048, HRef{nullptr, WB(OFF_SA), LO}, HDst{nullptr, WB(OFF_H2), LO, WF(OFF_SSQB)}, 1.0f);
    xcd_barrier(xb);
    gemm_gu(lds, WB(OFF_H2), WF(OFF_SSQB), WB(OFF_WGU11), WB(OFF_ACT11));
    const bool pp1_ready = slack_pp(lds, 5632, WB(OFF_PB), WB(OFF_WPP1), WB(203 * MIB + MIB / 2));
    xcd_barrier(xb);
    gemm_res(lds, WB(OFF_ACT11), WB(OFF_WD11), 2816, HRef{nullptr, WB(OFF_H2), LO}, HDst{nullptr, WB(OFF_H3), LO2, WF(OFF_SSQA)}, 0.5f);
    xcd_barrier(xb);
    ple_phase(lds, WB(OFF_PB), WB(OFF_WPP1), WB(203 * MIB + MIB / 2), WB(OFF_H3), WF(OFF_SSQA), WB(OFF_WPG1), HRef{nullptr, WB(OFF_H3), LO2}, HDst{out, nullptr, nullptr, nullptr}, pp1_ready);
#undef WB
#undef WF
}

extern "C" void kernel_launch(void* const* d_in, const int* in_sizes, int n_in, void* d_out, int out_size, void* d_ws, size_t ws_size, hipStream_t stream) {
    static int grid = 0;
    if (!grid) {
        int dev = 0, cus = 0, per = 0;
        (void)hipGetDevice(&dev); (void)hipDeviceGetAttribute(&cus, hipDeviceAttributeMultiprocessorCount, dev);
        (void)hipFuncSetAttribute((const void*)mega, hipFuncAttributeMaxDynamicSharedMemorySize, LDS_BYTES);
        (void)hipOccupancyMaxActiveBlocksPerMultiprocessor(&per, (const void*)mega, 512, LDS_BYTES);
        if (per < 1) { fprintf(stderr, "occupancy query says %d blocks/CU\n", per); per = 1; }
        grid = cus;
    }
    if (n_in != 21 || ws_size < WS_NEED) { fprintf(stderr, "kernel_launch: unexpected inputs / workspace (%d, %zu)\n", n_in, ws_size); return; }
    Args a{};
    for (int i = 0; i < 21; ++i) a.in[i] = (const float*)d_in[i];
    a.out = (float*)d_out; a.ws = (unsigned char*)d_ws;
    int nd = 0;
    auto add = [&](int si, size_t soff, int gi, size_t goff, size_t dstoff, int ldsrc, int col0, int ncols, int K, int dstrow0, int mode) {
        WDesc& w = a.wd[nd++]; w.src_idx = si; w.src_off = (unsigned)soff; w.gain_idx = gi; w.gain_off = (unsigned)goff; w.dst_off = dstoff; w.ldsrc = ldsrc; w.col0 = col0; w.ncols = ncols; w.K = K; w.dstrow0 = dstrow0; w.mode = mode; };
    const size_t offgu[4] = {OFF_WGU00, OFF_WGU01, OFF_WGU10, OFF_WGU11}, offd[4] = {OFF_WD00, OFF_WD01, OFF_WD10, OFF_WD11};
    auto addgu = [&](int f) { add(3, (size_t)f * 1024 * 2816, 2, f * 1024, offgu[f], 2816, 0, 2816, 1024, 0, 1); add(4, (size_t)f * 1024 * 2816, 2, f * 1024, offgu[f], 2816, 0, 2816, 1024, 0, 2); };
    auto addd = [&](int f) { add(5, (size_t)f * 2816 * 1024, -1, 0, offd[f], 1024, 0, 1024, 2816, 0, 0); };
    addgu(0);
    addd(0); add(7, 0, 6, 0, OFF_WATTIN, 2304, 0, 2304, 1024, 0, 0); add(11, 0, -1, 0, OFF_WATTOUT, 1024, 0, 1024, 1024, 0, 0);
    addgu(1); addd(1); add(19, 0, 18, 0, OFF_WPG0, 1024, 0, 1024, 1024, 0, 0); add(20, 0, -1, 0, OFF_WPP0, 1024, 0, 1024, 256, 0, 0);
    addgu(2); addd(2);
    add(12, 0, 6, 1024, OFF_WQKVG, 6176, 0, 4096, 1024, 0, 0); add(12, 0, 6, 1024, OFF_WQKVG, 6176, 6144, 32, 1024, 4096, 0); add(12, 0, 6, 1024, OFF_WZ, 6176, 4096, 2048, 1024, 0, 0); add(17, 0, -1, 0, OFF_WGO, 1024, 0, 1024, 2048, 0, 0);
    addgu(3); addd(3); add(19, 1024 * 1024, 18, 1024, OFF_WPG1, 1024, 0, 1024, 1024, 0, 0); add(20, 256 * 1024, -1, 0, OFF_WPP1, 1024, 0, 1024, 256, 0, 0);
    (void)hipMemsetAsync((unsigned char*)d_ws + 246 * MIB, 0, XCD_BAR_WORDS * 4, stream);
    void* args[] = {&a};
    hipError_t e = hipLaunchCooperativeKernel((const void*)mega, dim3(grid), dim3(512), args, LDS_BYTES, stream);
    if (e != hipSuccess) fprintf(stderr, "cooperative launch failed: %s (grid %d)\n", hipGetErrorString(e), grid);
}
```

```cpp
#include <hip/hip_runtime.h>
#include <hip/hip_cooperative_groups.h>
#include <cstdio>
namespace cg = cooperative_groups;
__device__ __forceinline__ int tid_fresh() { int t = threadIdx.x; asm volatile("" : "+v"(t)); return t; }
namespace pg8 {
#define PG8_LAS __attribute__((address_space(3)))
typedef unsigned short bf16_t;
typedef short bf16x8 __attribute__((ext_vector_type(8)));
typedef float f32x4 __attribute__((ext_vector_type(4)));
typedef unsigned u32x4 __attribute__((ext_vector_type(4)));
constexpr int BM = 256, BK = 64, HALF = 128, HTB = HALF * BK * 2  , STAGE_BYTES = 8 * HTB, NXCD = 8, WGM = 8;

__host__ __device__ __forceinline__ int lds_byte(int r, int c) { const int st = (r >> 4) * 2 + (c >> 5), rr = r & 15, cc = c & 31, ob = rr * 64 + cc * 2; return st * 1024 + (ob ^ (((ob >> 9) & 1) << 5)); }
__host__ __device__ __forceinline__ void stage_rc(int b, int& R, int& C) { const int st = b / 1024, sb = b % 1024, swz = sb ^ (((sb >> 9) & 1) << 5); R = (st >> 1) * 16 + swz / 64; C = (st & 1) * 32 + (swz % 64) / 2; }
__host__ __device__ __forceinline__ int perm32(int rho) { const int n = rho >> 4, i = rho & 15; return 8 * (i >> 2) + 4 * n + (i & 3); }

struct Unit { int pm, pn; };
struct Gemm { const bf16_t* A; const bf16_t* Bt; int M, N, K; int atiled; int krot; };

struct StaticOrder {
    int nM, nN, nwg, G, c;
    __host__ __device__ void init(int M, int N, int G_, int c_) { nM = M / BM; nN = N / BM; nwg = nM * nN; G = G_; c = c_; }
    __host__ __device__ bool next(int i, Unit& u) const {
        const long L = (long)i * G + c; if (L >= nwg) return false;
        int wgid = (int)L; { const int q = nwg / NXCD, r = nwg % NXCD, xcd = wgid % NXCD, off = wgid / NXCD; wgid = (xcd < r ? xcd * (q + 1) : r * (q + 1) + (xcd - r) * q) + off; }
        const int nig = WGM * nN, gid = wgid / nig, fm = gid * WGM, gsz = (nM - fm) < WGM ? (nM - fm) : WGM;
        u.pm = fm + ((wgid % nig) % gsz); u.pn = (wgid % nig) / gsz; return true;
    }
    __device__ __forceinline__ void a_ready(const Unit&) const {}
    __device__ __forceinline__ void done(const Unit&) const {}
};
__device__ __forceinline__ unsigned cvt_pk_bf16(float lo, float hi) { unsigned r; asm volatile("v_cvt_pk_bf16_f32 %0, %1, %2" : "=v"(r) : "v"(lo), "v"(hi)); return r; }
template <class Epi, class Sched, bool STAMP = false>
__device__ __forceinline__ void gemm_phase(PG8_LAS unsigned char* lds, const Gemm g, const Sched& S, const Epi& E, unsigned long long* stamps) {
    const int tid = tid_fresh(), wid = __builtin_amdgcn_readfirstlane(tid >> 6), lane = tid & 63, wr = wid >> 2, wc = wid & 3, fr = lane & 15, fq = lane >> 4;
    const int K = g.K, nt = K / BK;
    int ts_lo = 0, ts_hi = 0, nts = 0; const unsigned long long rt_entry = STAMP ? (unsigned long long)wall_clock64() : 0ull;
#define PG8_STAMP() do { if (STAMP && wid == 0 && nts < 64) { const unsigned long long _c = (unsigned long long)clock64(); \
        ts_lo = (lane == nts) ? (int)(unsigned)_c : ts_lo; ts_hi = (lane == nts) ? (int)(unsigned)(_c >> 32) : ts_hi; ++nts; } } while (0)
    PG8_STAMP();
    unsigned voffA[2], voffB[2];
#pragma unroll
    for (int i = 0; i < 2; ++i) { int R, C; stage_rc(tid * 16 + i * 8192, R, C); const int Rb = Epi::PERM ? ((R & ~31) + perm32(R & 31)) : R;
        voffA[i] = (unsigned)(R * (g.atiled ? BK : K) + C) * 2u; voffB[i] = (unsigned)(Rb * K + C) * 2u; }
    const size_t kstep = (size_t)(BK * 2);
    const size_t hstep = (size_t)HALF * K * 2;
    const size_t tstep = 2 * hstep;
    const size_t kstepA = g.atiled ? (size_t)(BM * BK * 2) : kstep, hstepA = g.atiled ? (size_t)(HALF * BK * 2) : hstep;
    const unsigned ldsw = (unsigned)wid * 1024u;
    const int aoff = lds_byte(wr * 64 + fr, fq * 8), boff = lds_byte(wc * 32 + fr, fq * 8);
#define PG8_SA(b, h) (((b) * 2 + (h)) * HTB)
#define PG8_SB(b, h) ((4 + (b) * 2 + (h)) * HTB)
#define PG8_STAGE(bufoff, gbase, voff) do { _Pragma("unroll") for (int _i = 0; _i < 2; ++_i) \
        __builtin_amdgcn_global_load_lds((const unsigned*)((const char*)(gbase) + (voff)[_i]), (PG8_LAS unsigned*)(lds + (bufoff) + ldsw + _i * 8192), 16, 0, 0); } while (0)
#define PG8_LDA(dst, b, h) do { _Pragma("unroll") for (int m = 0; m < 4; ++m) _Pragma("unroll") for (int k = 0; k < 2; ++k) dst[m][k] = *(const PG8_LAS bf16x8*)(lds + PG8_SA(b, h) + aoff + m * 2048 + k * 1024); } while (0)
#define PG8_LDB(dst, b, h) do { _Pragma("unroll") for (int n = 0; n < 2; ++n) _Pragma("unroll") for (int k = 0; k < 2; ++k) dst[n][k] = *(const PG8_LAS bf16x8*)(lds + PG8_SB(b, h) + boff + n * 2048 + k * 1024); } while (0)
#define PG8_MMA(ai, bj, At, Bt) do { __builtin_amdgcn_s_setprio(1); _Pragma("unroll") for (int m = 0; m < 4; ++m) _Pragma("unroll") for (int n = 0; n < 2; ++n) _Pragma("unroll") for (int k = 0; k < 2; ++k) \
        acc[ai][bj][m][n] = __builtin_amdgcn_mfma_f32_16x16x32_bf16(Bt[n][k], At[m][k], acc[ai][bj][m][n], 0, 0, 0); __builtin_amdgcn_s_setprio(0); } while (0)
#define PG8_WAIT_V(n) asm volatile("s_waitcnt vmcnt(" #n ")" ::: "memory")
#define PG8_WAIT_L(n) asm volatile("s_waitcnt lgkmcnt(" #n ")" ::: "memory")
#define PG8_BAR __builtin_amdgcn_s_barrier()
#define PG8_SCHED __builtin_amdgcn_sched_barrier(0)
    Unit cur, nxt; int ui = 0;
    if (!S.next(0, cur)) return;
    f32x4 acc[2][2][4][2];
#pragma unroll
    for (int a = 0; a < 2; ++a)
#pragma unroll
        for (int b = 0; b < 2; ++b)
#pragma unroll
            for (int m = 0; m < 4; ++m)
#pragma unroll
                for (int n = 0; n < 2; ++n) acc[a][b][m][n] = (f32x4){0.f, 0.f, 0.f, 0.f};
    bf16x8 At[4][2], B0[2][2], B1[2][2];
    const char* cA = (const char*)g.A + (size_t)cur.pm * tstep; const char* cB = (const char*)g.Bt + (size_t)cur.pn * tstep;
    int rc = g.krot ? (2 * (cur.pm & 7)) % nt : 0;
    S.a_ready(cur);
    PG8_STAGE(PG8_SB(0, 0), cB + rc * kstep, voffB); PG8_STAGE(PG8_SA(0, 0), cA + rc * kstepA, voffA); PG8_STAGE(PG8_SB(0, 1), cB + hstep + rc * kstep, voffB); PG8_STAGE(PG8_SA(0, 1), cA + hstepA + rc * kstepA, voffA);
    if (wr == 1) PG8_BAR;
    PG8_WAIT_V(4); PG8_BAR;
    PG8_STAGE(PG8_SB(1, 0), cB + (rc + 1) * kstep, voffB); PG8_STAGE(PG8_SA(1, 0), cA + (rc + 1) * kstepA, voffA); PG8_STAGE(PG8_SB(1, 1), cB + hstep + (rc + 1) * kstep, voffB);
    PG8_WAIT_V(6); PG8_BAR;
    PG8_STAMP();
    for (;;) {
        const bool has_next = S.next(ui + 1, nxt);
        const char* nA = has_next ? (const char*)g.A + (size_t)nxt.pm * tstep : cA; const char* nB = has_next ? (const char*)g.Bt + (size_t)nxt.pn * tstep : cB;
        const int rn = has_next ? (g.krot ? (2 * (nxt.pm & 7)) % nt : 0) : rc;
        for (int t = 0; t < nt; t += 2) {
            const bool last = (t == nt - 2);
            int p0 = t + rc; if (p0 >= nt) p0 -= nt; int p2 = p0 + 2; if (p2 >= nt) p2 -= nt;
            const char* a1 = cA + (size_t)(p0 + 1) * kstepA;
            const char* a2 = last ? nA + (size_t)rn * kstepA : cA + (size_t)p2 * kstepA; const char* b2 = last ? nB + (size_t)rn * kstep : cB + (size_t)p2 * kstep;
            const char* a3 = a2 + kstepA; const char* b3 = b2 + kstep;
            if (last && has_next) S.a_ready(nxt);
            PG8_LDB(B0, 0, 0); PG8_SCHED; PG8_LDA(At, 0, 0); PG8_STAGE(PG8_SA(1, 1), a1 + hstepA, voffA);
            PG8_WAIT_L(8); PG8_BAR; PG8_WAIT_L(0); PG8_MMA(0, 0, At, B0); PG8_BAR; PG8_SCHED;
            PG8_LDB(B1, 0, 1); PG8_STAGE(PG8_SB(0, 0), b2, voffB);
            PG8_BAR; PG8_WAIT_L(0); PG8_MMA(0, 1, At, B1); PG8_BAR;
            PG8_LDA(At, 0, 1); PG8_STAGE(PG8_SA(0, 0), a2, voffA);
            PG8_BAR; PG8_WAIT_L(0); PG8_MMA(1, 0, At, B0); PG8_BAR; PG8_SCHED;
            PG8_STAGE(PG8_SB(0, 1), b2 + hstep, voffB);
            PG8_WAIT_V(6); PG8_BAR; PG8_MMA(1, 1, At, B1); PG8_BAR;
            PG8_LDB(B0, 1, 0); PG8_SCHED; PG8_LDA(At, 1, 0); PG8_STAGE(PG8_SA(0, 1), a2 + hstepA, voffA);
            PG8_WAIT_L(8); PG8_BAR; PG8_WAIT_L(0); PG8_MMA(0, 0, At, B0); PG8_BAR; PG8_SCHED;
            PG8_LDB(B1, 1, 1); PG8_STAGE(PG8_SB(1, 0), b3, voffB);
            PG8_BAR; PG8_WAIT_L(0); PG8_MMA(0, 1, At, B1); PG8_BAR;
            PG8_LDA(At, 1, 1); PG8_STAGE(PG8_SA(1, 0), a3, voffA);
            PG8_BAR; PG8_WAIT_L(0); PG8_MMA(1, 0, At, B0); PG8_BAR; PG8_SCHED;
            PG8_STAGE(PG8_SB(1, 1), b3 + hstep, voffB);
            PG8_WAIT_V(6); PG8_BAR; PG8_MMA(1, 1, At, B1); PG8_BAR;
        }
        PG8_STAMP();
        if constexpr (!Epi::AFTER_DRAIN) { E(acc, cur, wr, wc, fr, fq); S.done(cur); }
        PG8_STAMP();
        if (!has_next) break;
#pragma unroll
        for (int a = 0; a < 2; ++a)
#pragma unroll
            for (int b = 0; b < 2; ++b)
#pragma unroll
                for (int m = 0; m < 4; ++m)
#pragma unroll
                    for (int n = 0; n < 2; ++n) acc[a][b][m][n] = (f32x4){0.f, 0.f, 0.f, 0.f};
        cur = nxt; cA = nA; cB = nB; rc = rn; ++ui;
    }
    PG8_WAIT_V(0);
    if (wr == 0) PG8_BAR;
    PG8_BAR;
    if constexpr (Epi::AFTER_DRAIN) { E.fused(acc, cur, wr, wc, fr, fq, lds, wid, lane); S.done(cur); }
    PG8_STAMP();
    if (STAMP && wid == 0) { stamps[lane] = lane < nts ? (((unsigned long long)(unsigned)ts_hi << 32) | (unsigned)ts_lo) : 0ull;
        if (lane == 62) stamps[62] = rt_entry; if (lane == 63) stamps[63] = (unsigned long long)wall_clock64(); }
#undef PG8_STAMP
#undef PG8_SA
#undef PG8_SB
#undef PG8_STAGE
#undef PG8_LDA
#undef PG8_LDB
#undef PG8_MMA
#undef PG8_WAIT_V
#undef PG8_WAIT_L
#undef PG8_BAR
#undef PG8_SCHED
}
}

using pg8::bf16_t; using pg8::bf16x8; using pg8::f32x4; using pg8::u32x4; using pg8::Unit;
typedef unsigned u32x2 __attribute__((ext_vector_type(2)));
typedef __bf16 bf2_t __attribute__((ext_vector_type(2)));
#define LAS __attribute__((address_space(3)))

constexpr int MROWS = 16384;
#define VCU(lds) (*(LAS const int*)((lds) + 163788))
#define VB(lds) (*(LAS const int*)((lds) + 163776))
constexpr size_t MIB = 1048576;
constexpr size_t OFF_WZ = 0, OFF_WGO = 4 * MIB, OFF_WGU11 = 8 * MIB, OFF_WD11 = 19 * MIB, OFF_WPG1 = 24 * MIB + MIB / 2, OFF_WPP1 = 26 * MIB + MIB / 2,
    OFF_WQKVG = 27 * MIB, OFF_WE = 35 * MIB + MIB / 2,
    OFF_WGU00 = OFF_WE, OFF_WD00 = OFF_WGU00 + 11 * MIB, OFF_WGU01 = OFF_WD00 + 11 * MIB / 2, OFF_WD01 = OFF_WGU01 + 11 * MIB,
    OFF_WATTIN = OFF_WD01 + 11 * MIB / 2, OFF_WATTOUT = OFF_WATTIN + 9 * MIB / 2, OFF_WPG0 = OFF_WATTOUT + 2 * MIB, OFF_WPP0 = OFF_WPG0 + 2 * MIB,
    OFF_WGU10 = OFF_WPP0 + MIB / 2, OFF_WD10 = OFF_WGU10 + 11 * MIB,
    OFF_SB = 94 * MIB, OFF_BIG = 126 * MIB, OFF_SSQA = 235 * MIB + MIB / 2, OFF_SSQB = OFF_SSQA + MIB, OFF_PB = OFF_SSQB + MIB, OFF_SA = 263422976,
    WS_NEED = OFF_SA + 32 * MIB,
    OFF_QKV = OFF_WE, OFF_GATES = OFF_QKV + 128 * MIB, OFF_HALO = OFF_GATES + 2 * MIB, OFF_TINV = OFF_HALO + 6 * MIB, OFF_ATTN = OFF_TINV + 32 * MIB,
    OFF_GB = OFF_WQKVG, OFF_OB = OFF_TINV, OFF_H2 = OFF_WE, OFF_ACT11 = OFF_H2 + 32 * MIB, OFF_H3 = OFF_ACT11 + 88 * MIB, OFF_PP1 = OFF_WE;
static_assert(OFF_WD10 + 11 * MIB / 2 == OFF_SB, "weights map");
static_assert(OFF_ATTN + 32 * MIB == OFF_SSQA, "gdn map");
static_assert(OFF_PB + 8 * MIB <= OFF_SA && WS_NEED <= 296977568ull, "ws size");

struct WDesc { unsigned long long dst_off; unsigned src_off, gain_off; int src_idx, gain_idx, ldsrc, col0, ncols, K, dstrow0, mode; };
constexpr int NDESC = 22;
struct Args { const float* in[21]; float* out; unsigned char* ws; WDesc wd[NDESC]; };

typedef float f2v_t __attribute__((ext_vector_type(2)));
__device__ __forceinline__ unsigned pk2(float lo, float hi) { const f2v_t f = {lo, hi}; const bf2_t r = __builtin_convertvector(f, bf2_t); return __builtin_bit_cast(unsigned, r); }
__device__ __forceinline__ float bf_lo(unsigned u) { return __uint_as_float(u << 16); }
__device__ __forceinline__ float bf_hi(unsigned u) { return __uint_as_float(u & 0xffff0000u); }
__device__ __forceinline__ float bf2f(bf16_t b) { return __uint_as_float(((unsigned)b) << 16); }
__device__ __forceinline__ float sigm(float x) { return __builtin_amdgcn_rcpf(1.f + __expf(-x)); }
__device__ __forceinline__ float silu_(float x) { return x * __builtin_amdgcn_rcpf(1.f + __expf(-x)); }
__device__ __forceinline__ float wave_sum(float v) {
#pragma unroll
    for (int o = 1; o < 64; o <<= 1) v += __shfl_xor(v, o);
    return v;
}
__device__ __forceinline__ float row_rstd(const float* ssq, int row) {
    const f32x4* p = (const f32x4*)(ssq + (size_t)row * 16);
    const f32x4 a = p[0], b = p[1], c = p[2], d = p[3];
    const float s = (((a.x + a.y) + (a.z + a.w)) + ((b.x + b.y) + (b.z + b.w))) + (((c.x + c.y) + (c.z + c.w)) + ((d.x + d.y) + (d.z + d.w)));
    return rsqrtf(s * (1.f / 1024.f) + 1e-6f);
}
__device__ __forceinline__ float dot2bf(unsigned a, unsigned b, float c) {
    return __builtin_amdgcn_fdot2_f32_bf16(__builtin_bit_cast(bf2_t, a), __builtin_bit_cast(bf2_t, b), c, false);
}

constexpr int TABR_OFF = 131072, TABO_OFF = 131072 + 8192;
__device__ __forceinline__ int unit_ordinal(const pg8::StaticOrder& S, const Unit& u) {
    int r = 0;
    for (int i = 0; i < 8; ++i) { Unit t; if (S.next(i, t) && t.pm == u.pm && t.pn == u.pn) r = i; }
    return r;
}
struct EpiT {
    static constexpr bool PERM = true, AFTER_DRAIN = false;
    int mode;
    LAS const float* tabr; bf16_t* out; int ldo;
    bf16_t* halo; float* gates;
    const bf16_t* osrc; const float* ogain; LAS const float* tabo; pg8::StaticOrder S;
    __device__ __forceinline__ void operator()(const f32x4 (&acc)[2][2][4][2], const Unit& u, int wr, int wc, int fr_, int fq_) const {
        int fr = fr_, fq = fq_; asm volatile("" : "+v"(fr), "+v"(fq));
        const int ui = unit_ordinal(S, u);
        if (mode == 3) {
            const int cg = wc * 32 + 8 * fq;
            const f32x4 ga = *(const f32x4*)(ogain + cg), gb = *(const f32x4*)(ogain + cg + 4);
#pragma unroll
            for (int ai = 0; ai < 2; ++ai) {
                u32x4 o8[4][2];
#pragma unroll
                for (int m = 0; m < 4; ++m)
#pragma unroll
                    for (int bj = 0; bj < 2; ++bj) o8[m][bj] = *(const u32x4*)(osrc + (size_t)(u.pm * 256 + ai * 128 + wr * 64 + m * 16 + fr) * 4096 + 2048 + u.pn * 256 + bj * 128 + cg);
#pragma unroll
                for (int m = 0; m < 4; ++m) {
                    const int rl = ai * 128 + wr * 64 + m * 16 + fr, row = u.pm * 256 + rl;
                    const float rs = tabr[ui * 256 + rl];
#pragma unroll
                    for (int bj = 0; bj < 2; ++bj) {
                        const int c0 = u.pn * 256 + bj * 128 + cg;
                        const f32x4 v0 = acc[ai][bj][m][0] * rs, v1 = acc[ai][bj][m][1] * rs;
                        const float ro = tabo[ui * 512 + rl * 2 + bj];
                        const u32x4 o = o8[m][bj];
                        u32x4 w;
                        w.x = pk2(bf_lo(o.x) * ro * ga[0] * silu_(v0[0]), bf_hi(o.x) * ro * ga[1] * silu_(v0[1]));
                        w.y = pk2(bf_lo(o.y) * ro * ga[2] * silu_(v0[2]), bf_hi(o.y) * ro * ga[3] * silu_(v0[3]));
                        w.z = pk2(bf_lo(o.z) * ro * gb[0] * silu_(v1[0]), bf_hi(o.z) * ro * gb[1] * silu_(v1[1]));
                        w.w = pk2(bf_lo(o.w) * ro * gb[2] * silu_(v1[2]), bf_hi(o.w) * ro * gb[3] * silu_(v1[3]));
                        *(u32x4*)(out + (size_t)row * 2048 + c0) = w;
                    }
                }
            }
            return;
        }
#pragma unroll
        for (int ai = 0; ai < 2; ++ai)
#pragma unroll
            for (int m = 0; m < 4; ++m) {
                const int rl = ai * 128 + wr * 64 + m * 16 + fr, row = u.pm * 256 + rl;
                const float rs = tabr[ui * 256 + rl];
                if (mode == 0) {
                    const float c1 = rs * -1.4426950408889634f, rs2 = rs * rs;
                    const f32x4 ga = acc[ai][0][m][0], gb_ = acc[ai][0][m][1];
                    const f32x4 pa = ga * acc[ai][1][m][0] * rs2, pb_ = gb_ * acc[ai][1][m][1] * rs2;
                    float o[8];
#pragma unroll
                    for (int j = 0; j < 4; ++j) { o[j] = pa[j] * __builtin_amdgcn_rcpf(1.f + __builtin_amdgcn_exp2f(ga[j] * c1)); o[4 + j] = pb_[j] * __builtin_amdgcn_rcpf(1.f + __builtin_amdgcn_exp2f(gb_[j] * c1)); }
                    u32x4 w; w.x = pk2(o[0], o[1]); w.y = pk2(o[2], o[3]); w.z = pk2(o[4], o[5]); w.w = pk2(o[6], o[7]);
                    {
                      bf16_t* au = out + ((size_t)(u.pm * 44 + u.pn * 2 + (wc >> 1)) * 256 + wr * 64) * 64 + (wc & 1) * 32;
                      *(u32x4*)((char*)au + 2u * ((unsigned)fr * 64u + 8u * (unsigned)fq + (unsigned)((ai * 128 + m * 16) * 64))) = w; }
                } else {
#pragma unroll
                    for (int bj = 0; bj < 2; ++bj) {
                        const int c0 = u.pn * 256 + bj * 128 + wc * 32 + 8 * fq;
                        const f32x4 v0 = acc[ai][bj][m][0] * rs, v1 = acc[ai][bj][m][1] * rs;
                        u32x4 w; w.x = pk2(v0[0], v0[1]); w.y = pk2(v0[2], v0[3]); w.z = pk2(v1[0], v1[1]); w.w = pk2(v1[2], v1[3]);
                        if (mode == 1) { *(u32x4*)(out + (size_t)row * ldo + c0) = w; }
                        else if (c0 < 4096) {
                            *(u32x4*)(out + (size_t)row * 4096 + c0) = w;
                            const int t = row & 4095;
                            if ((t & 63) >= 61) *(u32x4*)(halo + ((size_t)((row >> 12) * 64 + (t >> 6)) * 3 + ((t & 63) - 61)) * 4096 + c0) = w;
                        } else if (c0 < 4128) {
                            float* gp = gates + (size_t)row * 32 + (c0 - 4096);
                            *(f32x4*)gp = v0; *(f32x4*)(gp + 4) = v1;
                        }
                    }
                }
            }
    }
};
__device__ __forceinline__ float lo_scale(float hif) { return __uint_as_float(__float_as_uint(hif) & 0x7f800000u) * 3.0517578125e-5f; }
struct EpiF {
    static constexpr bool PERM = true, AFTER_DRAIN = false;
    int mode;
    const float* xin; const bf16_t* hbin; const signed char* loin;
    float* fout; bf16_t* hb; signed char* loout;
    float* ssqo; float scale; LAS const float* tabr; bf16_t* pp; pg8::StaticOrder S;
    __device__ __forceinline__ void operator()(const f32x4 (&acc)[2][2][4][2], const Unit& u, int wr, int wc, int fr_, int fq_) const {
        int fr = fr_, fq = fq_; asm volatile("" : "+v"(fr), "+v"(fq));
        const int ui = mode == 2 ? unit_ordinal(S, u) : 0;
        const unsigned ubase = ((unsigned)u.pm * 256u + (unsigned)wr * 64u) * 1024u + (unsigned)u.pn * 256u + (unsigned)wc * 32u;
        const unsigned loff = (unsigned)fr * 1024u + 8u * (unsigned)fq;
        const float* xin_u = xin ? xin + ubase : nullptr; const bf16_t* hbin_u = hbin + ubase; const signed char* loin_u = loin + ubase; bf16_t* pp_u = pp + ubase;
        float* fout_u = fout ? fout + ubase : nullptr; bf16_t* hb_u = hb + ubase; signed char* loout_u = loout + ubase;
#define EOFF(ai_, m_, bj_) (loff + (unsigned)(((ai_) * 128 + (m_) * 16) * 1024 + (bj_) * 128))
#pragma unroll
        for (int ai = 0; ai < 2; ++ai)
#pragma unroll
            for (int mp = 0; mp < 2; ++mp) {
                if (mode == 1) {
#pragma unroll
                    for (int m2 = 0; m2 < 2; ++m2)
#pragma unroll
                        for (int bj = 0; bj < 2; ++bj) { const f32x4 v0 = acc[ai][bj][2 * mp + m2][0], v1 = acc[ai][bj][2 * mp + m2][1];
                            u32x4 w; w.x = pk2(v0[0], v0[1]); w.y = pk2(v0[2], v0[3]); w.z = pk2(v1[0], v1[1]); w.w = pk2(v1[2], v1[3]);
                            *(u32x4*)((char*)pp_u + 2u * EOFF(ai, 2 * mp + m2, bj)) = w; }
                    continue;
                }
                f32x4 hv[2][2][2]; u32x4 qv[2][2];
                if (xin) {
#pragma unroll
                    for (int m2 = 0; m2 < 2; ++m2)
#pragma unroll
                        for (int bj = 0; bj < 2; ++bj)
#pragma unroll
                            for (int n = 0; n < 2; ++n) hv[m2][bj][n] = *(const f32x4*)((const char*)xin_u + 4u * (EOFF(ai, 2 * mp + m2, bj) + 4u * n));
                } else {
                    u32x4 hi4[2][2]; u32x2 lo8[2][2];
#pragma unroll
                    for (int m2 = 0; m2 < 2; ++m2)
#pragma unroll
                        for (int bj = 0; bj < 2; ++bj) { const unsigned eo = EOFF(ai, 2 * mp + m2, bj);
                            hi4[m2][bj] = *(const u32x4*)((const char*)hbin_u + 2u * eo); lo8[m2][bj] = *(const u32x2*)((const char*)loin_u + eo); }
#pragma unroll
                    for (int m2 = 0; m2 < 2; ++m2)
#pragma unroll
                        for (int bj = 0; bj < 2; ++bj)
#pragma unroll
                            for (int n = 0; n < 2; ++n) { const unsigned ha = n ? hi4[m2][bj].z : hi4[m2][bj].x, hb_ = n ? hi4[m2][bj].w : hi4[m2][bj].y, ll = n ? lo8[m2][bj].y : lo8[m2][bj].x;
                                const float h0 = bf_lo(ha), h1 = bf_hi(ha), h2 = bf_lo(hb_), h3 = bf_hi(hb_);
                                f32x4 r;
                                r[0] = h0 + (float)(int)(signed char)(ll & 0xffu) * lo_scale(h0); r[1] = h1 + (float)(int)(signed char)((ll >> 8) & 0xffu) * lo_scale(h1);
                                r[2] = h2 + (float)(int)(signed char)((ll >> 16) & 0xffu) * lo_scale(h2); r[3] = h3 + (float)(int)(signed char)(ll >> 24) * lo_scale(h3);
                                hv[m2][bj][n] = r; }
                }
                if (mode == 2) {
#pragma unroll
                    for (int m2 = 0; m2 < 2; ++m2)
#pragma unroll
                        for (int bj = 0; bj < 2; ++bj) qv[m2][bj] = *(const u32x4*)((const char*)pp_u + 2u * EOFF(ai, 2 * mp + m2, bj));
                }
#pragma unroll
                for (int m2 = 0; m2 < 2; ++m2) {
                    const int m = 2 * mp + m2, rl = ai * 128 + wr * 64 + m * 16 + fr, row = u.pm * 256 + rl;
                    const float rs = mode == 2 ? tabr[ui * 256 + rl] : 0.f;
                    float sq = 0.f;
#pragma unroll
                    for (int bj = 0; bj < 2; ++bj) {
                        const unsigned eo = EOFF(ai, m, bj);
                        unsigned hw[4], lw[2];
#pragma unroll
                        for (int n = 0; n < 2; ++n) {
                            const f32x4 v = acc[ai][bj][m][n];
                            f32x4 h = hv[m2][bj][n];
                            if (mode == 0) h = h + v * scale;
                            else { const unsigned qa = n ? qv[m2][bj].z : qv[m2][bj].x, qb = n ? qv[m2][bj].w : qv[m2][bj].y;
                                h[0] += sigm(v[0] * rs) * bf_lo(qa); h[1] += sigm(v[1] * rs) * bf_hi(qa); h[2] += sigm(v[2] * rs) * bf_lo(qb); h[3] += sigm(v[3] * rs) * bf_hi(qb); }
                            if (fout) *(f32x4*)((char*)fout_u + 4u * (eo + 4u * n)) = h;
                            else {
                                const unsigned w0 = pk2(h[0], h[1]), w1 = pk2(h[2], h[3]); hw[2 * n] = w0; hw[2 * n + 1] = w1;
                                const float g0 = bf_lo(w0), g1 = bf_hi(w0), g2 = bf_lo(w1), g3 = bf_hi(w1);
                                const float q0 = __builtin_amdgcn_fmed3f(rintf((h[0] - g0) * __uint_as_float(0x86800000u - (__float_as_uint(g0) & 0x7f800000u))), -128.f, 127.f);
                                const float q1 = __builtin_amdgcn_fmed3f(rintf((h[1] - g1) * __uint_as_float(0x86800000u - (__float_as_uint(g1) & 0x7f800000u))), -128.f, 127.f);
                                const float q2 = __builtin_amdgcn_fmed3f(rintf((h[2] - g2) * __uint_as_float(0x86800000u - (__float_as_uint(g2) & 0x7f800000u))), -128.f, 127.f);
                                const float q3 = __builtin_amdgcn_fmed3f(rintf((h[3] - g3) * __uint_as_float(0x86800000u - (__float_as_uint(g3) & 0x7f800000u))), -128.f, 127.f);
                                lw[n] = ((unsigned)(int)q0 & 0xffu) | (((unsigned)(int)q1 & 0xffu) << 8) | (((unsigned)(int)q2 & 0xffu) << 16) | (((unsigned)(int)q3 & 0xffu) << 24);
                            }
                            sq += (h[0] * h[0] + h[1] * h[1]) + (h[2] * h[2] + h[3] * h[3]);
                        }
                        if (!fout) { const u32x4 hs = {hw[0], hw[1], hw[2], hw[3]}; const u32x2 ls = {lw[0], lw[1]}; *(u32x4*)((char*)hb_u + 2u * eo) = hs; *(u32x2*)((char*)loout_u + eo) = ls; }
                    }
                    if (ssqo) { sq += __shfl_xor(sq, 16); sq += __shfl_xor(sq, 32); if (fq == 0) ssqo[(size_t)row * 16 + u.pn * 4 + wc] = sq; }
                }
            }
#undef EOFF
    }
};
__device__ __forceinline__ void fill_rstd_tab(LAS unsigned char* lds, const float* ssq, int N) {
    const int tid = tid_fresh(), rl = tid & 255, hi = tid >> 8;
    LAS float* tab = (LAS float*)(lds + TABR_OFF);
    pg8::StaticOrder S; S.init(MROWS, N, gridDim.x, VB(lds));
    f32x4 v[4][4]; bool ok[4];
#pragma unroll
    for (int ps = 0; ps < 4; ++ps) { Unit u; ok[ps] = S.next(2 * ps + hi, u);
        if (ok[ps]) { const f32x4* p = (const f32x4*)(ssq + (size_t)(u.pm * 256 + rl) * 16); v[ps][0] = p[0]; v[ps][1] = p[1]; v[ps][2] = p[2]; v[ps][3] = p[3]; } }
#pragma unroll
    for (int ps = 0; ps < 4; ++ps) if (ok[ps]) {
        const f32x4 a = v[ps][0], b = v[ps][1], c = v[ps][2], d = v[ps][3];
        const float s = (((a.x + a.y) + (a.z + a.w)) + ((b.x + b.y) + (b.z + b.w))) + (((c.x + c.y) + (c.z + c.w)) + ((d.x + d.y) + (d.z + d.w)));
        tab[(2 * ps + hi) * 256 + rl] = rsqrtf(s * (1.f / 1024.f) + 1e-6f); }
    __syncthreads();
}
template <class Epi> __device__ __forceinline__ void run_gemm(LAS unsigned char* lds, const bf16_t* A, const bf16_t* Bt, int N, int K, const Epi& E, int atiled = 0, int krot = 0) {
    pg8::StaticOrder S; S.init(MROWS, N, gridDim.x, VB(lds));
    const pg8::Gemm g{A, Bt, MROWS, N, K, atiled, krot};
    pg8::gemm_phase<Epi, pg8::StaticOrder, false>(lds, g, S, E, nullptr);
}
__device__ __forceinline__ void gemm_gu(LAS unsigned char* lds, const bf16_t* A, const float* ssq, const bf16_t* W, bf16_t* act) {
    fill_rstd_tab(lds, ssq, 5632);
    EpiT e{}; e.mode = 0; e.tabr = (LAS const float*)(lds + TABR_OFF); e.out = act; e.S.init(MROWS, 5632, gridDim.x, VB(lds)); run_gemm(lds, A, W, 5632, 1024, e);
}
struct HRef { const float* x; const bf16_t* hi; const signed char* lo; };
struct HDst { float* f; bf16_t* hi; signed char* lo; float* ssq; };
__device__ __forceinline__ void gemm_res(LAS unsigned char* lds, const bf16_t* A, const bf16_t* W, int K, HRef in, HDst out, float scale) {
    EpiF e{}; e.mode = 0; e.xin = in.x; e.hbin = in.hi; e.loin = in.lo; e.fout = out.f; e.hb = out.hi; e.loout = out.lo; e.ssqo = out.ssq; e.scale = scale;
    run_gemm(lds, A, W, 1024, K, e, K == 2816 ? 1 : 0, 0);
}
__device__ __forceinline__ void ple_phase(LAS unsigned char* lds, const bf16_t* pb, const bf16_t* Wpp, bf16_t* pp, const bf16_t* A, const float* ssqi, const bf16_t* Wpg, HRef in, HDst out, bool pp_ready = false) {
    fill_rstd_tab(lds, ssqi, 1024);
    pg8::StaticOrder S; S.init(MROWS, 1024, gridDim.x, VB(lds));
    if (!pp_ready) {
        run_gemm(lds, pb, Wpp, 1024, 256, EpiF{1, nullptr, nullptr, nullptr, nullptr, nullptr, nullptr, nullptr, 0.f, nullptr, pp, S});
        __threadfence(); __syncthreads(); __builtin_amdgcn_fence(__ATOMIC_ACQUIRE, "agent"); }
    run_gemm(lds, A, Wpg, 1024, 1024, EpiF{2, in.x, in.hi, in.lo, out.f, out.hi, out.lo, out.ssq, 0.f, (LAS const float*)(lds + TABR_OFF), pp, S});
}

__device__ __forceinline__ void cvt_rows_bf16(const float* src, bf16_t* dst, int ncol4  , int lane, int gw, int NGW) {
    for (int row = gw; row < MROWS; row += NGW) {
        const f32x4 v = *(const f32x4*)(src + (size_t)row * 256 + 4 * lane);
        u32x2 w; w.x = pk2(v[0], v[1]); w.y = pk2(v[2], v[3]);
        *(u32x2*)(dst + (size_t)row * 256 + 4 * lane) = w;
    }
}
__device__ __forceinline__ void convert_descs(const Args& a, int d_lo, int d_hi, int rank, int n) {
    const int lane = tid_fresh() & 63, wave = tid_fresh() >> 6;
    int total = 0;
    for (int d = d_lo; d < d_hi; ++d) total += (a.wd[d].K >> 6) * (a.wd[d].ncols >> 5);
    const int kc = lane & 7, ng = lane >> 3;
    for (int it = rank * 8 + wave; it < total; it += n * 8) {
        int r = it, d = d_lo;
        for (;;) { const int c = (a.wd[d].K >> 6) * (a.wd[d].ncols >> 5); if (r < c) break; r -= c; ++d; }
        const float* src = a.in[a.wd[d].src_idx] + a.wd[d].src_off; const float* gain = a.wd[d].gain_idx >= 0 ? a.in[a.wd[d].gain_idx] + a.wd[d].gain_off : nullptr; bf16_t* dst = (bf16_t*)(a.ws + a.wd[d].dst_off);
        const int ldsrc = a.wd[d].ldsrc, col0 = a.wd[d].col0, K = a.wd[d].K, dstrow0 = a.wd[d].dstrow0, mode = a.wd[d].mode;
        const int nblk = a.wd[d].ncols >> 5, kb = r / nblk, nb = r % nblk, k0 = 64 * kb + 8 * kc, n0 = 32 * nb + 4 * ng;
        f32x4 v[8];
#pragma unroll
        for (int i = 0; i < 8; ++i) v[i] = *(const f32x4*)(src + (size_t)(k0 + i) * ldsrc + col0 + n0);
        if (gain) { const f32x4 g0 = *(const f32x4*)(gain + k0), g1 = *(const f32x4*)(gain + k0 + 4);
#pragma unroll
            for (int i = 0; i < 4; ++i) { v[i] = v[i] * g0[i]; v[4 + i] = v[4 + i] * g1[i]; } }
#pragma unroll
        for (int j = 0; j < 4; ++j) { const int f = n0 + j;
            const int drow = mode == 0 ? dstrow0 + f : (256 * (f >> 7) + (f & 127) + (mode == 2 ? 128 : 0));
            u32x4 o; o.x = pk2(v[0][j], v[1][j]); o.y = pk2(v[2][j], v[3][j]); o.z = pk2(v[4][j], v[5][j]); o.w = pk2(v[6][j], v[7][j]);
            *(u32x4*)(dst + (size_t)drow * K + k0) = o; }
    }
}
__device__ __forceinline__ bool slack_pp(LAS unsigned char* lds, int N, const bf16_t* pb, const bf16_t* Wpp, bf16_t* pp) {
    const int G = (int)gridDim.x, nwg = 64 * (N >> 8), busy_last = nwg - ((nwg + G - 1) / G - 1) * G, c = VB(lds);
    if (busy_last >= G) return false;
    if (c >= busy_last) { pg8::StaticOrder S; S.init(MROWS, 1024, G - busy_last, c - busy_last); const pg8::Gemm g{pb, Wpp, MROWS, 1024, 256, 0, 0};
        const EpiF e{1, nullptr, nullptr, nullptr, nullptr, nullptr, nullptr, nullptr, 0.f, nullptr, pp, S}; pg8::gemm_phase<EpiF, pg8::StaticOrder, false>(lds, g, S, e, nullptr); }
    return true;
}
__device__ __forceinline__ void slack_convert(const Args& a, LAS unsigned char* lds, int N, int d_lo, int d_hi) {
    const int G = (int)gridDim.x, nwg = 64 * (N >> 8), busy_last = nwg - ((nwg + G - 1) / G - 1) * G, c = VB(lds);
    if (busy_last >= G) convert_descs(a, d_lo, d_hi, c, G);
    else if (c >= busy_last) convert_descs(a, d_lo, d_hi, c - busy_last, G - busy_last);
}
__device__ __forceinline__ void p0_phase(const Args& a, LAS unsigned char* lds) {
    const int lane = tid_fresh() & 63, wave = tid_fresh() >> 6;
    const int gw = blockIdx.x * 8 + wave, NGW = gridDim.x * 8;
    convert_descs(a, 0, 2, blockIdx.x, gridDim.x);
    const float* x = a.in[0]; bf16_t* xb = (bf16_t*)(a.ws + OFF_SA); float* ssq = (float*)(a.ws + OFF_SSQA);
    for (int row = gw; row < MROWS; row += NGW) {
        float s = 0.f;
#pragma unroll
        for (int j = 0; j < 4; ++j) { const f32x4 v = *(const f32x4*)(x + (size_t)row * 1024 + 256 * j + 4 * lane);
            s += (v[0] * v[0] + v[1] * v[1]) + (v[2] * v[2] + v[3] * v[3]);
            u32x2 w; w.x = pk2(v[0], v[1]); w.y = pk2(v[2], v[3]); *(u32x2*)(xb + (size_t)row * 1024 + 256 * j + 4 * lane) = w; }
        s = wave_sum(s);
        if (lane < 16) ssq[(size_t)row * 16 + lane] = lane == 0 ? s : 0.f;
    }
    cvt_rows_bf16(a.in[1], (bf16_t*)(a.ws + OFF_PB), 64, lane, gw, NGW);
}
#define XB_TMO      128
#define XB_XCNT(j)  (256  + 64 * (j))
#define XB_XSUB(j)  (1280 + 64 * (j))
#define XB_XGEN(j)  (2304 + 64 * (j))
#define XB_TOP      3328
#define XB_TOPGEN   3392
#define XCD_BAR_WORDS 3456
#define XB_SPIN_CAP (1u << 18)
__device__ __forceinline__ unsigned xb_ld(unsigned* p)              { return __hip_atomic_load(p, __ATOMIC_RELAXED, __HIP_MEMORY_SCOPE_AGENT); }
__device__ __forceinline__ unsigned xb_add(unsigned* p, unsigned v) { return __hip_atomic_fetch_add(p, v, __ATOMIC_RELAXED, __HIP_MEMORY_SCOPE_AGENT); }
__device__ __forceinline__ unsigned xb_xcc_id() { return (unsigned)__builtin_amdgcn_s_getreg((3 << 11) | 20) & 0xFu; }
#define XB_SPIN(cond, bar) do { unsigned _sp = 0; while (cond) { __builtin_amdgcn_s_sleep(1); \
    if ((++_sp & 255u) == 0u) { if (xb_ld(&(bar)[XB_TMO])) break; if (_sp > XB_SPIN_CAP) { atomicAdd(&(bar)[XB_TMO], 1u); break; } } } } while (0)

struct XcdBarrier {
    unsigned* bar; unsigned x;
    volatile LAS unsigned* st;
};

__device__ __forceinline__ XcdBarrier xcd_barrier_post(unsigned* bar, volatile LAS unsigned* st) {
    XcdBarrier b; b.bar = bar; b.x = xb_xcc_id(); b.st = st;
    if (tid_fresh() == 0) (void)xb_add(&bar[XB_XCNT(b.x)], 1u);
    return b;
}
__device__ __forceinline__ void xcd_barrier_complete(unsigned* bar, unsigned x, unsigned& nloc, unsigned& nx) {
    const unsigned G = gridDim.x * gridDim.y * gridDim.z;
    unsigned sum, cnt, mine, sp = 0u;
    for (;;) {
        sum = 0u; cnt = 0u; mine = 0u;
#pragma unroll
        for (unsigned j = 0; j < 16; ++j) { const unsigned c = xb_ld(&bar[XB_XCNT(j)]); sum += c; cnt += (c > 0u) ? 1u : 0u; mine = (j == x) ? c : mine; }
        if (sum == G) break;
        __builtin_amdgcn_s_sleep(1);
        if ((++sp & 255u) == 0u) { if (xb_ld(&bar[XB_TMO])) break; if (sp > XB_SPIN_CAP) { atomicAdd(&bar[XB_TMO], 1u); break; } }
    }
    nloc = mine > 0u ? mine : 1u; nx = cnt > 0u ? cnt : 1u;
}

__device__ __forceinline__ void xcd_barrier(const XcdBarrier& b) {
    asm volatile("s_waitcnt vmcnt(0)" ::: "memory");
    __syncthreads();
    if (tid_fresh() == 0) {
        unsigned* bar = b.bar;
        __builtin_amdgcn_s_waitcnt(0);
        unsigned nloc = b.st[0], nx = b.st[1];
        if (nloc == 0u) { xcd_barrier_complete(bar, b.x, nloc, nx); b.st[0] = nloc; b.st[1] = nx; }
        const unsigned old = xb_add(&bar[XB_XSUB(b.x)], 1u);
        const unsigned gen = old / nloc;
        if (old + 1u == (gen + 1u) * nloc) {
            __builtin_amdgcn_fence(__ATOMIC_RELEASE, "agent");
            asm volatile("s_waitcnt vmcnt(0)" ::: "memory");
            const unsigned og = xb_add(&bar[XB_TOP], 1u);
            const unsigned tg = og / nx;
            if (og + 1u == (tg + 1u) * nx) xb_add(&bar[XB_TOPGEN], 1u);
            else XB_SPIN(xb_ld(&bar[XB_TOPGEN]) == tg, bar);
            __builtin_amdgcn_fence(__ATOMIC_ACQUIRE, "agent");
            xb_add(&bar[XB_XGEN(b.x)], 1u);
            asm volatile("s_waitcnt vmcnt(0)" ::: "memory");
        } else {
            XB_SPIN(xb_ld(&bar[XB_XGEN(b.x)]) == gen, bar);
            __builtin_amdgcn_fence(__ATOMIC_ACQUIRE, "agent");
            asm volatile("s_waitcnt vmcnt(0)" ::: "memory");
        }
    }
    __syncthreads();
}

__device__ __forceinline__ void stage_k(const bf16_t* src, LAS unsigned char* Kt, int lane) {
#pragma unroll
    for (int i = 0; i < 8; ++i) { const int r = (lane >> 3) + 8 * i;
        const u32x4 v = *(const u32x4*)(src + (size_t)r * 2304 + (lane & 7) * 8);
        *(LAS u32x4*)(Kt + r * 144 + (lane & 7) * 16) = v; }
}
__device__ __forceinline__ void stage_k_norm(const bf16_t* src, const float* kg, LAS unsigned char* Kt, int lane) {
    const f32x4 g0 = *(const f32x4*)(kg + (lane & 7) * 8), g1 = *(const f32x4*)(kg + (lane & 7) * 8 + 4);
#pragma unroll
    for (int i = 0; i < 8; ++i) { const int r = (lane >> 3) + 8 * i;
        const u32x4 v = *(const u32x4*)(src + (size_t)r * 2304 + (lane & 7) * 8);
        float f[8] = {bf_lo(v.x), bf_hi(v.x), bf_lo(v.y), bf_hi(v.y), bf_lo(v.z), bf_hi(v.z), bf_lo(v.w), bf_hi(v.w)};
        float s = 0.f;
#pragma unroll
        for (int e = 0; e < 8; ++e) s += f[e] * f[e];
        s += __shfl_xor(s, 1); s += __shfl_xor(s, 2); s += __shfl_xor(s, 4);
        const float inv = rsqrtf(s * (1.f / 64.f) + 1e-6f);
        u32x4 w; w.x = pk2(f[0] * inv * g0[0], f[1] * inv * g0[1]); w.y = pk2(f[2] * inv * g0[2], f[3] * inv * g0[3]);
        w.z = pk2(f[4] * inv * g1[0], f[5] * inv * g1[1]); w.w = pk2(f[6] * inv * g1[2], f[7] * inv * g1[3]);
        *(LAS u32x4*)(Kt + r * 144 + (lane & 7) * 16) = w; }
}
__device__ __forceinline__ void stage_vt(const bf16_t* src, LAS unsigned char* Vt, int lane) {
#pragma unroll
    for (int c = 0; c < 8; ++c) {
        const u32x4 v = *(const u32x4*)(src + (size_t)lane * 2304 + c * 8);
        LAS unsigned short* p = (LAS unsigned short*)(Vt + (8 * c) * 144 + lane * 2);
        p[0 * 72] = (unsigned short)(v.x & 0xffffu); p[1 * 72] = (unsigned short)(v.x >> 16);
        p[2 * 72] = (unsigned short)(v.y & 0xffffu); p[3 * 72] = (unsigned short)(v.y >> 16);
        p[4 * 72] = (unsigned short)(v.z & 0xffffu); p[5 * 72] = (unsigned short)(v.z >> 16);
        p[6 * 72] = (unsigned short)(v.w & 0xffffu); p[7 * 72] = (unsigned short)(v.w >> 16);
    }
}
typedef short s16x4 __attribute__((ext_vector_type(4)));
__device__ __forceinline__ s16x4 lds_tr4(LAS const unsigned char* p) { return __builtin_amdgcn_ds_read_tr16_b64_v4i16((LAS s16x4*)p); }
__device__ __forceinline__ void tile_fetch(u32x4 (&r)[8], const bf16_t* src, int lane) {
#pragma unroll
    for (int i = 0; i < 8; ++i) r[i] = *(const u32x4*)(src + (size_t)((lane >> 3) + 8 * i) * 2304 + (lane & 7) * 8);
}
__device__ __forceinline__ void tile_park(const u32x4 (&r)[8], LAS unsigned char* T, int lane) {
#pragma unroll
    for (int i = 0; i < 8; ++i) *(LAS u32x4*)(T + ((lane >> 3) + 8 * i) * 144 + (lane & 7) * 16) = r[i];
}
template <int I0, int N> __device__ __forceinline__ void tile_fetch_part(u32x4 (&r)[N], const bf16_t* src, int lane) {
#pragma unroll
    for (int i = 0; i < N; ++i) r[i] = *(const u32x4*)(src + (size_t)((lane >> 3) + 8 * (I0 + i)) * 2304 + (lane & 7) * 8);
}
template <int I0, int N> __device__ __forceinline__ void tile_park_part(const u32x4 (&r)[N], LAS unsigned char* T, int lane) {
#pragma unroll
    for (int i = 0; i < N; ++i) *(LAS u32x4*)(T + ((lane >> 3) + 8 * (I0 + i)) * 144 + (lane & 7) * 16) = r[i];
}
__device__ __forceinline__ void tile_park_norm(const u32x4 (&r)[8], const float* kg, LAS unsigned char* T, int lane) {
    const f32x4 g0 = *(const f32x4*)(kg + (lane & 7) * 8), g1 = *(const f32x4*)(kg + (lane & 7) * 8 + 4);
#pragma unroll
    for (int i = 0; i < 8; ++i) { const u32x4 v = r[i];
        float f[8] = {bf_lo(v.x), bf_hi(v.x), bf_lo(v.y), bf_hi(v.y), bf_lo(v.z), bf_hi(v.z), bf_lo(v.w), bf_hi(v.w)};
        float s = 0.f;
#pragma unroll
        for (int e = 0; e < 8; ++e) s += f[e] * f[e];
        s += __shfl_xor(s, 1); s += __shfl_xor(s, 2); s += __shfl_xor(s, 4);
        const float inv = rsqrtf(s * (1.f / 64.f) + 1e-6f);
        u32x4 w; w.x = pk2(f[0] * inv * g0[0], f[1] * inv * g0[1]); w.y = pk2(f[2] * inv * g0[2], f[3] * inv * g0[3]);
        w.z = pk2(f[4] * inv * g1[0], f[5] * inv * g1[1]); w.w = pk2(f[6] * inv * g1[2], f[7] * inv * g1[3]);
        *(LAS u32x4*)(T + ((lane >> 3) + 8 * i) * 144 + (lane & 7) * 16) = w; }
}
__device__ __forceinline__ void wave_lds_fence() { asm volatile("s_waitcnt lgkmcnt(0)" ::: "memory"); }
__device__ __forceinline__ f32x4 amfma(bf16x8 x, bf16x8 y, f32x4 c) { return __builtin_amdgcn_mfma_f32_16x16x32_bf16(x, y, c, 0, 0, 0); }
__device__ __forceinline__ bf16x8 mk8(unsigned a, unsigned b, unsigned c, unsigned d) { const u32x4 t = {a, b, c, d}; return __builtin_bit_cast(bf16x8, t); }

template <int KIND, int NQS>
__device__ __forceinline__ void att_item(const bf16_t* proj, bf16_t* oatt, const float* qg, const float* kg, const float* sinks, LAS unsigned char* wl, int b, int h, int qbi, int lane) {
    const int t0 = qbi * (16 * NQS);
    LAS unsigned char* Kt = wl; LAS unsigned char* Vt = wl + 9216;
    const int l15 = lane & 15, l4 = lane >> 4;
    const int kvh = KIND ? (h >> 2) : h;
    const int qcol = KIND ? 1536 + h * 64 : h * 64, kcol = KIND ? 2048 + kvh * 64 : 512 + h * 64, vcol = KIND ? 2176 + kvh * 64 : 1024 + h * 64, ocol = KIND ? 512 + h * 64 : h * 64;
    const float slope = exp2f(-(float)(h + 1));
    const size_t rowb = (size_t)b * 4096 + t0;
    bf16x8 qf[NQS][2];
#pragma unroll
    for (int qs = 0; qs < NQS; ++qs) {
        const u32x4 r0 = *(const u32x4*)(proj + (rowb + 16 * qs + l15) * 2304 + qcol + 8 * l4), r1 = *(const u32x4*)(proj + (rowb + 16 * qs + l15) * 2304 + qcol + 32 + 8 * l4);
        if (KIND == 0) { qf[qs][0] = __builtin_bit_cast(bf16x8, r0); qf[qs][1] = __builtin_bit_cast(bf16x8, r1); }
        else {
            float f[16] = {bf_lo(r0.x), bf_hi(r0.x), bf_lo(r0.y), bf_hi(r0.y), bf_lo(r0.z), bf_hi(r0.z), bf_lo(r0.w), bf_hi(r0.w),
                           bf_lo(r1.x), bf_hi(r1.x), bf_lo(r1.y), bf_hi(r1.y), bf_lo(r1.z), bf_hi(r1.z), bf_lo(r1.w), bf_hi(r1.w)};
            float ss = 0.f;
#pragma unroll
            for (int e = 0; e < 16; ++e) ss += f[e] * f[e];
            ss += __shfl_xor(ss, 16); ss += __shfl_xor(ss, 32);
            const float inv = rsqrtf(ss * (1.f / 64.f) + 1e-6f) * 0.125f;
            const f32x4 g0 = *(const f32x4*)(qg + 8 * l4), g1 = *(const f32x4*)(qg + 8 * l4 + 4), g2 = *(const f32x4*)(qg + 32 + 8 * l4), g3 = *(const f32x4*)(qg + 36 + 8 * l4);
            qf[qs][0] = mk8(pk2(f[0] * inv * g0[0], f[1] * inv * g0[1]), pk2(f[2] * inv * g0[2], f[3] * inv * g0[3]), pk2(f[4] * inv * g1[0], f[5] * inv * g1[1]), pk2(f[6] * inv * g1[2], f[7] * inv * g1[3]));
            qf[qs][1] = mk8(pk2(f[8] * inv * g2[0], f[9] * inv * g2[1]), pk2(f[10] * inv * g2[2], f[11] * inv * g2[3]), pk2(f[12] * inv * g3[0], f[13] * inv * g3[1]), pk2(f[14] * inv * g3[2], f[15] * inv * g3[3]));
        }
    }
    f32x4 O[NQS][4];
#pragma unroll
    for (int qs = 0; qs < NQS; ++qs)
#pragma unroll
        for (int dt = 0; dt < 4; ++dt) O[qs][dt] = (f32x4){0.f, 0.f, 0.f, 0.f};
    float st0[NQS], st1[NQS];
#pragma unroll
    for (int qs = 0; qs < NQS; ++qs) { st0[qs] = KIND ? sinks[h] : 0.f; st1[qs] = (KIND && l4 == 0) ? 1.f : 0.f; }
    const int kb_hi = (t0 + 16 * NQS - 1) >> 6, kb_lo = t0 >= 127 ? ((t0 - 127) >> 6) : 0;
    const int kb_first = KIND ? kb_lo : kb_hi, kb_last = KIND ? kb_hi : 0, kb_step = KIND ? 1 : -1;
    u32x4 kr[8], vlo[4];
    { const bf16_t* kbase = proj + ((size_t)b * 4096 + kb_first * 64) * 2304; tile_fetch(kr, kbase + kcol, lane); tile_fetch_part<0, 4>(vlo, kbase + vcol, lane); }
    for (int kb = kb_first; KIND ? (kb <= kb_last) : (kb >= kb_last); kb += kb_step) {
        wave_lds_fence();
        { u32x4 vhi[4]; tile_fetch_part<4, 4>(vhi, proj + ((size_t)b * 4096 + kb * 64) * 2304 + vcol, lane);
          if (KIND) tile_park_norm(kr, kg, Kt, lane); else tile_park(kr, Kt, lane);
          tile_park_part<0, 4>(vlo, Vt, lane); tile_park_part<4, 4>(vhi, Vt, lane); }
        { const int kn = kb + kb_step;
          if (KIND ? (kn <= kb_last) : (kn >= kb_last)) { const bf16_t* kbase = proj + ((size_t)b * 4096 + kn * 64) * 2304; tile_fetch(kr, kbase + kcol, lane); tile_fetch_part<0, 4>(vlo, kbase + vcol, lane); } }
        wave_lds_fence();
#pragma unroll
        for (int qs = 0; qs < NQS; ++qs) {
            f32x4 S[4];
#pragma unroll
            for (int kt = 0; kt < 4; ++kt) { const bf16x8 k0 = *(LAS const bf16x8*)(Kt + (16 * kt + l15) * 144 + (8 * l4) * 2), k1 = *(LAS const bf16x8*)(Kt + (16 * kt + l15) * 144 + (32 + 8 * l4) * 2);
                S[kt] = amfma(k0, qf[qs][0], (f32x4){0.f, 0.f, 0.f, 0.f}); S[kt] = amfma(k1, qf[qs][1], S[kt]); }
            const int t = t0 + 16 * qs + l15, key0 = kb * 64 + 4 * l4;
            float w[4][4];
            if (KIND == 0) {
                float sp[4][4], q4[4], hi[4], tot[4];
#pragma unroll
                for (int kt = 0; kt < 4; ++kt) { q4[kt] = 0.f;
#pragma unroll
                    for (int r = 0; r < 4; ++r) { const float z = S[kt][r] * 0.125f; S[kt][r] = z;
                        const float v = fmaxf(z, 0.f) + __logf(1.f + __expf(-fabsf(z)));
                        sp[kt][r] = (key0 + 16 * kt + r < t) ? v : 0.f; q4[kt] += sp[kt][r]; } }
#pragma unroll
                for (int kt = 0; kt < 4; ++kt) {
                    const float a1 = __shfl(q4[kt], (lane + 16) & 63), a2 = __shfl(q4[kt], (lane + 32) & 63), a3 = __shfl(q4[kt], (lane + 48) & 63);
                    hi[kt] = (l4 < 3 ? a1 : 0.f) + (l4 < 2 ? a2 : 0.f) + (l4 < 1 ? a3 : 0.f);
                    tot[kt] = __shfl(hi[kt] + q4[kt], l15); }
                float above = st0[qs];
#pragma unroll
                for (int kt = 3; kt >= 0; --kt) { float run = above + hi[kt];
#pragma unroll
                    for (int r = 3; r >= 0; --r) { w[kt][r] = (key0 + 16 * kt + r < t) ? __expf(S[kt][r] - sp[kt][r] - run) : 0.f; run += sp[kt][r]; }
                    above += tot[kt]; }
                st0[qs] = above;
            } else {
                float mx = st0[qs];
#pragma unroll
                for (int kt = 0; kt < 4; ++kt)
#pragma unroll
                    for (int r = 0; r < 4; ++r) { const int dist = t - (key0 + 16 * kt + r); const bool valid = dist >= 0 && dist < 128;
                        const float sc = valid ? S[kt][r] - slope * (float)dist : -1e30f; S[kt][r] = sc; mx = fmaxf(mx, sc); }
                mx = fmaxf(mx, __shfl_xor(mx, 16)); mx = fmaxf(mx, __shfl_xor(mx, 32));
                const float corr = __expf(st0[qs] - mx); st0[qs] = mx;
                float ls = 0.f;
#pragma unroll
                for (int kt = 0; kt < 4; ++kt)
#pragma unroll
                    for (int r = 0; r < 4; ++r) { w[kt][r] = S[kt][r] > -1e29f ? __expf(S[kt][r] - mx) : 0.f; ls += w[kt][r]; }
                st1[qs] = st1[qs] * corr + ls;
#pragma unroll
                for (int dt = 0; dt < 4; ++dt) O[qs][dt] = O[qs][dt] * corr;
            }
            const bf16x8 pf0 = mk8(pk2(w[0][0], w[0][1]), pk2(w[0][2], w[0][3]), pk2(w[1][0], w[1][1]), pk2(w[1][2], w[1][3]));
            const bf16x8 pf1 = mk8(pk2(w[2][0], w[2][1]), pk2(w[2][2], w[2][3]), pk2(w[3][0], w[3][1]), pk2(w[3][2], w[3][3]));
            {
                LAS const unsigned char* vb = Vt + (4 * l4 + (l15 >> 2)) * 144 + 8 * (l15 & 3);
#pragma unroll
                for (int dt = 0; dt < 4; ++dt) {
                    const s16x4 a0 = lds_tr4(vb + 32 * dt), b0 = lds_tr4(vb + 16 * 144 + 32 * dt), a1 = lds_tr4(vb + 32 * 144 + 32 * dt), b1 = lds_tr4(vb + 48 * 144 + 32 * dt);
                    const bf16x8 v0 = {a0[0], a0[1], a0[2], a0[3], b0[0], b0[1], b0[2], b0[3]}, v1 = {a1[0], a1[1], a1[2], a1[3], b1[0], b1[1], b1[2], b1[3]};
                    O[qs][dt] = amfma(v0, pf0, O[qs][dt]);
                    O[qs][dt] = amfma(v1, pf1, O[qs][dt]);
                }
            }
        }
        if (KIND == 0) { float rmin = st0[0];
#pragma unroll
            for (int qs = 1; qs < NQS; ++qs) rmin = fminf(rmin, st0[qs]);
            if (__all(rmin > 104.f)) break; }
    }
#pragma unroll
    for (int qs = 0; qs < NQS; ++qs) {
        float sc = 1.f;
        if (KIND) { float l = st1[qs]; l += __shfl_xor(l, 16); l += __shfl_xor(l, 32); sc = 1.f / l; }
#pragma unroll
        for (int dt = 0; dt < 4; ++dt) { u32x2 o; o.x = pk2(O[qs][dt][0] * sc, O[qs][dt][1] * sc); o.y = pk2(O[qs][dt][2] * sc, O[qs][dt][3] * sc);
            *(u32x2*)(oatt + (rowb + 16 * qs + l15) * 1024 + ocol + 16 * dt + 4 * l4) = o; }
    }
}
__device__ __forceinline__ void att_phase(const Args& a, LAS unsigned char* lds, const bf16_t* proj, bf16_t* oatt) {
    const int lane = tid_fresh() & 63, wave = tid_fresh() >> 6;
    LAS unsigned char* wl = lds + wave * 18432;
    const int NGW = gridDim.x * 8;
    for (int it = blockIdx.x * 8 + wave; it < 8192; it += NGW) {
        const int kind = it >> 12, r = it & 4095;
        const int qbi = 127 - (r & 127), h = (r >> 7) & 7, b = r >> 10;
        if (kind == 0) att_item<0, 2>(proj, oatt, a.in[8], a.in[9], a.in[10], wl, b, h, qbi, lane);
        else att_item<1, 2>(proj, oatt, a.in[8], a.in[9], a.in[10], wl, b, h, qbi, lane);
    }
}
__device__ __forceinline__ f32x4 mfma16(bf16x8 x, bf16x8 y, f32x4 c) { return __builtin_amdgcn_mfma_f32_16x16x32_bf16(x, y, c, 0, 0, 0); }
__device__ __forceinline__ bf16_t f2bf(float x) { return (bf16_t)(pk2(x, 0.f) & 0xffffu); }

__device__ __forceinline__ void gdn_prep_phase(const Args& a, LAS unsigned char* lds, const bool dry = false) {
    const int tid = tid_fresh(), lane = tid & 63, wave = tid >> 6;
    unsigned char* ws = a.ws;
    bf16_t* QKV = (bf16_t*)(ws + OFF_QKV); const bf16_t* halo = (const bf16_t*)(ws + OFF_HALO); const float* gates = (const float*)(ws + OFF_GATES);
    float* gb = (float*)(ws + OFF_GB); bf16_t* Tinv = (bf16_t*)(ws + OFF_TINV); bf16_t* attn = (bf16_t*)(ws + OFF_ATTN);
    const float* convw = a.in[13]; const float* a_log = a.in[14]; const float* dtb = a.in[15];
    constexpr int CSP = 1040;
    LAS unsigned char* cs = lds;
    LAS float* kkf = (LAS float*)(lds + 69888);
    LAS float* qkf = (LAS float*)(lds + 69888 + 17408);
    LAS float* Lm = (LAS float*)(lds + 104704);
    LAS float* betas = (LAS float*)(lds + 137472);
    LAS float* gcs = betas + 128;
    auto fetch_raw = [&](int item, u32x4 (&raw)[9]) {
        const int n = item & 63, hk = (item >> 6) & 7, b = item >> 9;
        const size_t row0 = (size_t)b * 4096 + 64 * n;
#pragma unroll
        for (int i = 0; i < 9; ++i) { const int v = tid + 512 * i; raw[i] = (u32x4){0u, 0u, 0u, 0u};
            if (v < 67 * 64) { const int r = v >> 6, ch = 8 * (v & 63);
                const int gcol = ch < 128 ? hk * 128 + ch : (ch < 256 ? 1024 + hk * 128 + (ch - 128) : 2048 + hk * 256 + (ch - 256));
                if (r >= 3) raw[i] = *(const u32x4*)(QKV + (row0 + r - 3) * 4096 + gcol);
                else if (n > 0) raw[i] = *(const u32x4*)(halo + ((size_t)(b * 64 + n - 1) * 3 + r) * 4096 + gcol); } }
    };
    u32x4 raw[9];
    if ((int)blockIdx.x < 2048) fetch_raw(blockIdx.x, raw);
    for (int item = blockIdx.x; item < 2048; item += gridDim.x) {
        const int n = item & 63, hk = (item >> 6) & 7, b = item >> 9;
        const size_t row0 = (size_t)b * 4096 + 64 * n;
        __syncthreads();
#pragma unroll
        for (int i = 0; i < 9; ++i) { const int v = tid + 512 * i; if (v < 67 * 64) *(LAS u32x4*)(cs + (v >> 6) * CSP + 16 * (v & 63)) = raw[i]; }
        if (item + (int)gridDim.x < 2048) fetch_raw(item + gridDim.x, raw);
        __syncthreads();
        {
            const int ch = tid;
            const int gcol = ch < 128 ? hk * 128 + ch : (ch < 256 ? 1024 + hk * 128 + (ch - 128) : 2048 + hk * 256 + (ch - 256));
            const float w0 = convw[gcol], w1 = convw[4096 + gcol], w2 = convw[8192 + gcol], w3 = convw[12288 + gcol];
            LAS bf16_t* col = (LAS bf16_t*)(cs + ch * 2);
            float x0 = bf2f(col[0]), x1 = bf2f(col[520]), x2 = bf2f(col[1040]);
#pragma unroll 8
            for (int t = 0; t < 64; ++t) { const float x3 = bf2f(col[(t + 3) * 520]);
                const float y = (w0 * x0 + w1 * x1) + (w2 * x2 + w3 * x3);
                col[(t + 3) * 520] = f2bf(silu_(y)); x0 = x1; x1 = x2; x2 = x3; }
        }
        __syncthreads();
        {
            const int pair = tid >> 2, t = pair >> 1, part = pair & 1, qd = tid & 3;
            LAS u32x4* p = (LAS u32x4*)(cs + (t + 3) * CSP + part * 256 + qd * 64);
            u32x4 u[4]; float ss = 0.f;
#pragma unroll
            for (int i = 0; i < 4; ++i) { u[i] = p[i];
                ss += (bf_lo(u[i].x) * bf_lo(u[i].x) + bf_hi(u[i].x) * bf_hi(u[i].x)) + (bf_lo(u[i].y) * bf_lo(u[i].y) + bf_hi(u[i].y) * bf_hi(u[i].y))
                    + (bf_lo(u[i].z) * bf_lo(u[i].z) + bf_hi(u[i].z) * bf_hi(u[i].z)) + (bf_lo(u[i].w) * bf_lo(u[i].w) + bf_hi(u[i].w) * bf_hi(u[i].w)); }
            ss += __shfl_xor(ss, 1); ss += __shfl_xor(ss, 2);
            const float inv = rsqrtf(ss + 1e-6f) * (part == 0 ? 0.08838834764831845f : 1.f);
            bf16_t* gp = QKV + (row0 + t) * 4096 + part * 1024 + hk * 128 + qd * 32;
#pragma unroll
            for (int i = 0; i < 4; ++i) { u32x4 w;
                w.x = pk2(bf_lo(u[i].x) * inv, bf_hi(u[i].x) * inv); w.y = pk2(bf_lo(u[i].y) * inv, bf_hi(u[i].y) * inv);
                w.z = pk2(bf_lo(u[i].z) * inv, bf_hi(u[i].z) * inv); w.w = pk2(bf_lo(u[i].w) * inv, bf_hi(u[i].w) * inv);
                p[i] = w; if (!dry) *(u32x4*)(gp + 8 * i) = w; }
        }
        for (int v = tid; v < 2048; v += 512) { const int t = v >> 5, c8 = v & 31;
            if (!dry) *(u32x4*)(QKV + (row0 + t) * 4096 + 2048 + hk * 256 + 8 * c8) = *(LAS const u32x4*)(cs + (t + 3) * CSP + 512 + 16 * c8); }
        if (tid < 128) {
            const int hvl = tid >> 6, hv = 2 * hk + hvl; const size_t row = row0 + lane;
            const float bl = gates[row * 32 + hv], av = gates[row * 32 + 16 + hv];
            const float beta = sigm(bl); const float xx = av + dtb[hv];
            const float ex = __expf(-fabsf(xx));
            const float sp = fmaxf(xx, 0.f) + (ex < 1e-4f ? ex * (1.f - 0.5f * ex) : __logf(1.f + ex));
            float g = -__expf(a_log[hv]) * sp;
#pragma unroll
            for (int o = 1; o < 64; o <<= 1) { const float y = __shfl_up(g, o); if (lane >= o) g += y; }
            betas[hvl * 64 + lane] = beta; gcs[hvl * 64 + lane] = g;
            float2 bg; bg.x = beta; bg.y = g; if (!dry) *(float2*)(gb + (row * 16 + hv) * 2) = bg;
        }
        __syncthreads();
        {
            const int ct = wave & 3, which = wave >> 2, l15 = lane & 15, l4 = lane >> 4;
            LAS float* dstm = which ? qkf : kkf;
            bf16x8 ya[4];
#pragma unroll
            for (int ks = 0; ks < 4; ++ks) ya[ks] = *(LAS const bf16x8*)(cs + (3 + 16 * ct + l15) * CSP + (which ? 0 : 256) + (32 * ks + 8 * l4) * 2);
#pragma unroll
            for (int st = 0; st < 4; ++st) { f32x4 acc = {0.f, 0.f, 0.f, 0.f};
#pragma unroll
                for (int ks = 0; ks < 4; ++ks) { const bf16x8 xs = *(LAS const bf16x8*)(cs + (3 + 16 * st + l15) * CSP + 256 + (32 * ks + 8 * l4) * 2); acc = mfma16(xs, ya[ks], acc); }
                *(LAS f32x4*)(dstm + (16 * ct + l15) * 68 + 16 * st + 4 * l4) = acc; }
        }
        __syncthreads();
        {
            const int hvl = tid >> 8, c = (tid >> 2) & 63, s0 = 16 * (tid & 3), hv = 2 * hk + hvl;
            const float gcc = gcs[hvl * 64 + c], bc = betas[hvl * 64 + c];
            unsigned aw[8];
#pragma unroll
            for (int i = 0; i < 16; i += 2) {
                float lv[2], av[2];
#pragma unroll
                for (int e = 0; e < 2; ++e) { const int s_ = s0 + i + e; const float dec = c >= s_ ? __expf(gcc - gcs[hvl * 64 + s_]) : 0.f;
                    lv[e] = c > s_ ? bc * kkf[c * 68 + s_] * dec : 0.f; av[e] = qkf[c * 68 + s_] * dec; }
                Lm[hvl * 4096 + c * 64 + s0 + i] = lv[0]; Lm[hvl * 4096 + c * 64 + s0 + i + 1] = lv[1];
                aw[i >> 1] = pk2(av[0], av[1]); }
            if (!dry) { bf16_t* ap = attn + ((size_t)((b * 16 + hv) * 64 + n)) * 4096 + c * 64 + s0;
                u32x4 w0 = {aw[0], aw[1], aw[2], aw[3]}, w1 = {aw[4], aw[5], aw[6], aw[7]}; *(u32x4*)ap = w0; *(u32x4*)(ap + 8) = w1; }
        }
        __syncthreads();
        LAS float* X = kkf;
        LAS float* Mb = (LAS float*)cs;
        if (tid < 128) {
            const int hvl = tid >> 6, half = lane >> 5, jj = lane & 31, base = 32 * half;
            LAS const float* Lh = Lm + hvl * 4096 + base * 64 + base;
            LAS float* Xh = X + hvl * 4096;
            float x[32];
#pragma unroll
            for (int c = 0; c < 32; ++c) x[c] = 0.f;
#pragma unroll
            for (int c = 0; c < 32; ++c) { float a0 = (c == jj) ? 1.f : 0.f, a1 = 0.f, a2 = 0.f, a3 = 0.f;
#pragma unroll
                for (int s4 = 0; s4 < (c + 3) / 4; ++s4) { const f32x4 Lv = *(LAS const f32x4*)(Lh + c * 64 + 4 * s4);
                    a0 -= Lv[0] * x[4 * s4]; a1 -= Lv[1] * x[4 * s4 + 1]; a2 -= Lv[2] * x[4 * s4 + 2]; a3 -= Lv[3] * x[4 * s4 + 3]; }
                x[c] = (a0 + a1) + (a2 + a3);
                Xh[(base + c) * 64 + base + jj] = x[c];
                if (half == 0) Xh[c * 64 + 32 + jj] = 0.f; }
        }
        __syncthreads();
        {
            const int hvl = tid >> 8, r = (tid >> 3) & 31, q0 = 4 * (tid & 7);
            LAS const float* Lh = Lm + hvl * 4096; LAS float* Xh = X + hvl * 4096;
            f32x4 m = {0.f, 0.f, 0.f, 0.f};
#pragma unroll 8
            for (int t = 0; t < 32; ++t) m = m + *(LAS const f32x4*)(Xh + t * 64 + q0) * Lh[(32 + r) * 64 + t];
            *(LAS f32x4*)(Mb + hvl * 1024 + r * 32 + q0) = m;
            __syncthreads();
            f32x4 e = {0.f, 0.f, 0.f, 0.f};
#pragma unroll 8
            for (int t = 0; t < 32; ++t) e = e - *(LAS const f32x4*)(Mb + hvl * 1024 + t * 32 + q0) * Xh[(32 + r) * 64 + 32 + t];
            *(LAS f32x4*)(Xh + (32 + r) * 64 + q0) = e;
        }
        __syncthreads();
        if (!dry) {
            const int hvl = tid >> 8, c = (tid >> 2) & 63, s0 = 16 * (tid & 3), hv = 2 * hk + hvl;
            LAS const float* xr = X + hvl * 4096 + c * 64 + s0;
            const f32x4 a0 = *(LAS const f32x4*)xr, a1 = *(LAS const f32x4*)(xr + 4), a2 = *(LAS const f32x4*)(xr + 8), a3 = *(LAS const f32x4*)(xr + 12);
            bf16_t* tp = Tinv + ((size_t)((b * 16 + hv) * 64 + n)) * 4096 + c * 64 + s0;
            u32x4 w0 = {pk2(a0[0], a0[1]), pk2(a0[2], a0[3]), pk2(a1[0], a1[1]), pk2(a1[2], a1[3])}, w1 = {pk2(a2[0], a2[1]), pk2(a2[2], a2[3]), pk2(a3[0], a3[1]), pk2(a3[2], a3[3])};
            *(u32x4*)tp = w0; *(u32x4*)(tp + 8) = w1;
        }
    }
}

constexpr int SC_KT = 0, SC_QT = 17408, SC_TT = 34816, SC_AT = 44032, SC_VT = 53248, SC_GB = 58368, SC_STRIDE = 58880, SC_BASE = 22528;
struct ScanStage { u32x4 k[2], q[2], t, a, v; f2v_t g; };
__device__ __forceinline__ void scan_fetch(ScanStage& o, const bf16_t* QKV, const float* gb, const bf16_t* Tinv, const bf16_t* attn, int b, int hv, int hk, int j, int n, int tid) {
    const size_t row0 = (size_t)b * 4096 + 64 * n;
    const size_t itm = (size_t)((b * 16 + hv) * 64 + n) * 4096;
#pragma unroll
    for (int i = 0; i < 2; ++i) { const int idx = tid + 512 * i, row = idx >> 4, c16 = idx & 15;
        o.q[i] = *(const u32x4*)(QKV + (row0 + row) * 4096 + hk * 128 + 8 * c16);
        o.k[i] = *(const u32x4*)(QKV + (row0 + row) * 4096 + 1024 + hk * 128 + 8 * c16); }
    o.t = *(const u32x4*)(Tinv + itm + (tid >> 3) * 64 + 8 * (tid & 7));
    o.a = *(const u32x4*)(attn + itm + (tid >> 3) * 64 + 8 * (tid & 7));
    if (tid < 256) o.v = *(const u32x4*)(QKV + (row0 + (tid >> 2)) * 4096 + 2048 + hv * 128 + 32 * j + 8 * (tid & 3));
    else if (tid < 320) o.g = *(const f2v_t*)(gb + ((row0 + (tid - 256)) * 16 + hv) * 2);
}
__device__ __forceinline__ void scan_park(const ScanStage& o, LAS unsigned char* img, int tid) {
#pragma unroll
    for (int i = 0; i < 2; ++i) { const int idx = tid + 512 * i, row = idx >> 4, c16 = idx & 15;
        *(LAS u32x4*)(img + SC_QT + row * 272 + c16 * 16) = o.q[i]; *(LAS u32x4*)(img + SC_KT + row * 272 + c16 * 16) = o.k[i]; }
    *(LAS u32x4*)(img + SC_TT + (tid >> 3) * 144 + (tid & 7) * 16) = o.t;
    *(LAS u32x4*)(img + SC_AT + (tid >> 3) * 144 + (tid & 7) * 16) = o.a;
    if (tid < 256) *(LAS u32x4*)(img + SC_VT + (tid >> 2) * 80 + (tid & 3) * 16) = o.v;
    else if (tid < 320) *(LAS f2v_t*)(img + SC_GB + (tid - 256) * 8) = o.g;
}
__device__ __forceinline__ void gdn_scan_phase(const Args& a, LAS unsigned char* lds, const bool dry = false) {
    const int tid = tid_fresh(), lane = tid & 63, wave = tid >> 6, l15 = lane & 15, l4 = lane >> 4, ct = wave >> 1, dt = wave & 1;
    unsigned char* ws = a.ws;
    bf16_t* QKV = (bf16_t*)(ws + OFF_QKV); const float* gb = (const float*)(ws + OFF_GB);
    const bf16_t* Tinv = (const bf16_t*)(ws + OFF_TINV); const bf16_t* attn = (const bf16_t*)(ws + OFF_ATTN);
    LAS unsigned char* Sb = lds; LAS unsigned char* RT = lds + 8704; LAS unsigned char* vnT = lds + 13312; LAS unsigned char* vnsT = lds + 17920;
    for (int item = VCU(lds); item < 256; item += gridDim.x) {
        const int j = item & 3, hv = (item >> 2) & 15, b = item >> 6, hk = hv >> 1;
        __syncthreads();
        for (int i = tid; i < 8704 / 4; i += 512) ((LAS unsigned*)Sb)[i] = 0u;
        f32x4 S0 = {0.f, 0.f, 0.f, 0.f}, S1 = {0.f, 0.f, 0.f, 0.f};
        { ScanStage s0; scan_fetch(s0, QKV, gb, Tinv, attn, b, hv, hk, j, 0, tid); scan_park(s0, lds + SC_BASE, tid); }
        __syncthreads();
        for (int n = 0; n < 64; ++n) {
            LAS const unsigned char* img = lds + SC_BASE + (n & 1) * SC_STRIDE;
            ScanStage nx; scan_fetch(nx, QKV, gb, Tinv, attn, b, hv, hk, j, n < 63 ? n + 1 : 63, tid);
            bf16_t* vcol = QKV + ((size_t)b * 4096 + 64 * n + 16 * ct + 4 * l4) * 4096 + 2048 + hv * 128 + 32 * j + 16 * dt + l15;
            float vv[4], be[4], gcr[4];
#pragma unroll
            for (int r = 0; r < 4; ++r) { vv[r] = bf2f(*(LAS const bf16_t*)(img + SC_VT + (16 * ct + 4 * l4 + r) * 80 + (16 * dt + l15) * 2));
                const f2v_t bg = *(LAS const f2v_t*)(img + SC_GB + (16 * ct + 4 * l4 + r) * 8); be[r] = bg.x; gcr[r] = bg.y; }
            const float gcl = *(LAS const float*)(img + SC_GB + 63 * 8 + 4);
            f32x4 KS = {0.f, 0.f, 0.f, 0.f}, QS = {0.f, 0.f, 0.f, 0.f};
#pragma unroll
            for (int ks = 0; ks < 4; ++ks) { const bf16x8 sf = *(LAS const bf16x8*)(Sb + (16 * dt + l15) * 272 + (32 * ks + 8 * l4) * 2);
                const bf16x8 kf = *(LAS const bf16x8*)(img + SC_KT + (16 * ct + l15) * 272 + (32 * ks + 8 * l4) * 2), qf = *(LAS const bf16x8*)(img + SC_QT + (16 * ct + l15) * 272 + (32 * ks + 8 * l4) * 2);
                KS = mfma16(kf, sf, KS); QS = mfma16(qf, sf, QS); }
            float Oacc[4], Rr[4];
#pragma unroll
            for (int r = 0; r < 4; ++r) { const float eg = __expf(gcr[r]); Rr[r] = be[r] * (vv[r] - eg * KS[r]); Oacc[r] = eg * QS[r]; }
            { u32x2 w; w.x = pk2(Rr[0], Rr[1]); w.y = pk2(Rr[2], Rr[3]); *(LAS u32x2*)(RT + (16 * dt + l15) * 144 + (16 * ct + 4 * l4) * 2) = w; }
            __syncthreads();
            f32x4 VN = {0.f, 0.f, 0.f, 0.f};
#pragma unroll
            for (int k2 = 0; k2 < 2; ++k2) { const bf16x8 rf = *(LAS const bf16x8*)(RT + (16 * dt + l15) * 144 + (32 * k2 + 8 * l4) * 2);
                const bf16x8 tf = *(LAS const bf16x8*)(img + SC_TT + (16 * ct + l15) * 144 + (32 * k2 + 8 * l4) * 2); VN = mfma16(tf, rf, VN); }
            { u32x2 w; w.x = pk2(VN[0], VN[1]); w.y = pk2(VN[2], VN[3]); *(LAS u32x2*)(vnT + (16 * dt + l15) * 144 + (16 * ct + 4 * l4) * 2) = w;
              u32x2 x; x.x = pk2(VN[0] * __expf(gcl - gcr[0]), VN[1] * __expf(gcl - gcr[1])); x.y = pk2(VN[2] * __expf(gcl - gcr[2]), VN[3] * __expf(gcl - gcr[3]));
              *(LAS u32x2*)(vnsT + (16 * dt + l15) * 144 + (16 * ct + 4 * l4) * 2) = x; }
            __syncthreads();
            f32x4 O = {Oacc[0], Oacc[1], Oacc[2], Oacc[3]};
#pragma unroll
            for (int k2 = 0; k2 < 2; ++k2) { const bf16x8 vf = *(LAS const bf16x8*)(vnT + (16 * dt + l15) * 144 + (32 * k2 + 8 * l4) * 2);
                const bf16x8 af = *(LAS const bf16x8*)(img + SC_AT + (16 * ct + l15) * 144 + (32 * k2 + 8 * l4) * 2); O = mfma16(af, vf, O); }
#pragma unroll
            for (int r = 0; r < 4; ++r) { if (!dry) vcol[(size_t)r * 4096] = f2bf(O[r]); }
            const float dec = __expf(gcl);
            S0 = S0 * dec; S1 = S1 * dec;
#pragma unroll
            for (int k2 = 0; k2 < 2; ++k2) {
                LAS const unsigned char* kb_ = img + SC_KT + (32 * k2 + 8 * l4 + (l15 >> 2)) * 272 + 32 * wave + 8 * (l15 & 3);
                const s16x4 ka = lds_tr4(kb_), kc = lds_tr4(kb_ + 4 * 272);
                const bf16x8 ktf = {ka[0], ka[1], ka[2], ka[3], kc[0], kc[1], kc[2], kc[3]};
                const bf16x8 v0 = *(LAS const bf16x8*)(vnsT + l15 * 144 + (32 * k2 + 8 * l4) * 2), v1 = *(LAS const bf16x8*)(vnsT + (16 + l15) * 144 + (32 * k2 + 8 * l4) * 2);
                S0 = mfma16(ktf, v0, S0); S1 = mfma16(ktf, v1, S1); }
            { u32x2 w; w.x = pk2(S0[0], S0[1]); w.y = pk2(S0[2], S0[3]); *(LAS u32x2*)(Sb + l15 * 272 + (16 * wave + 4 * l4) * 2) = w;
              u32x2 x; x.x = pk2(S1[0], S1[1]); x.y = pk2(S1[2], S1[3]); *(LAS u32x2*)(Sb + (16 + l15) * 272 + (16 * wave + 4 * l4) * 2) = x; }
            scan_park(nx, lds + SC_BASE + ((n + 1) & 1) * SC_STRIDE, tid);
            __syncthreads();
        }
    }
}

__device__ __forceinline__ void gdn_z_phase(const Args& a, LAS unsigned char* lds) {
    const int tid = tid_fresh();
    unsigned char* ws = a.ws;
    const bf16_t* QKV = (const bf16_t*)(ws + OFF_QKV);
    LAS float* tab = (LAS float*)(lds + TABO_OFF);
    pg8::StaticOrder S; S.init(MROWS, 2048, gridDim.x, VB(lds));
    Unit u;
    for (int i = 0; i < 8 && S.next(i, u); ++i) {
        const int rl = tid >> 1, bj = tid & 1;
        const bf16_t* op = QKV + (size_t)(u.pm * 256 + rl) * 4096 + 2048 + (2 * u.pn + bj) * 128;
        float ss = 0.f;
#pragma unroll
        for (int c = 0; c < 16; ++c) { const u32x4 v = *(const u32x4*)(op + 8 * c);
            ss += (bf_lo(v.x) * bf_lo(v.x) + bf_hi(v.x) * bf_hi(v.x)) + (bf_lo(v.y) * bf_lo(v.y) + bf_hi(v.y) * bf_hi(v.y)) + (bf_lo(v.z) * bf_lo(v.z) + bf_hi(v.z) * bf_hi(v.z)) + (bf_lo(v.w) * bf_lo(v.w) + bf_hi(v.w) * bf_hi(v.w)); }
        tab[i * 512 + rl * 2 + bj] = rsqrtf(ss * (1.f / 128.f) + 1e-6f);
    }
    fill_rstd_tab(lds, (const float*)(ws + OFF_SSQA), 2048);
    EpiT e{}; e.mode = 3; e.tabr = (LAS const float*)(lds + TABR_OFF); e.out = (bf16_t*)(ws + OFF_OB); e.osrc = QKV; e.ogain = a.in[16]; e.tabo = tab; e.S.init(MROWS, 2048, gridDim.x, VB(lds));
    run_gemm(lds, (const bf16_t*)(ws + OFF_SA), (const bf16_t*)(ws + OFF_WZ), 2048, 1024, e);
}
extern __shared__ __attribute__((aligned(16))) unsigned char dyn_lds[];
constexpr int LDS_BYTES = 160 * 1024;
__global__ void __launch_bounds__(512, 2) mega(Args a) {
    cg::grid_group grid = cg::this_grid();
    LAS unsigned char* lds = (LAS unsigned char*)dyn_lds;
    unsigned char* ws = a.ws;
#define WB(off) ((bf16_t*)(ws + (off)))
#define WF(off) ((float*)(ws + (off)))
    float* out = a.out;
    signed char* LO = (signed char*)a.out;
    signed char* LO2 = (signed char*)(ws + 187 * MIB + MIB / 2);
    unsigned* bar = (unsigned*)(ws + 246 * MIB);
    XcdBarrier xb; xb.bar = bar; xb.x = xb_xcc_id(); xb.st = (volatile LAS unsigned*)(lds + 163792);
    if (tid_fresh() == 0) {
        const unsigned rank = xb_add(&bar[XB_XCNT(xb.x)], 1u);
        *(LAS int*)(lds + 163780) = (int)xb.x; *(LAS int*)(lds + 163784) = (int)rank; xb.st[0] = 0u; xb.st[1] = 0u; }
    __syncthreads();
    p0_phase(a, lds);
    if (ws == nullptr) grid.sync();
    xcd_barrier(xb);
    if (tid_fresh() == 0) {
        const int xcc = *(LAS const int*)(lds + 163780), rank = *(LAS const int*)(lds + 163784), G = (int)gridDim.x;
        int pre = 0; for (int x = 0; x < 8; ++x) { const unsigned cx = xb_ld(&bar[XB_XCNT(x)]); if (x < xcc) pre += (int)cx; }
        const int vcu = pre + rank;
        *(LAS int*)(lds + 163776) = (G % 8 == 0) ? (vcu % (G / 8)) * 8 + vcu / (G / 8) : vcu; *(LAS int*)(lds + 163788) = vcu; }
    __syncthreads();
    gemm_gu(lds, WB(OFF_SA), WF(OFF_SSQA), WB(OFF_WGU00), WB(OFF_BIG));
    slack_convert(a, lds, 5632, 2, 5);
    xcd_barrier(xb);
    gemm_res(lds, WB(OFF_BIG), WB(OFF_WD00), 2816, HRef{a.in[0], nullptr, nullptr}, HDst{nullptr, WB(OFF_SB), LO, WF(OFF_SSQB)}, 0.5f);
    xcd_barrier(xb);
    fill_rstd_tab(lds, WF(OFF_SSQB), 2304);
    { EpiT e{}; e.mode = 1; e.tabr = (LAS const float*)(lds + TABR_OFF); e.out = WB(OFF_BIG); e.ldo = 2304; e.S.init(MROWS, 2304, gridDim.x, VB(lds)); run_gemm(lds, WB(OFF_SB), WB(OFF_WATTIN), 2304, 1024, e); }
    slack_convert(a, lds, 2304, 5, 10);
    xcd_barrier(xb);
    att_phase(a, lds, WB(OFF_BIG), WB(OFF_SA));
    xcd_barrier(xb);
    gemm_res(lds, WB(OFF_SA), WB(OFF_WATTOUT), 1024, HRef{nullptr, WB(OFF_SB), LO}, HDst{nullptr, WB(OFF_SB), LO, WF(OFF_SSQB)}, 1.0f);
    xcd_barrier(xb);
    gemm_gu(lds, WB(OFF_SB), WF(OFF_SSQB), WB(OFF_WGU01), WB(OFF_BIG));
    slack_convert(a, lds, 5632, 10, 13);
    xcd_barrier(xb);
    gemm_res(lds, WB(OFF_BIG), WB(OFF_WD01), 2816, HRef{nullptr, WB(OFF_SB), LO}, HDst{nullptr, WB(OFF_SA), LO, WF(OFF_SSQA)}, 0.5f);
    xcd_barrier(xb);
    ple_phase(lds, WB(OFF_PB), WB(OFF_WPP0), WB(OFF_BIG), WB(OFF_SA), WF(OFF_SSQA), WB(OFF_WPG0), HRef{nullptr, WB(OFF_SA), LO}, HDst{nullptr, WB(OFF_SB), LO, WF(OFF_SSQB)});
    xcd_barrier(xb);
    cvt_rows_bf16(a.in[1] + (size_t)MROWS * 256, WB(OFF_PB), 64, tid_fresh() & 63, blockIdx.x * 8 + (tid_fresh() >> 6), gridDim.x * 8);
    gemm_gu(lds, WB(OFF_SB), WF(OFF_SSQB), WB(OFF_WGU10), WB(OFF_BIG));
    slack_convert(a, lds, 5632, 13, 17);
    xcd_barrier(xb);
    gemm_res(lds, WB(OFF_BIG), WB(OFF_WD10), 2816, HRef{nullptr, WB(OFF_SB), LO}, HDst{nullptr, WB(OFF_SA), LO, WF(OFF_SSQA)}, 0.5f);
    xcd_barrier(xb);
    fill_rstd_tab(lds, WF(OFF_SSQA), 4352);
    { EpiT e{}; e.mode = 2; e.tabr = (LAS const float*)(lds + TABR_OFF); e.out = WB(OFF_QKV); e.halo = WB(OFF_HALO); e.gates = WF(OFF_GATES); e.S.init(MROWS, 4352, gridDim.x, VB(lds)); run_gemm(lds, WB(OFF_SA), WB(OFF_WQKVG), 4352, 1024, e); }
    slack_convert(a, lds, 4352, 17, 22);
    xcd_barrier(xb);
    gdn_prep_phase(a, lds);
    xcd_barrier(xb);
    gdn_scan_phase(a, lds);
    xcd_barrier(xb);
    gdn_z_phase(a, lds);
    xcd_barrier(xb);
    gemm_res(lds, WB(OFF_OB), WB(OFF_WGO), 2048, HRef{nullptr, WB(OFF_SA), LO}, HDst{nullptr, WB(OFF_H2), LO, WF(OFF_SSQB)}, 1.0f);
    xcd_barrier(xb);
    gemm_gu(lds, WB(OFF_H2), WF(OFF_SSQB), WB(OFF_WGU11), WB(OFF_ACT11));
    const bool pp1_ready = slack_pp(lds, 5632, WB(OFF_PB), WB(OFF_WPP1), WB(203 * MIB + MIB / 2));
    xcd_barrier(xb);
    gemm_res(lds, WB(OFF_ACT11), WB(OFF_WD11), 2816, HRef{nullptr, WB(OFF_H2), LO}, HDst{nullptr, WB(OFF_H3), LO2, WF(OFF_SSQA)}, 0.5f);
    xcd_barrier(xb);
    ple_phase(lds, WB(OFF_PB), WB(OFF_WPP1), WB(203 * MIB + MIB / 2), WB(OFF_H3), WF(OFF_SSQA), WB(OFF_WPG1), HRef{nullptr, WB(OFF_H3), LO2}, HDst{out, nullptr, nullptr, nullptr}, pp1_ready);
#undef WB
#undef WF
}

extern "C" void kernel_launch(void* const* d_in, const int* in_sizes, int n_in, void* d_out, int out_size, void* d_ws, size_t ws_size, hipStream_t stream) {
    static int grid = 0;
    if (!grid) {
        int dev = 0, cus = 0, per = 0;
        (void)hipGetDevice(&dev); (void)hipDeviceGetAttribute(&cus, hipDeviceAttributeMultiprocessorCount, dev);
        (void)hipFuncSetAttribute((const void*)mega, hipFuncAttributeMaxDynamicSharedMemorySize, LDS_BYTES);
        (void)hipOccupancyMaxActiveBlocksPerMultiprocessor(&per, (const void*)mega, 512, LDS_BYTES);
        if (per < 1) { fprintf(stderr, "occupancy query says %d blocks/CU\n", per); per = 1; }
        grid = cus;
    }
    if (n_in != 21 || ws_size < WS_NEED) { fprintf(stderr, "kernel_launch: unexpected inputs / workspace (%d, %zu)\n", n_in, ws_size); return; }
    Args a{};
    for (int i = 0; i < 21; ++i) a.in[i] = (const float*)d_in[i];
    a.out = (float*)d_out; a.ws = (unsigned char*)d_ws;
    int nd = 0;
    auto add = [&](int si, size_t soff, int gi, size_t goff, size_t dstoff, int ldsrc, int col0, int ncols, int K, int dstrow0, int mode) {
        WDesc& w = a.wd[nd++]; w.src_idx = si; w.src_off = (unsigned)soff; w.gain_idx = gi; w.gain_off = (unsigned)goff; w.dst_off = dstoff; w.ldsrc = ldsrc; w.col0 = col0; w.ncols = ncols; w.K = K; w.dstrow0 = dstrow0; w.mode = mode; };
    const size_t offgu[4] = {OFF_WGU00, OFF_WGU01, OFF_WGU10, OFF_WGU11}, offd[4] = {OFF_WD00, OFF_WD01, OFF_WD10, OFF_WD11};
    auto addgu = [&](int f) { add(3, (size_t)f * 1024 * 2816, 2, f * 1024, offgu[f], 2816, 0, 2816, 1024, 0, 1); add(4, (size_t)f * 1024 * 2816, 2, f * 1024, offgu[f], 2816, 0, 2816, 1024, 0, 2); };
    auto addd = [&](int f) { add(5, (size_t)f * 2816 * 1024, -1, 0, offd[f], 1024, 0, 1024, 2816, 0, 0); };
    addgu(0);
    addd(0); add(7, 0, 6, 0, OFF_WATTIN, 2304, 0, 2304, 1024, 0, 0); add(11, 0, -1, 0, OFF_WATTOUT, 1024, 0, 1024, 1024, 0, 0);
    addgu(1); addd(1); add(19, 0, 18, 0, OFF_WPG0, 1024, 0, 1024, 1024, 0, 0); add(20, 0, -1, 0, OFF_WPP0, 1024, 0, 1024, 256, 0, 0);
    addgu(2); addd(2);
    add(12, 0, 6, 1024, OFF_WQKVG, 6176, 0, 4096, 1024, 0, 0); add(12, 0, 6, 1024, OFF_WQKVG, 6176, 6144, 32, 1024, 4096, 0); add(12, 0, 6, 1024, OFF_WZ, 6176, 4096, 2048, 1024, 0, 0); add(17, 0, -1, 0, OFF_WGO, 1024, 0, 1024, 2048, 0, 0);
    addgu(3); addd(3); add(19, 1024 * 1024, 18, 1024, OFF_WPG1, 1024, 0, 1024, 1024, 0, 0); add(20, 256 * 1024, -1, 0, OFF_WPP1, 1024, 0, 1024, 256, 0, 0);
    (void)hipMemsetAsync((unsigned char*)d_ws + 246 * MIB, 0, XCD_BAR_WORDS * 4, stream);
    void* args[] = {&a};
    hipError_t e = hipLaunchCooperativeKernel((const void*)mega, dim3(grid), dim3(512), args, LDS_BYTES, stream);
    if (e != hipSuccess) fprintf(stderr, "cooperative launch failed: %s (grid %d)\n", hipGetErrorString(e), grid);
}
```
